# Optimizing an MI355X kernel written in HIP

```python
import math
import jax, jax.numpy as jnp
from jax import lax
import numpy as np

D_MODEL = 1024
BATCH = 4
SEQ = 8192
DEPTH = 1

HEAD_DIM = 64
MOBA_HEADS = 6
DSA_HEADS = 6
MEM_HEADS = 4
MOBA_W = MOBA_HEADS * HEAD_DIM
DSA_W = DSA_HEADS * HEAD_DIM
MEM_W = MEM_HEADS * HEAD_DIM
IDX_HEADS = 8
IDX_DIM = 64
MOBA_BLOCK = 256
MOBA_TOPK = 3
DSA_TOPK = 256
N_MEM = 256
REL_BUCKETS = 32
REL_MAX_DIST = 128
Q_CHUNK = 128
EPS = 1e-6
IN_SIZES = (MOBA_W,) * 4 + (DSA_W,) * 4 + (IDX_HEADS * IDX_DIM, IDX_DIM, IDX_HEADS) + (MEM_W, MEM_W) + (D_MODEL,) * 3
IN_WIDTH = sum(IN_SIZES)
BRANCH_WIDTH = MOBA_W + DSA_W + MEM_W

kernel_name = 'hybrid_moba_dsa_memory_gated_block'


def rmsnorm(x, g):
    xf = x.astype(jnp.float32)
    y = xf * lax.rsqrt(jnp.mean(xf * xf, axis=-1, keepdims=True) + EPS)
    return (y * g.astype(jnp.float32)).astype(x.dtype)


def rel_bucket(dist):
    n = jnp.maximum(dist, 0)
    exact = REL_BUCKETS // 2
    nf = jnp.maximum(n, 1).astype(jnp.float32)
    large = exact + (jnp.log(nf / exact) / math.log(REL_MAX_DIST / exact) * (REL_BUCKETS - exact)).astype(jnp.int32)
    return jnp.where(n < exact, n, jnp.minimum(large, REL_BUCKETS - 1))


def split_cols(t, sizes):
    outs, off = [], 0
    for s in sizes:
        outs.append(t[..., off:off + s])
        off += s
    return outs


def masked_softmax(logits, mask):
    return jax.nn.softmax(jnp.where(mask, logits, -jnp.inf), axis=-1)


def moba_attention(q, k, v, bias_hb):
    b, t_len, h, dh = q.shape
    nb = -(-t_len // MOBA_BLOCK)
    padw = ((0, 0), (0, nb * MOBA_BLOCK - t_len), (0, 0), (0, 0))
    k_bh = jnp.pad(k, padw).reshape(b, nb, MOBA_BLOCK, h, dh).transpose(0, 3, 1, 2, 4)
    v_bh = jnp.pad(v, padw).reshape(b, nb, MOBA_BLOCK, h, dh).transpose(0, 3, 1, 2, 4)
    k_mean = jnp.mean(k_bh.astype(jnp.float32), axis=3)
    n_sel = min(MOBA_TOPK, nb)
    n_past = n_sel * MOBA_BLOCK
    scale = dh ** -0.5
    n_chunks = t_len // Q_CHUNK
    q_c = q.reshape(b, n_chunks, Q_CHUNK, h, dh).transpose(1, 0, 3, 2, 4)
    blk = jnp.arange(nb)
    offs = jnp.arange(MOBA_BLOCK)
    h_idx = jnp.arange(h)[None, :, None, None, None]
    gather = jax.vmap(jax.vmap(lambda kb, ib: kb[ib]))

    def one_chunk(args):
        ci, qc = args
        t = ci * Q_CHUNK + jnp.arange(Q_CHUNK)
        own = (ci * Q_CHUNK) // MOBA_BLOCK
        gate = jnp.einsum('bhqd,bhnd->bhqn', qc.astype(jnp.float32), k_mean)
        gate = jnp.where(blk < own, gate, -jnp.inf)
        _, sel = lax.top_k(gate, n_sel)
        k_sel = gather(k_bh, sel)
        v_sel = gather(v_bh, sel)
        lp = jnp.einsum('bhqd,bhqnsd->bhqns', qc, k_sel, preferred_element_type=jnp.float32) * scale
        pos = sel[..., None] * MOBA_BLOCK + offs
        lp = lp + bias_hb[h_idx, rel_bucket(t[:, None, None] - pos)]
        mp = jnp.broadcast_to((sel < own)[..., None], lp.shape)
        k_own = lax.dynamic_index_in_dim(k_bh, own, axis=2, keepdims=False)
        v_own = lax.dynamic_index_in_dim(v_bh, own, axis=2, keepdims=False)
        lo = jnp.einsum('bhqd,bhsd->bhqs', qc, k_own, preferred_element_type=jnp.float32) * scale
        dist = t[:, None] - (own * MOBA_BLOCK + offs)[None, :]
        lo = lo + bias_hb[:, rel_bucket(dist)][None]
        mo = jnp.broadcast_to(dist >= 0, lo.shape)
        logits = jnp.concatenate([lp.reshape(b, h, Q_CHUNK, n_past), lo], axis=-1)
        mask = jnp.concatenate([mp.reshape(b, h, Q_CHUNK, n_past), mo], axis=-1)
        p = masked_softmax(logits, mask).astype(v.dtype)
        p_past = p[..., :n_past].reshape(b, h, Q_CHUNK, n_sel, MOBA_BLOCK)
        return (jnp.einsum('bhqns,bhqnsd->bqhd', p_past, v_sel)
                + jnp.einsum('bhqs,bhsd->bqhd', p[..., n_past:], v_own))

    out = lax.map(one_chunk, (jnp.arange(n_chunks), q_c))
    return out.transpose(1, 0, 2, 3, 4).reshape(b, t_len, h * dh)


def dsa_attention(q, k, v, iq, ik, iw, bias_hb):
    b, t_len, h, dh = q.shape
    n_top = min(DSA_TOPK, t_len // 4)
    scale = dh ** -0.5
    n_chunks = t_len // Q_CHUNK
    q_c = q.reshape(b, n_chunks, Q_CHUNK, h, dh).transpose(1, 0, 2, 3, 4)
    iq_c = iq.reshape(b, n_chunks, Q_CHUNK, IDX_HEADS, IDX_DIM).transpose(1, 0, 2, 3, 4)
    iw_c = iw.reshape(b, n_chunks, Q_CHUNK, IDX_HEADS).transpose(1, 0, 2, 3)
    keys = jnp.arange(t_len)
    gather = jax.vmap(lambda a, i: a[i])

    def one_chunk(args):
        ci, qc, iqc, iwc = args
        t = ci * Q_CHUNK + jnp.arange(Q_CHUNK)
        rel = jax.nn.relu(jnp.einsum('bqhd,bsd->bqhs', iqc, ik, preferred_element_type=jnp.float32) * IDX_DIM ** -0.5)
        score = jnp.einsum('bqh,bqhs->bqs', iwc.astype(jnp.float32) * IDX_HEADS ** -0.5, rel)
        score = jnp.where(keys[None, None, :] <= t[None, :, None], score, -jnp.inf)
        _, idx = lax.top_k(score, n_top)
        k_sel = gather(k, idx)
        v_sel = gather(v, idx)
        logits = jnp.einsum('bqhd,bqkhd->bhqk', qc, k_sel, preferred_element_type=jnp.float32) * scale
        dist = t[None, :, None] - idx
        logits = logits + jnp.moveaxis(bias_hb[:, rel_bucket(dist)], 0, 1)
        mask = jnp.broadcast_to((dist >= 0)[:, None], logits.shape)
        p = masked_softmax(logits, mask).astype(v.dtype)
        return jnp.einsum('bhqk,bqkhd->bqhd', p, v_sel)

    out = lax.map(one_chunk, (jnp.arange(n_chunks), q_c, iq_c, iw_c))
    return out.transpose(1, 0, 2, 3, 4).reshape(b, t_len, h * dh)


def memory_attention(q, mem_k, mem_v):
    logits = jnp.einsum('bthd,bmhd->bhtm', q, mem_k, preferred_element_type=jnp.float32) * HEAD_DIM ** -0.5
    p = jax.nn.softmax(logits, axis=-1).astype(mem_v.dtype)
    return jnp.einsum('bhtm,bmhd->bthd', p, mem_v)


def hybrid_layer(x, mem, norm_gain, w_in, rel_bias, mem_norm_gain, w_mem_kv, w_branch, w_out):
    b, t_len, _ = x.shape
    n_mem = mem.shape[1]
    heads = lambda a: a.reshape(a.shape[0], a.shape[1], -1, HEAD_DIM)
    h = rmsnorm(x, norm_gain)
    proj = jnp.einsum('btd,dp->btp', h, w_in)
    (qa, ka, va, za, qb, kb, vb, zb, iq, ik, iw, qm, zm, ga, gb, gm) = split_cols(proj, IN_SIZES)
    bias_a = rel_bias[:, :MOBA_HEADS].T
    bias_b = rel_bias[:, MOBA_HEADS:].T
    ya = moba_attention(heads(qa), heads(ka), heads(va), bias_a) * jax.nn.silu(za)
    yb = dsa_attention(heads(qb), heads(kb), heads(vb),
                       iq.reshape(b, t_len, IDX_HEADS, IDX_DIM), ik, iw, bias_b) * jax.nn.silu(zb)
    mem_n = rmsnorm(mem, mem_norm_gain)
    mk, mv = split_cols(jnp.einsum('bmd,dp->bmp', mem_n, w_mem_kv), (MEM_W, MEM_W))
    ym = memory_attention(heads(qm), heads(mk), heads(mv)).reshape(b, t_len, MEM_W) * jax.nn.silu(zm)
    pa = w_branch[:MOBA_W]
    pb = w_branch[MOBA_W:MOBA_W + DSA_W]
    pm = w_branch[MOBA_W + DSA_W:]
    merged = (jax.nn.sigmoid(ga) * jnp.einsum('btc,cd->btd', ya, pa)
              + jax.nn.sigmoid(gb) * jnp.einsum('btc,cd->btd', yb, pb)
              + jax.nn.sigmoid(gm) * jnp.einsum('btc,cd->btd', ym, pm))
    return x + jnp.einsum('btd,de->bte', merged, w_out)


def setup_inputs(seed: int = 0) -> dict:
    key = jax.random.key(seed)
    ks = jax.random.split(key, 10)
    f = jnp.float32
    nrm = jax.random.normal
    return {
        'x': nrm(ks[0], (BATCH, SEQ, D_MODEL), f),
        'mem': nrm(ks[1], (BATCH, N_MEM, D_MODEL), f),
        'norm_gain': 1.0 + 0.02 * nrm(ks[2], (DEPTH, D_MODEL), f),
        'w_in': nrm(ks[3], (DEPTH, D_MODEL, IN_WIDTH), f) * D_MODEL ** -0.5,
        'rel_bias': 0.5 * nrm(ks[4], (REL_BUCKETS, MOBA_HEADS + DSA_HEADS), f),
        'mem_norm_gain': 1.0 + 0.02 * nrm(ks[5], (DEPTH, D_MODEL), f),
        'w_mem_kv': nrm(ks[6], (DEPTH, D_MODEL, 2 * MEM_W), f) * D_MODEL ** -0.5,
        'w_branch': nrm(ks[7], (DEPTH, BRANCH_WIDTH, D_MODEL), f) * MOBA_W ** -0.5,
        'w_out': nrm(ks[8], (DEPTH, D_MODEL, D_MODEL), f) * D_MODEL ** -0.5,
        'final_norm_gain': 1.0 + 0.02 * nrm(ks[9], (D_MODEL,), f),
    }


def reference(x, mem, norm_gain, w_in, rel_bias, mem_norm_gain, w_mem_kv, w_branch, w_out, final_norm_gain):
    for layer in range(DEPTH):
        x = hybrid_layer(x, mem, norm_gain[layer], w_in[layer], rel_bias, mem_norm_gain[layer],
                         w_mem_kv[layer], w_branch[layer], w_out[layer])
    return rmsnorm(x, final_norm_gain)
```

```cpp
#include <hip/hip_runtime.h>
#include <hip/hip_cooperative_groups.h>
#include <stdint.h>
#include <stdio.h>
namespace cg = cooperative_groups;

#define DEVINL __device__ __forceinline__
#define LAS __attribute__((address_space(3)))

typedef unsigned short bf16_t;
typedef short bf16x8 __attribute__((ext_vector_type(8)));
typedef short s16x4 __attribute__((ext_vector_type(4)));
typedef float f32x16 __attribute__((ext_vector_type(16)));
typedef float f32x4 __attribute__((ext_vector_type(4)));
typedef unsigned u32x4 __attribute__((ext_vector_type(4)));
typedef unsigned u32x2 __attribute__((ext_vector_type(2)));

constexpr int NB = 4, SEQ = 8192, DM = 1024, NT = NB * SEQ;
constexpr int HD = 64, HA = 6, HB = 6, HM = 4, WA = 384, WB = 384, WM = 256;
constexpr int NMEM = 256, INW = 7240;
constexpr int NWIN = 7296;
constexpr int NG1 = 33;
constexpr int GATE0 = 4224;
constexpr float EPS = 1e-6f;
constexpr float LOG2E = 1.4426950408889634f;
constexpr float QSCALE = 0.125f * LOG2E;
constexpr float CSCALE = 0.35355339059327373f * 0.125f;
constexpr int NTHR = 512;

constexpr size_t MiB = 1u << 20;
constexpr size_t WS_CTL = 0, WS_WIN = 1 * MiB, WS_WBR = 16 * MiB, WS_WOUT = 18 * MiB, WS_WMEM = 20 * MiB, WS_MEMN = 21 * MiB,
                 WS_MK = 23 * MiB, WS_MV = 23 * MiB + 512 * 1024, WS_KMEAN = 24 * MiB, WS_IW = 25 * MiB, WS_IK = 26 * MiB,
                 WS_LIST = 30 * MiB, WS_IDX = 36 * MiB, WS_IQ = 52 * MiB, WS_QM = 84 * MiB, WS_ZM = 100 * MiB, WS_ACT8 = 116 * MiB,
                 WS_GATES = 308 * MiB, WS_SSQ = 500 * MiB, WS_END = 501 * MiB;
constexpr size_t ACT_STRIDE = (size_t)NT * 384 * 2;
constexpr size_t WS_MERGED = WS_ACT8 + ACT_STRIDE;
constexpr size_t WS_PO = WS_GATES, WS_PL = WS_GATES + 96 * MiB;
constexpr int CTL_WORDS = 2048, CTL_QUEUE = 1024;
constexpr int LIST_PER_BH = 126976;

struct Params {
    const float *x, *mem, *norm_gain, *w_in, *rel_bias, *mem_gain, *w_mem_kv, *w_branch, *w_out, *final_gain;
    float* out; unsigned char* ws;
};

typedef __bf16 bf16x2_t __attribute__((ext_vector_type(2)));
DEVINL unsigned cvtpk(float lo, float hi) { bf16x2_t v; v.x = (__bf16)lo; v.y = (__bf16)hi; return __builtin_bit_cast(unsigned, v); }
DEVINL float bf_lo(unsigned u) { return __uint_as_float(u << 16); }
DEVINL float bf_hi(unsigned u) { return __uint_as_float(u & 0xffff0000u); }
DEVINL float bf2f(bf16_t b) { return __uint_as_float(((unsigned)b) << 16); }
DEVINL float wave_sum(float v) {
#pragma unroll
    for (int o = 1; o < 64; o <<= 1) v += __shfl_xor(v, o);
    return v;
}
DEVINL float wave_max(float v) {
#pragma unroll
    for (int o = 1; o < 64; o <<= 1) v = fmaxf(v, __shfl_xor(v, o));
    return v;
}
DEVINL float fexp2(float x) { return __builtin_amdgcn_exp2f(x); }
DEVINL float fsigm(float z) { return 1.f / (1.f + fexp2(-z * LOG2E)); }
DEVINL float fsilu(float z) { return z * fsigm(z); }
#define LDS_WAIT() asm volatile("s_waitcnt lgkmcnt(0)" ::: "memory")
#define MFMA32(a, b, c) __builtin_amdgcn_mfma_f32_32x32x16_bf16(a, b, c, 0, 0, 0)
DEVINL int crow(int r, int hi) { return (r & 3) + 8 * (r >> 2) + 4 * hi; }
DEVINL int rel_bucket(int d) {
    if (d < 16) return d;
    return 16 + (d >= 19) + (d >= 21) + (d >= 24) + (d >= 27) + (d >= 31) + (d >= 35) + (d >= 40) + (d >= 46) + (d >= 52) + (d >= 59) +
           (d >= 67) + (d >= 77) + (d >= 87) + (d >= 99) + (d >= 113);
}
DEVINL int list_off(int n) { return 8192 * n - 128 * n * (n + 1); }

DEVINL int win_srccol(int n) {
    if (n < 3584) return n;
    if (n < 3840) return n - 3584 + 3656;
    if (n < 4096) return n - 3840 + 3912;
    if (n < 4160) return n - 4096 + 3584;
    if (n < 4168) return n - 4160 + 3648;
    if (n < GATE0) return -1;
    return n - GATE0 + 4168;
}
template <int KIND>
DEVINL void p0_transpose_item(const float* __restrict__ W, int ldw, const float* __restrict__ gain, bf16_t* WT, int K, int item, int nblk, float* scr, int lane) {
    const int kb = item / nblk, nb = item % nblk, k0 = kb * 64, n0 = nb * 32;
    const int n = n0 + (lane & 31);
    const int sc = (KIND == 0) ? win_srccol(n) : n;
#pragma unroll 8
    for (int i = 0; i < 32; ++i) {
        const int kk = 2 * i + (lane >> 5);
        float v = 0.f;
        if (sc >= 0) v = W[(size_t)(k0 + kk) * ldw + sc];
        if (gain) v *= gain[k0 + kk];
        scr[kk * 33 + (lane & 31)] = v;
    }
    LDS_WAIT();
    const int c = lane & 7;
#pragma unroll
    for (int j = 0; j < 4; ++j) {
        const int nn = (lane >> 3) + 8 * j;
        const float* s = scr + (8 * c) * 33 + nn;
        u32x4 o;
        o.x = cvtpk(s[0 * 33], s[1 * 33]); o.y = cvtpk(s[2 * 33], s[3 * 33]); o.z = cvtpk(s[4 * 33], s[5 * 33]); o.w = cvtpk(s[6 * 33], s[7 * 33]);
        *(u32x4*)(WT + (size_t)(n0 + nn) * K + k0 + 8 * c) = o;
    }
    LDS_WAIT();
}
DEVINL void norm_row_bf16(const float* xrow, bf16_t* orow, int lane) {
    const f32x4* xr = (const f32x4*)xrow + lane;
    f32x4 v[4]; float s = 0.f;
#pragma unroll
    for (int j = 0; j < 4; ++j) { v[j] = xr[64 * j]; s += (v[j].x * v[j].x + v[j].y * v[j].y) + (v[j].z * v[j].z + v[j].w * v[j].w); }
    const float rstd = rsqrtf(wave_sum(s) * (1.f / DM) + EPS);
    u32x2* o8 = (u32x2*)orow + lane;
#pragma unroll
    for (int j = 0; j < 4; ++j) { u32x2 w; w.x = cvtpk(v[j].x * rstd, v[j].y * rstd); w.y = cvtpk(v[j].z * rstd, v[j].w * rstd); o8[64 * j] = w; }
}
DEVINL void phase0(const Params& p, char* lds) {
    const int tid = threadIdx.x, lane = tid & 63, wave = tid >> 6;
    const int gw = blockIdx.x * 8 + wave, NGW = gridDim.x * 8;
    unsigned* ctl = (unsigned*)(p.ws + WS_CTL);
    for (int i = blockIdx.x * NTHR + tid; i < CTL_WORDS; i += gridDim.x * NTHR) ctl[i] = 0u;
    bf16_t* XN = (bf16_t*)p.out;
    bf16_t* MEMN = (bf16_t*)(p.ws + WS_MEMN);
    for (int r = gw; r < NT + NB * NMEM; r += NGW) {
        if (r < NT) norm_row_bf16(p.x + (size_t)r * DM, XN + (size_t)r * DM, lane);
        else norm_row_bf16(p.mem + (size_t)(r - NT) * DM, MEMN + (size_t)(r - NT) * DM, lane);
    }
    float* scr = (float*)(lds + wave * 8448);
    constexpr int I_WIN = 16 * (NWIN / 32), I_BR = 16 * 32, I_OUT = 16 * 32, I_MEM = 16 * 16;
    for (int it = gw; it < I_WIN + I_BR + I_OUT + I_MEM; it += NGW) {
        int r = it;
        if (r < I_WIN) { p0_transpose_item<0>(p.w_in, INW, p.norm_gain, (bf16_t*)(p.ws + WS_WIN), DM, r, NWIN / 32, scr, lane); continue; } r -= I_WIN;
        if (r < I_BR) { p0_transpose_item<1>(p.w_branch, DM, nullptr, (bf16_t*)(p.ws + WS_WBR), DM, r, 32, scr, lane); continue; } r -= I_BR;
        if (r < I_OUT) { p0_transpose_item<1>(p.w_out, DM, nullptr, (bf16_t*)(p.ws + WS_WOUT), DM, r, 32, scr, lane); continue; } r -= I_OUT;
        p0_transpose_item<1>(p.w_mem_kv, 512, p.mem_gain, (bf16_t*)(p.ws + WS_WMEM), DM, r, 16, scr, lane);
    }
}

constexpr int G_STAGE = 49152, G_AOFF = 0, G_BOFF = 32768;
DEVINL int swz128(int row, int chunk) { return row * 128 + ((chunk ^ ((row >> 1) & 7)) << 4); }
DEVINL void gemm_tile(const bf16_t* __restrict__ A, int lda, const bf16_t* __restrict__ Bt, int ldb, int K, f32x16 (&acc)[2][2], char* lds) {
    const int tid = threadIdx.x, lane = tid & 63, wave = tid >> 6, wm = wave >> 1, wn = wave & 1, r32 = lane & 31, hi = lane >> 5;
    const int lr = tid >> 3, lc = tid & 7;
    const bf16_t* ga = A + (size_t)lr * lda + lc * 8;
    const bf16_t* gb = Bt + (size_t)lr * ldb + lc * 8;
    u32x4 ra[4], rb[2];
#pragma unroll
    for (int j = 0; j < 4; ++j) ra[j] = *(const u32x4*)(ga + (size_t)(64 * j) * lda);
#pragma unroll
    for (int j = 0; j < 2; ++j) rb[j] = *(const u32x4*)(gb + (size_t)(64 * j) * ldb);
#pragma unroll
    for (int j = 0; j < 4; ++j) *(u32x4*)(lds + G_AOFF + swz128(lr + 64 * j, lc)) = ra[j];
#pragma unroll
    for (int j = 0; j < 2; ++j) *(u32x4*)(lds + G_BOFF + swz128(lr + 64 * j, lc)) = rb[j];
    __syncthreads();
    const int nk = K / 64;
    for (int kt = 0; kt < nk; ++kt) {
        const char* st = lds + (kt & 1) * G_STAGE;
        if (kt + 1 < nk) {
#pragma unroll
            for (int j = 0; j < 4; ++j) ra[j] = *(const u32x4*)(ga + (size_t)(64 * j) * lda + (kt + 1) * 64);
#pragma unroll
            for (int j = 0; j < 2; ++j) rb[j] = *(const u32x4*)(gb + (size_t)(64 * j) * ldb + (kt + 1) * 64);
        }
#pragma unroll
        for (int s = 0; s < 4; ++s) {
            const bf16x8 a0 = *(const bf16x8*)(st + G_AOFF + swz128(wm * 64 + r32, 2 * s + hi));
            const bf16x8 a1 = *(const bf16x8*)(st + G_AOFF + swz128(wm * 64 + 32 + r32, 2 * s + hi));
            const bf16x8 b0 = *(const bf16x8*)(st + G_BOFF + swz128(wn * 64 + r32, 2 * s + hi));
            const bf16x8 b1 = *(const bf16x8*)(st + G_BOFF + swz128(wn * 64 + 32 + r32, 2 * s + hi));
            acc[0][0] = MFMA32(b0, a0, acc[0][0]); acc[0][1] = MFMA32(b1, a0, acc[0][1]);
            acc[1][0] = MFMA32(b0, a1, acc[1][0]); acc[1][1] = MFMA32(b1, a1, acc[1][1]);
        }
        if (kt + 1 < nk) {
            char* sn = lds + ((kt + 1) & 1) * G_STAGE;
#pragma unroll
            for (int j = 0; j < 4; ++j) *(u32x4*)(sn + G_AOFF + swz128(lr + 64 * j, lc)) = ra[j];
#pragma unroll
            for (int j = 0; j < 2; ++j) *(u32x4*)(sn + G_BOFF + swz128(lr + 64 * j, lc)) = rb[j];
        }
        __syncthreads();
    }
}
DEVINL void zero_acc(f32x16 (&acc)[2][2]) {
#pragma unroll
    for (int i = 0; i < 2; ++i)
#pragma unroll
        for (int j = 0; j < 2; ++j)
#pragma unroll
            for (int r = 0; r < 16; ++r) acc[i][j][r] = 0.f;
}
constexpr int STG_PITCH = 272;
template <int ACT>
DEVINL void epi_to_lds(const f32x16 (&acc)[2][2], char* lds, float sc) {
    const int tid = threadIdx.x, lane = tid & 63, wave = tid >> 6, wm = wave >> 1, wn = wave & 1, r32 = lane & 31, hi = lane >> 5;
#pragma unroll
    for (int i = 0; i < 2; ++i)
#pragma unroll
        for (int j = 0; j < 2; ++j)
#pragma unroll
            for (int g = 0; g < 4; ++g) {
                float v[4];
#pragma unroll
                for (int e = 0; e < 4; ++e) {
                    float t = acc[i][j][4 * g + e];
                    if (ACT == 1) t *= sc;
                    if (ACT == 2) t = fsilu(t);
                    if (ACT == 3) t = fsigm(t);
                    v[e] = t;
                }
                u32x2 w; w.x = cvtpk(v[0], v[1]); w.y = cvtpk(v[2], v[3]);
                *(u32x2*)(lds + (wm * 64 + 32 * i + r32) * STG_PITCH + (wn * 64 + 32 * j + 8 * g + 4 * hi) * 2) = w;
            }
}
DEVINL void lds_tile_store(char* lds, bf16_t* C, int ldc) {
    const int tid = threadIdx.x;
#pragma unroll
    for (int j = 0; j < 8; ++j) {
        const int row = (tid >> 4) + 32 * j, ch = tid & 15;
        const u32x4 v = *(const u32x4*)(lds + row * STG_PITCH + ch * 16);
        *(u32x4*)(C + (size_t)row * ldc + ch * 8) = v;
    }
}

DEVINL void phase1(const Params& p, char* lds) {
    const int tid = threadIdx.x, lane = tid & 63, wave = tid >> 6, wm = wave >> 1, wn = wave & 1, r32 = lane & 31, hi = lane >> 5;
    const bf16_t* XN = (const bf16_t*)p.out;
    const bf16_t* WIN = (const bf16_t*)(p.ws + WS_WIN);
    constexpr int NMAIN = 128 * NG1, NMEMT = 4 * 4;
    for (int it = blockIdx.x; it < NMAIN + NMEMT; it += gridDim.x) {
        f32x16 acc[2][2]; zero_acc(acc);
        if (it < NMAIN) {
            const int grp = it / (8 * NG1), rem = it % (8 * NG1), nt = rem / 8, mt = grp * 8 + (rem & 7);
            gemm_tile(XN + (size_t)mt * 256 * DM, DM, WIN + (size_t)nt * 128 * DM, DM, DM, acc, lds);
            const size_t m0 = (size_t)mt * 256;
            if (nt < 24) {
                const int g8 = nt / 3, co = (nt % 3) * 128;
                bf16_t* dst = (bf16_t*)(p.ws + WS_ACT8 + (size_t)g8 * ACT_STRIDE) + m0 * 384 + co;
                if (g8 == 0 || g8 == 4) epi_to_lds<1>(acc, lds, QSCALE);
                else if (g8 == 3 || g8 == 7) epi_to_lds<2>(acc, lds, 1.f);
                else epi_to_lds<0>(acc, lds, 1.f);
                __syncthreads();
                lds_tile_store(lds, dst, 384);
                if (g8 == 1 && tid < 128) {
                    float s = 0.f;
                    for (int r = 0; r < 256; ++r) s += bf2f(*(const bf16_t*)(lds + r * STG_PITCH + tid * 2));
                    ((float*)(p.ws + WS_KMEAN))[(size_t)mt * 384 + co + tid] = s * (1.f / 256.f);
                }
                __syncthreads();
            } else if (nt < 28) {
                epi_to_lds<0>(acc, lds, 1.f); __syncthreads();
                lds_tile_store(lds, (bf16_t*)(p.ws + WS_IQ) + m0 * 512 + (nt - 24) * 128, 512); __syncthreads();
            } else if (nt < 30) {
                epi_to_lds<1>(acc, lds, QSCALE); __syncthreads();
                lds_tile_store(lds, (bf16_t*)(p.ws + WS_QM) + m0 * 256 + (nt - 28) * 128, 256); __syncthreads();
            } else if (nt < 32) {
                epi_to_lds<2>(acc, lds, 1.f); __syncthreads();
                lds_tile_store(lds, (bf16_t*)(p.ws + WS_ZM) + m0 * 256 + (nt - 30) * 128, 256); __syncthreads();
            } else {
                epi_to_lds<0>(acc, lds, 1.f); __syncthreads();
                {
                    bf16_t* IK = (bf16_t*)(p.ws + WS_IK) + m0 * 64;
#pragma unroll
                    for (int j = 0; j < 4; ++j) {
                        const int idx = tid + 512 * j, row = idx >> 3, ch = idx & 7;
                        *(u32x4*)(IK + (size_t)row * 64 + ch * 8) = *(const u32x4*)(lds + row * STG_PITCH + ch * 16);
                    }
                }
                if (wn == 1) {
                    float* IW = (float*)(p.ws + WS_IW) + m0 * 8;
#pragma unroll
                    for (int i = 0; i < 2; ++i) {
                        f32x4 v; v.x = acc[i][0][0] * CSCALE; v.y = acc[i][0][1] * CSCALE; v.z = acc[i][0][2] * CSCALE; v.w = acc[i][0][3] * CSCALE;
                        *(f32x4*)(IW + (size_t)(wm * 64 + 32 * i + r32) * 8 + 4 * hi) = v;
                    }
                }
                __syncthreads();
            }
        } else {
            const int mi = it - NMAIN, mt = mi >> 2, nt = mi & 3;
            gemm_tile((const bf16_t*)(p.ws + WS_MEMN) + (size_t)mt * 256 * DM, DM, (const bf16_t*)(p.ws + WS_WMEM) + (size_t)nt * 128 * DM, DM, DM, acc, lds);
            epi_to_lds<0>(acc, lds, 1.f); __syncthreads();
            bf16_t* dst = (bf16_t*)(p.ws + (nt < 2 ? WS_MK : WS_MV)) + (size_t)mt * 256 * 256 + (nt & 1) * 128;
            lds_tile_store(lds, dst, 256); __syncthreads();
        }
    }
}

DEVINL void phase_gates(const Params& p, char* lds) {
    const bf16_t* XN = (const bf16_t*)p.out;
    const bf16_t* WIN = (const bf16_t*)(p.ws + WS_WIN);
    for (int it = blockIdx.x; it < 128 * 24; it += gridDim.x) {
        const int grp = it / (8 * 24), rem = it % (8 * 24), nt = rem / 8, mt = grp * 8 + (rem & 7);
        f32x16 acc[2][2]; zero_acc(acc);
        gemm_tile(XN + (size_t)mt * 256 * DM, DM, WIN + (size_t)(GATE0 + nt * 128) * DM, DM, DM, acc, lds);
        epi_to_lds<3>(acc, lds, 1.f); __syncthreads();
        lds_tile_store(lds, (bf16_t*)(p.ws + WS_GATES) + (size_t)mt * 256 * 3072 + nt * 128, 3072); __syncthreads();
    }
}

DEVINL void phase_merge(const Params& p, char* lds) {
    const int tid = threadIdx.x, lane = tid & 63, wave = tid >> 6, wm = wave >> 1, wn = wave & 1, r32 = lane & 31, hi = lane >> 5;
    const bf16_t* WBR = (const bf16_t*)(p.ws + WS_WBR);
    const bf16_t* GATES = (const bf16_t*)(p.ws + WS_GATES);
    for (int it = blockIdx.x; it < 128 * 8; it += gridDim.x) {
        const int nt = it >> 7, mt = it & 127;
        const size_t m0 = (size_t)mt * 256;
        f32x16 acc[2][2]; zero_acc(acc);
#pragma unroll 1
        for (int br = 0; br < 3; ++br) {
            const bf16_t* Y; int ldy, K, koff;
            if (br == 0) { Y = (const bf16_t*)(p.ws + WS_ACT8) + m0 * 384; ldy = 384; K = 384; koff = 0; }
            else if (br == 1) { Y = (const bf16_t*)(p.ws + WS_ACT8 + 4 * ACT_STRIDE) + m0 * 384; ldy = 384; K = 384; koff = 384; }
            else { Y = (const bf16_t*)(p.ws + WS_QM) + m0 * 256; ldy = 256; K = 256; koff = 768; }
            gemm_tile(Y, ldy, WBR + (size_t)nt * 128 * DM + koff, DM, K, acc, lds);
#pragma unroll
            for (int i = 0; i < 2; ++i)
#pragma unroll
                for (int j = 0; j < 2; ++j)
#pragma unroll
                    for (int g = 0; g < 4; ++g) {
                        const size_t m = m0 + wm * 64 + 32 * i + r32;
                        const int n = nt * 128 + wn * 64 + 32 * j + 8 * g + 4 * hi;
                        const u32x2 gw = *(const u32x2*)(GATES + m * 3072 + br * 1024 + n);
                        float f0 = bf_lo(gw.x), f1 = bf_hi(gw.x), f2 = bf_lo(gw.y), f3 = bf_hi(gw.y);
                        if (br < 2) {
                            const u32x2 gn = *(const u32x2*)(GATES + m * 3072 + (br + 1) * 1024 + n);
                            f0 = f0 / bf_lo(gn.x); f1 = f1 / bf_hi(gn.x); f2 = f2 / bf_lo(gn.y); f3 = f3 / bf_hi(gn.y);
                        }
                        acc[i][j][4 * g + 0] *= f0; acc[i][j][4 * g + 1] *= f1; acc[i][j][4 * g + 2] *= f2; acc[i][j][4 * g + 3] *= f3;
                    }
        }
        epi_to_lds<0>(acc, lds, 1.f); __syncthreads();
        lds_tile_store(lds, (bf16_t*)(p.ws + WS_MERGED) + m0 * DM + nt * 128, DM); __syncthreads();
    }
}

DEVINL void phase_out(const Params& p, char* lds) {
    const int tid = threadIdx.x, lane = tid & 63, wave = tid >> 6, wm = wave >> 1, wn = wave & 1, r32 = lane & 31, hi = lane >> 5;
    float* SSQ = (float*)(p.ws + WS_SSQ);
    for (int it = blockIdx.x; it < 128 * 8; it += gridDim.x) {
        const int nt = it >> 7, mt = it & 127;
        const size_t m0 = (size_t)mt * 256;
        f32x16 acc[2][2]; zero_acc(acc);
        gemm_tile((const bf16_t*)(p.ws + WS_MERGED) + m0 * DM, DM, (const bf16_t*)(p.ws + WS_WOUT) + (size_t)nt * 128 * DM, DM, DM, acc, lds);
        float* ssl = (float*)lds;
#pragma unroll
        for (int i = 0; i < 2; ++i) {
            const size_t m = m0 + wm * 64 + 32 * i + r32;
            float ss = 0.f;
#pragma unroll
            for (int j = 0; j < 2; ++j)
#pragma unroll
                for (int g = 0; g < 4; ++g) {
                    const int n = nt * 128 + wn * 64 + 32 * j + 8 * g + 4 * hi;
                    const f32x4 xv = *(const f32x4*)(p.x + m * DM + n);
                    f32x4 y; y.x = xv.x + acc[i][j][4 * g + 0]; y.y = xv.y + acc[i][j][4 * g + 1]; y.z = xv.z + acc[i][j][4 * g + 2]; y.w = xv.w + acc[i][j][4 * g + 3];
                    ss += (y.x * y.x + y.y * y.y) + (y.z * y.z + y.w * y.w);
                    *(f32x4*)(p.out + m * DM + n) = y;
                }
            ss += __shfl_xor(ss, 32);
            if (hi == 0) ssl[(wm * 64 + 32 * i + r32) * 2 + wn] = ss;
        }
        __syncthreads();
        if (tid < 256) SSQ[(m0 + tid) * 8 + nt] = ssl[tid * 2] + ssl[tid * 2 + 1];
        __syncthreads();
    }
}
DEVINL void phase_final(const Params& p) {
    const int tid = threadIdx.x, lane = tid & 63, wave = tid >> 6;
    const float* SSQ = (const float*)(p.ws + WS_SSQ);
    for (int r = blockIdx.x * 8 + wave; r < NT; r += gridDim.x * 8) {
        const f32x4 s0 = *(const f32x4*)(SSQ + (size_t)r * 8), s1 = *(const f32x4*)(SSQ + (size_t)r * 8 + 4);
        const float ss = ((s0.x + s0.y) + (s0.z + s0.w)) + ((s1.x + s1.y) + (s1.z + s1.w));
        const float rstd = rsqrtf(ss * (1.f / DM) + EPS);
        f32x4* yr = (f32x4*)(p.out + (size_t)r * DM) + lane;
        const f32x4* gr = (const f32x4*)p.final_gain + lane;
#pragma unroll
        for (int j = 0; j < 4; ++j) { f32x4 y = yr[64 * j]; const f32x4 g = gr[64 * j]; y.x *= rstd * g.x; y.y *= rstd * g.y; y.z *= rstd * g.z; y.w *= rstd * g.w; yr[64 * j] = y; }
    }
}

constexpr int AT_K = 0, AT_V = 32768, AT_VPLANE = 16384 + 64, AT_END = AT_V + 2 * AT_VPLANE;
DEVINL void load_kv_block(const bf16_t* __restrict__ Kg, const bf16_t* __restrict__ Vg, int ld, char* lds) {
    const int tid = threadIdx.x, c = tid & 7, kr = tid >> 3;
    u32x4 kk[4], vv[4];
#pragma unroll
    for (int j = 0; j < 4; ++j) { kk[j] = *(const u32x4*)(Kg + (size_t)(kr + 64 * j) * ld + c * 8); vv[j] = *(const u32x4*)(Vg + (size_t)(kr + 64 * j) * ld + c * 8); }
#pragma unroll
    for (int j = 0; j < 4; ++j) {
        const int key = kr + 64 * j;
        *(u32x4*)(lds + AT_K + swz128(key, c)) = kk[j];
        *(u32x4*)(lds + AT_V + (c >> 2) * AT_VPLANE + key * 64 + (c & 3) * 16) = vv[j];
    }
}
DEVINL s16x4 tr_read(const char* p) {
    typedef short v4i16_t __attribute__((ext_vector_type(4)));
    return __builtin_bit_cast(s16x4, __builtin_amdgcn_ds_read_tr16_b64_v4i16((LAS v4i16_t*)(uintptr_t)(unsigned)(uintptr_t)p));
}
struct AttnState { float mhat, l; f32x16 o0, o1; };
constexpr float ATT_THR = 8.f;
template <int MODE>
DEVINL void attn_256(const bf16x8 (&qf)[4], const char* lds, int t_row, int pos0, const float* lut, float* wsf, AttnState& st) {
    const int lane = threadIdx.x & 63, r32 = lane & 31, hi = lane >> 5;
    const char* KL = lds + AT_K;
    const char* vbase = lds + AT_V + (4 * hi + ((lane & 15) >> 2)) * 64 + ((lane >> 4) & 1) * 32 + (lane & 3) * 8;
    float mhat = 0.f, l = 0.f;
    f32x16 o0, o1;
#pragma unroll
    for (int r = 0; r < 16; ++r) { o0[r] = 0.f; o1[r] = 0.f; }
#pragma unroll 1
    for (int stp = 0; stp < 4; ++stp) {
        f32x16 s0, s1;
#pragma unroll
        for (int r = 0; r < 16; ++r) { s0[r] = 0.f; s1[r] = 0.f; }
#pragma unroll
        for (int s = 0; s < 4; ++s) {
            const bf16x8 k0 = *(const bf16x8*)(KL + swz128(64 * stp + r32, 2 * s + hi));
            const bf16x8 k1 = *(const bf16x8*)(KL + swz128(64 * stp + 32 + r32, 2 * s + hi));
            s0 = MFMA32(k0, qf[s], s0); s1 = MFMA32(k1, qf[s], s1);
        }
        if (MODE == 1) {
#pragma unroll
            for (int r = 0; r < 16; ++r) {
                const int d0 = t_row - (pos0 + 64 * stp + crow(r, hi)), d1 = d0 - 32;
                s0[r] = d0 < 0 ? -INFINITY : s0[r] + lut[d0 > 127 ? 127 : d0];
                s1[r] = d1 < 0 ? -INFINITY : s1[r] + lut[d1 > 127 ? 127 : d1];
            }
        }
        float rm = fmaxf(s0[0], s1[0]);
#pragma unroll
        for (int r = 1; r < 16; ++r) rm = fmaxf(rm, fmaxf(s0[r], s1[r]));
        { auto rr = __builtin_amdgcn_permlane32_swap(__float_as_uint(rm), __float_as_uint(rm), false, false); rm = fmaxf(__uint_as_float(rr[0]), __uint_as_float(rr[1])); }
        if (stp == 0) { mhat = fmaxf(rm, -1e30f); }
        else {
            const float grow = rm - mhat;
            if (__any(grow > ATT_THR)) {
                const float dl = fmaxf(grow, 0.f); mhat += dl;
                const float f = fexp2(-dl); l *= f;
                if (hi == 0) wsf[r32] = f;
                LDS_WAIT();
#pragma unroll
                for (int g = 0; g < 4; ++g) {
                    const f32x4 fv = *(const f32x4*)(wsf + 8 * g + 4 * hi);
                    o0[4 * g + 0] *= fv.x; o0[4 * g + 1] *= fv.y; o0[4 * g + 2] *= fv.z; o0[4 * g + 3] *= fv.w;
                    o1[4 * g + 0] *= fv.x; o1[4 * g + 1] *= fv.y; o1[4 * g + 2] *= fv.z; o1[4 * g + 3] *= fv.w;
                }
                LDS_WAIT();
            }
        }
        float ps = 0.f;
#pragma unroll
        for (int r = 0; r < 16; ++r) { s0[r] = fexp2(s0[r] - mhat); s1[r] = fexp2(s1[r] - mhat); ps += s0[r] + s1[r]; }
        l += ps;
#pragma unroll
        for (int sub = 0; sub < 2; ++sub)
#pragma unroll
            for (int sp = 0; sp < 2; ++sp) {
                u32x4 pw;
                if (sub == 0) { pw.x = cvtpk(s0[8 * sp + 0], s0[8 * sp + 1]); pw.y = cvtpk(s0[8 * sp + 2], s0[8 * sp + 3]); pw.z = cvtpk(s0[8 * sp + 4], s0[8 * sp + 5]); pw.w = cvtpk(s0[8 * sp + 6], s0[8 * sp + 7]); }
                else { pw.x = cvtpk(s1[8 * sp + 0], s1[8 * sp + 1]); pw.y = cvtpk(s1[8 * sp + 2], s1[8 * sp + 3]); pw.z = cvtpk(s1[8 * sp + 4], s1[8 * sp + 5]); pw.w = cvtpk(s1[8 * sp + 6], s1[8 * sp + 7]); }
                const bf16x8 pf = __builtin_bit_cast(bf16x8, pw);
                const int keybase = 64 * stp + 32 * sub + 16 * sp;
                const char* va = vbase + keybase * 64;
                const s16x4 a0 = tr_read(va), a1 = tr_read(va + 512);
                const s16x4 b0 = tr_read(va + AT_VPLANE), b1 = tr_read(va + AT_VPLANE + 512);
                const bf16x8 vf0 = (bf16x8){a0[0], a0[1], a0[2], a0[3], a1[0], a1[1], a1[2], a1[3]};
                const bf16x8 vf1 = (bf16x8){b0[0], b0[1], b0[2], b0[3], b1[0], b1[1], b1[2], b1[3]};
                o0 = MFMA32(pf, vf0, o0); o1 = MFMA32(pf, vf1, o1);
            }
    }
    st.mhat = mhat; st.l = l; st.o0 = o0; st.o1 = o1;
}
DEVINL float half_sum(float v) { auto rr = __builtin_amdgcn_permlane32_swap(__float_as_uint(v), __float_as_uint(v), false, false); return __uint_as_float(rr[0]) + __uint_as_float(rr[1]); }
DEVINL void rows_to_regs(float v, float* wsf, float (&out)[16]) {
    const int lane = threadIdx.x & 63, r32 = lane & 31, hi = lane >> 5;
    LDS_WAIT();
    if (hi == 0) wsf[r32] = v;
    LDS_WAIT();
#pragma unroll
    for (int g = 0; g < 4; ++g) { const f32x4 fv = *(const f32x4*)(wsf + 8 * g + 4 * hi); out[4 * g] = fv.x; out[4 * g + 1] = fv.y; out[4 * g + 2] = fv.z; out[4 * g + 3] = fv.w; }
    LDS_WAIT();
}
DEVINL void build_lut(float* lut, const float* rel_bias, int col) {
    const int tid = threadIdx.x;
    if (tid < 128) lut[tid] = rel_bias[rel_bucket(tid) * 12 + col] * LOG2E;
}

DEVINL void moba_select_item(const Params& p, char* lds, int item) {
    const int tid = threadIdx.x;
    const int b = item / (HA * 16), h = (item / 16) % HA, t = (item % 16) * 512 + tid, own = t >> 8;
    float* km = (float*)lds;
    unsigned* lcnt = (unsigned*)(lds + 8192);
    unsigned* lbase = lcnt + 32;
    const float* KMEAN = (const float*)(p.ws + WS_KMEAN);
    for (int i = tid; i < 2048; i += NTHR) km[i] = KMEAN[(size_t)(b * 32 + (i >> 6)) * 384 + h * 64 + (i & 63)];
    if (tid < 32) lcnt[tid] = 0u;
    __syncthreads();
    const bf16_t* q = (const bf16_t*)(p.ws + WS_ACT8) + (size_t)(b * SEQ + t) * 384 + h * 64;
    float qv[64];
#pragma unroll
    for (int c = 0; c < 8; ++c) {
        const u32x4 w = *(const u32x4*)(q + c * 8);
        qv[8 * c + 0] = bf_lo(w.x); qv[8 * c + 1] = bf_hi(w.x); qv[8 * c + 2] = bf_lo(w.y); qv[8 * c + 3] = bf_hi(w.y);
        qv[8 * c + 4] = bf_lo(w.z); qv[8 * c + 5] = bf_hi(w.z); qv[8 * c + 6] = bf_lo(w.w); qv[8 * c + 7] = bf_hi(w.w);
    }
    float v0 = -INFINITY, v1 = -INFINITY, v2 = -INFINITY; int i0 = 0, i1 = 1, i2 = 2;
    const int nmax = (((item % 16) * 512 + 511) >> 8);
#pragma unroll 1
    for (int n = 0; n < nmax; ++n) {
        float g = 0.f;
#pragma unroll
        for (int c = 0; c < 16; ++c) { const f32x4 kv = *(const f32x4*)(km + n * 64 + 4 * c); g += qv[4 * c] * kv.x + qv[4 * c + 1] * kv.y + qv[4 * c + 2] * kv.z + qv[4 * c + 3] * kv.w; }
        if (n < own) {
            if (g > v0) { v2 = v1; i2 = i1; v1 = v0; i1 = i0; v0 = g; i0 = n; }
            else if (g > v1) { v2 = v1; i2 = i1; v1 = g; i1 = n; }
            else if (g > v2) { v2 = g; i2 = n; }
        }
    }
    const int nsel = own < 3 ? own : 3;
    unsigned o0 = 0, o1 = 0, o2 = 0;
    if (nsel > 0) o0 = atomicAdd(&lcnt[i0], 1u);
    if (nsel > 1) o1 = atomicAdd(&lcnt[i1], 1u);
    if (nsel > 2) o2 = atomicAdd(&lcnt[i2], 1u);
    __syncthreads();
    unsigned* gcnt = (unsigned*)(p.ws + WS_CTL) + (b * HA + h) * 32;
    if (tid < 32) lbase[tid] = lcnt[tid] ? atomicAdd(&gcnt[tid], lcnt[tid]) : 0u;
    __syncthreads();
    bf16_t* L = (bf16_t*)(p.ws + WS_LIST) + (size_t)(b * HA + h) * LIST_PER_BH;
    if (nsel > 0) L[list_off(i0) + lbase[i0] + o0] = (bf16_t)(t | (0 << 13));
    if (nsel > 1) L[list_off(i1) + lbase[i1] + o1] = (bf16_t)(t | (1 << 13));
    if (nsel > 2) L[list_off(i2) + lbase[i2] + o2] = (bf16_t)(t | (2 << 13));
    __syncthreads();
}

DEVINL void mem_attn_item(const Params& p, char* lds, int item) {
    const int tid = threadIdx.x, lane = tid & 63, wave = tid >> 6, r32 = lane & 31, hi = lane >> 5;
    const int b = item / (HM * 32), h = (item / 32) % HM, qt = item % 32;
    float* wsf = (float*)(lds + AT_END) + wave * 32;
    char* ostg = lds + AT_END + 1024 + wave * 4096;
    load_kv_block((const bf16_t*)(p.ws + WS_MK) + (size_t)b * 256 * 256 + h * 64, (const bf16_t*)(p.ws + WS_MV) + (size_t)b * 256 * 256 + h * 64, 256, lds);
    const size_t row0 = (size_t)b * SEQ + qt * 256 + wave * 32;
    bf16_t* QM = (bf16_t*)(p.ws + WS_QM);
    bf16x8 qf[4];
#pragma unroll
    for (int s = 0; s < 4; ++s) qf[s] = *(const bf16x8*)(QM + (row0 + r32) * 256 + h * 64 + 16 * s + 8 * hi);
    __syncthreads();
    AttnState st;
    attn_256<0>(qf, lds, 0, 0, nullptr, wsf, st);
    const float ltot = half_sum(st.l);
    float rl[16]; rows_to_regs(1.f / ltot, wsf, rl);
#pragma unroll
    for (int r = 0; r < 16; ++r) {
        *(bf16_t*)(ostg + crow(r, hi) * 128 + r32 * 2) = (bf16_t)(cvtpk(st.o0[r] * rl[r], 0.f) & 0xffffu);
        *(bf16_t*)(ostg + crow(r, hi) * 128 + (32 + r32) * 2) = (bf16_t)(cvtpk(st.o1[r] * rl[r], 0.f) & 0xffffu);
    }
    LDS_WAIT();
    const bf16_t* ZM = (const bf16_t*)(p.ws + WS_ZM);
#pragma unroll
    for (int i = 0; i < 4; ++i) {
        const int row = i * 8 + (lane >> 3), ch = lane & 7;
        const u32x4 ov = *(const u32x4*)(ostg + row * 128 + ch * 16);
        const u32x4 zv = *(const u32x4*)(ZM + (row0 + row) * 256 + h * 64 + ch * 8);
        u32x4 w;
        w.x = cvtpk(bf_lo(ov.x) * bf_lo(zv.x), bf_hi(ov.x) * bf_hi(zv.x)); w.y = cvtpk(bf_lo(ov.y) * bf_lo(zv.y), bf_hi(ov.y) * bf_hi(zv.y));
        w.z = cvtpk(bf_lo(ov.z) * bf_lo(zv.z), bf_hi(ov.z) * bf_hi(zv.z)); w.w = cvtpk(bf_lo(ov.w) * bf_lo(zv.w), bf_hi(ov.w) * bf_hi(zv.w));
        *(u32x4*)(QM + (row0 + row) * 256 + h * 64 + ch * 8) = w;
    }
    __syncthreads();
}

DEVINL unsigned score_key(float s) { unsigned u = __float_as_uint(s); if ((u << 1) == 0u) u = 0u; return (u & 0x80000000u) ? ~u : (u | 0x80000000u); }
constexpr int IX_C = 0, IX_HIST = 1024;
DEVINL void indexer_item(const Params& p, char* lds, int item, float* scratch) {
    const int tid = threadIdx.x, lane = tid & 63, wave = tid >> 6, r32 = lane & 31, hi = lane >> 5;
    const int b = item >> 8, qt = 255 - (item & 255), t0 = qt * 32;
    bf16_t* IDX = (bf16_t*)(p.ws + WS_IDX) + ((size_t)b * SEQ + t0) * 256;
    if (t0 + 31 >= 256) {
        float* cl = (float*)(lds + IX_C);
        if (tid < 256) cl[tid] = ((const float*)(p.ws + WS_IW))[((size_t)b * SEQ + t0) * 8 + tid];
        const bf16_t* IQ = (const bf16_t*)(p.ws + WS_IQ) + ((size_t)b * SEQ + t0) * 512;
        const bf16_t* IK = (const bf16_t*)(p.ws + WS_IK) + (size_t)b * SEQ * 64;
        const int rbh = wave >> 2, kw = wave & 3;
        bf16x8 af[4][4];
#pragma unroll
        for (int rb = 0; rb < 4; ++rb)
#pragma unroll
            for (int s = 0; s < 4; ++s) af[rb][s] = *(const bf16x8*)(IQ + (size_t)(4 * (4 * rbh + rb) + (r32 >> 3)) * 512 + (r32 & 7) * 64 + 16 * s + 8 * hi);
        __syncthreads();
        const int nkt = (t0 + 32) / 32;
#pragma unroll 1
        for (int kt = kw; kt < nkt; kt += 4) {
            bf16x8 bf[4];
#pragma unroll
            for (int s = 0; s < 4; ++s) bf[s] = *(const bf16x8*)(IK + (size_t)(32 * kt + r32) * 64 + 16 * s + 8 * hi);
#pragma unroll
            for (int rb = 0; rb < 4; ++rb) {
                const int rbg = 4 * rbh + rb;
                f32x16 acc;
#pragma unroll
                for (int r = 0; r < 16; ++r) acc[r] = 0.f;
#pragma unroll
                for (int s = 0; s < 4; ++s) acc = MFMA32(af[rb][s], bf[s], acc);
                float pj[4];
#pragma unroll
                for (int j = 0; j < 4; ++j) {
                    const f32x4 cv = *(const f32x4*)(cl + (4 * rbg + j) * 8 + 4 * hi);
                    pj[j] = cv.x * fmaxf(acc[4 * j], 0.f) + cv.y * fmaxf(acc[4 * j + 1], 0.f) + cv.z * fmaxf(acc[4 * j + 2], 0.f) + cv.w * fmaxf(acc[4 * j + 3], 0.f);
                }
                auto r02 = __builtin_amdgcn_permlane32_swap(__float_as_uint(pj[0]), __float_as_uint(pj[2]), false, false);
                auto r13 = __builtin_amdgcn_permlane32_swap(__float_as_uint(pj[1]), __float_as_uint(pj[3]), false, false);
                const float sA = __uint_as_float(r02[0]) + __uint_as_float(r02[1]);
                const float sB = __uint_as_float(r13[0]) + __uint_as_float(r13[1]);
                scratch[(size_t)(4 * rbg + 2 * hi) * 8192 + 32 * kt + r32] = sA;
                scratch[(size_t)(4 * rbg + 2 * hi + 1) * 8192 + 32 * kt + r32] = sB;
            }
        }
        __threadfence_block();
        __syncthreads();
    }
    unsigned* hist = (unsigned*)(lds + IX_HIST) + wave * 2048;
#pragma unroll 1
    for (int rr = 0; rr < 4; ++rr) {
        const int row = 4 * wave + rr, t = t0 + row, n = t + 1;
        bf16_t* out = IDX + (size_t)row * 256;
        if (n <= 256) {
#pragma unroll
            for (int k = 0; k < 4; ++k) { const int i = lane + 64 * k; out[i] = (bf16_t)(i < n ? i : 0xFFFF); }
            continue;
        }
        const float* S = scratch + (size_t)row * 8192;
        unsigned prefix = 0u; int need = 256, shift = 32;
#pragma unroll 1
        for (int level = 0; level < 3; ++level) {
            const int bits = level < 2 ? 11 : 10;
            shift -= bits;
            const unsigned mask = (1u << bits) - 1u;
#pragma unroll
            for (int k = 0; k < 32; ++k) hist[lane + 64 * k] = 0u;
            LDS_WAIT();
            for (int i = lane; i < n; i += 64) {
                const unsigned u = score_key(S[i]);
                const bool match = (level == 0) ? true : ((u >> (shift + bits)) == prefix);
                if (match) atomicAdd(&hist[(u >> shift) & mask], 1u);
            }
            LDS_WAIT();
            unsigned c = 0;
#pragma unroll
            for (int k = 0; k < 8; ++k) { const u32x4 hv = *(const u32x4*)(hist + 32 * lane + 4 * k); c += (hv.x + hv.y) + (hv.z + hv.w); }
            unsigned suf = c;
#pragma unroll
            for (int o = 1; o < 64; o <<= 1) { const unsigned tv = __shfl_down(suf, o); if (lane + o < 64) suf += tv; }
            const unsigned long long bal = __ballot(suf >= (unsigned)need);
            const int Ls = 63 - __builtin_clzll(bal);
            const unsigned sufL = __shfl(suf, Ls), cL = __shfl(c, Ls);
            unsigned cum = sufL - cL; int digit = 0; unsigned cb = 0; bool found = false;
#pragma unroll 1
            for (int k = 31; k >= 0; --k) {
                const unsigned hv = hist[32 * Ls + k];
                if (!found) { if (cum + hv >= (unsigned)need) { digit = 32 * Ls + k; cb = hv; found = true; } else cum += hv; }
            }
            need -= (int)cum;
            prefix = (prefix << bits) | (unsigned)digit;
            if ((int)cb == need) break;
        }
        int base = 0, eqbase = 0;
        for (int i0 = 0; i0 < n; i0 += 64) {
            const int i = i0 + lane;
            bool gt = false, eq = false;
            if (i < n) { const unsigned u = score_key(S[i]); const unsigned hp = (shift >= 32) ? 0u : (u >> shift); gt = hp > prefix; eq = hp == prefix; }
            const unsigned long long beq = __ballot(eq);
            const unsigned long long lt = (1ull << lane) - 1ull;
            const bool sel = gt || (eq && (eqbase + __popcll(beq & lt) < need));
            const unsigned long long bs = __ballot(sel);
            if (sel) out[base + __popcll(bs & lt)] = (bf16_t)i;
            base += __popcll(bs); eqbase += __popcll(beq);
        }
    }
    __syncthreads();
}

DEVINL float dot2bf(unsigned a, unsigned b, float c) {
    typedef __bf16 bf2 __attribute__((ext_vector_type(2)));
    return __builtin_amdgcn_fdot2_f32_bf16(__builtin_bit_cast(bf2, a), __builtin_bit_cast(bf2, b), c, false);
}
DEVINL void dsa_item(const Params& p, char* lds, int item) {
    const int tid = threadIdx.x, lane = tid & 63, wave = tid >> 6, g = lane >> 3, j = lane & 7;
    const int pair = (item & 7) + 8 * (item >> 8), chunk = (item >> 3) & 31;
    const int b = pair / HB, h = pair % HB;
    float* lut = (float*)lds;
    float* pbuf = (float*)(lds + 512) + wave * 256;
    __syncthreads();
    build_lut(lut, p.rel_bias, 6 + h);
    __syncthreads();
    bf16_t* QB = (bf16_t*)(p.ws + WS_ACT8 + 4 * ACT_STRIDE);
    const bf16_t* KB = (const bf16_t*)(p.ws + WS_ACT8 + 5 * ACT_STRIDE) + (size_t)b * SEQ * 384 + h * 64 + 8 * j;
    const bf16_t* VB = (const bf16_t*)(p.ws + WS_ACT8 + 6 * ACT_STRIDE) + (size_t)b * SEQ * 384 + h * 64 + 8 * j;
    const bf16_t* ZB = (const bf16_t*)(p.ws + WS_ACT8 + 7 * ACT_STRIDE);
    const bf16_t* IDX = (const bf16_t*)(p.ws + WS_IDX);
#pragma unroll 1
    for (int qi = 0; qi < 32; ++qi) {
        const int t = chunk * 256 + wave * 32 + qi;
        const size_t row = (size_t)b * SEQ + t;
        const u32x4 qv = *(const u32x4*)(QB + row * 384 + h * 64 + 8 * j);
        const bf16_t* irow = IDX + row * 256 + g * 32;
        u32x4 iv[4];
#pragma unroll
        for (int k = 0; k < 4; ++k) iv[k] = *(const u32x4*)(irow + 8 * k);
        int myk[4];
#pragma unroll
        for (int bt = 0; bt < 4; ++bt) myk[bt] = irow[8 * bt + j];
        float lg[4];
#pragma unroll
        for (int bt = 0; bt < 4; ++bt) {
            float part[8];
#pragma unroll
            for (int i = 0; i < 8; ++i) {
                const int ii = 8 * bt + i;
                const unsigned w = (ii & 1) ? (iv[ii >> 3][(ii >> 1) & 3] >> 16) : (iv[ii >> 3][(ii >> 1) & 3] & 0xffffu);
                const int key = w == 0xFFFFu ? 0 : (int)w;
                const u32x4 kv = *(const u32x4*)(KB + (size_t)key * 384);
                part[i] = dot2bf(kv.w, qv.w, dot2bf(kv.z, qv.z, dot2bf(kv.y, qv.y, dot2bf(kv.x, qv.x, 0.f))));
            }
            float v4[4];
#pragma unroll
            for (int a = 0; a < 4; ++a) { const float keep = (j & 4) ? part[4 + a] : part[a], send = (j & 4) ? part[a] : part[4 + a]; v4[a] = keep + __shfl_xor(send, 4); }
            float v2[2];
#pragma unroll
            for (int a = 0; a < 2; ++a) { const float keep = (j & 2) ? v4[2 + a] : v4[a], send = (j & 2) ? v4[a] : v4[2 + a]; v2[a] = keep + __shfl_xor(send, 2); }
            { const float keep = (j & 1) ? v2[1] : v2[0], send = (j & 1) ? v2[0] : v2[1]; lg[bt] = keep + __shfl_xor(send, 1); }
        }
        float mx = -INFINITY;
#pragma unroll
        for (int bt = 0; bt < 4; ++bt) {
            const int d = t - myk[bt];
            lg[bt] = (myk[bt] == 0xFFFF || d < 0) ? -INFINITY : lg[bt] + lut[d > 127 ? 127 : d];
            mx = fmaxf(mx, lg[bt]);
        }
        mx = wave_max(mx);
        float ls = 0.f;
#pragma unroll
        for (int bt = 0; bt < 4; ++bt) { lg[bt] = fexp2(lg[bt] - mx); ls += lg[bt]; pbuf[g * 32 + 8 * bt + j] = lg[bt]; }
        ls = wave_sum(ls);
        LDS_WAIT();
        float acc[8];
#pragma unroll
        for (int e = 0; e < 8; ++e) acc[e] = 0.f;
#pragma unroll
        for (int k = 0; k < 4; ++k) {
            const f32x4 pa = *(const f32x4*)(pbuf + g * 32 + 8 * k), pb = *(const f32x4*)(pbuf + g * 32 + 8 * k + 4);
            const float pp[8] = {pa.x, pa.y, pa.z, pa.w, pb.x, pb.y, pb.z, pb.w};
#pragma unroll
            for (int i2 = 0; i2 < 4; ++i2) {
                const unsigned wpair = iv[k][i2];
                const unsigned w0 = wpair & 0xffffu, w1 = wpair >> 16;
                const int key0 = w0 == 0xFFFFu ? 0 : (int)w0, key1 = w1 == 0xFFFFu ? 0 : (int)w1;
                const u32x4 va = *(const u32x4*)(VB + (size_t)key0 * 384), vb = *(const u32x4*)(VB + (size_t)key1 * 384);
                const unsigned ppk = cvtpk(pp[2 * i2], pp[2 * i2 + 1]);
#pragma unroll
                for (int w = 0; w < 4; ++w) {
                    const unsigned lo = __builtin_amdgcn_perm(vb[w], va[w], 0x05040100u), hh = __builtin_amdgcn_perm(vb[w], va[w], 0x07060302u);
                    acc[2 * w] = dot2bf(lo, ppk, acc[2 * w]); acc[2 * w + 1] = dot2bf(hh, ppk, acc[2 * w + 1]);
                }
            }
        }
        LDS_WAIT();
        float a4[4];
#pragma unroll
        for (int a = 0; a < 4; ++a) { const float keep = (g & 4) ? acc[4 + a] : acc[a], send = (g & 4) ? acc[a] : acc[4 + a]; a4[a] = keep + __shfl_xor(send, 32); }
        float a2[2];
#pragma unroll
        for (int a = 0; a < 2; ++a) { const float keep = (g & 2) ? a4[2 + a] : a4[a], send = (g & 2) ? a4[a] : a4[2 + a]; a2[a] = keep + __shfl_xor(send, 16); }
        float a1;
        { const float keep = (g & 1) ? a2[1] : a2[0], send = (g & 1) ? a2[0] : a2[1]; a1 = keep + __shfl_xor(send, 8); }
        const int dim = 8 * j + g;
        const float z = bf2f(ZB[row * 384 + h * 64 + dim]);
        QB[row * 384 + h * 64 + dim] = (bf16_t)(cvtpk(a1 / ls * z, 0.f) & 0xffffu);
    }
}

DEVINL void moba_past_item(const Params& p, char* lds, int b, int h, int n, int c, int cnt) {
    const int tid = threadIdx.x, lane = tid & 63, wave = tid >> 6, r32 = lane & 31, hi = lane >> 5;
    float* lut = (float*)(lds + AT_END);
    float* wsf = (float*)(lds + AT_END + 512) + wave * 32;
    bf16_t* ent = (bf16_t*)(lds + AT_END + 1536);
    char* ostg = lds + AT_END + 2048 + wave * 4096;
    const bf16_t* L = (const bf16_t*)(p.ws + WS_LIST) + (size_t)(b * HA + h) * LIST_PER_BH + list_off(n) + c * 256;
    __syncthreads();
    const int nvalid = cnt - c * 256 < 256 ? cnt - c * 256 : 256;
    if (tid < 256) ent[tid] = tid < nvalid ? L[tid] : L[0];
    build_lut(lut, p.rel_bias, h);
    load_kv_block((const bf16_t*)(p.ws + WS_ACT8 + 1 * ACT_STRIDE) + ((size_t)b * SEQ + n * 256) * 384 + h * 64,
                  (const bf16_t*)(p.ws + WS_ACT8 + 2 * ACT_STRIDE) + ((size_t)b * SEQ + n * 256) * 384 + h * 64, 384, lds);
    __syncthreads();
    if (wave * 32 < nvalid) {
        const int e = ent[wave * 32 + r32], t_row = e & 8191;
        const bf16_t* QA = (const bf16_t*)(p.ws + WS_ACT8);
        bf16x8 qf[4];
#pragma unroll
        for (int s = 0; s < 4; ++s) qf[s] = *(const bf16x8*)(QA + ((size_t)b * SEQ + t_row) * 384 + h * 64 + 16 * s + 8 * hi);
        AttnState st;
        attn_256<1>(qf, lds, t_row, n * 256, lut, wsf, st);
        const float ltot = half_sum(st.l);
        float rl[16]; rows_to_regs(1.f / ltot, wsf, rl);
#pragma unroll
        for (int r = 0; r < 16; ++r) {
            *(bf16_t*)(ostg + crow(r, hi) * 128 + r32 * 2) = (bf16_t)(cvtpk(st.o0[r] * rl[r], 0.f) & 0xffffu);
            *(bf16_t*)(ostg + crow(r, hi) * 128 + (32 + r32) * 2) = (bf16_t)(cvtpk(st.o1[r] * rl[r], 0.f) & 0xffffu);
        }
        LDS_WAIT();
        bf16_t* PO = (bf16_t*)(p.ws + WS_PO);
        float* PL = (float*)(p.ws + WS_PL);
        if (hi == 0 && wave * 32 + r32 < nvalid) PL[(((size_t)b * SEQ + t_row) * HA + h) * 4 + (e >> 13)] = st.mhat + __builtin_amdgcn_logf(ltot);
#pragma unroll
        for (int i = 0; i < 4; ++i) {
            const int row = i * 8 + (lane >> 3), ch = lane & 7;
            if (wave * 32 + row < nvalid) {
                const int e2 = ent[wave * 32 + row];
                *(u32x4*)(PO + ((((size_t)b * SEQ + (e2 & 8191)) * HA + h) * 4 + (e2 >> 13)) * 64 + ch * 8) = *(const u32x4*)(ostg + row * 128 + ch * 16);
            }
        }
    }
    __syncthreads();
}

DEVINL void moba_own_item(const Params& p, char* lds, int item) {
    const int tid = threadIdx.x, lane = tid & 63, wave = tid >> 6, r32 = lane & 31, hi = lane >> 5;
    const int b = item / (HA * 32), h = (item / 32) % HA, n = item % 32;
    float* lut = (float*)(lds + AT_END);
    float* wsf = (float*)(lds + AT_END + 512) + wave * 32;
    float* lse_own = (float*)(lds + AT_END + 1536);
    float* oown = (float*)lds;
    __syncthreads();
    build_lut(lut, p.rel_bias, h);
    const size_t row0 = (size_t)b * SEQ + n * 256;
    load_kv_block((const bf16_t*)(p.ws + WS_ACT8 + 1 * ACT_STRIDE) + row0 * 384 + h * 64, (const bf16_t*)(p.ws + WS_ACT8 + 2 * ACT_STRIDE) + row0 * 384 + h * 64, 384, lds);
    bf16_t* QA = (bf16_t*)(p.ws + WS_ACT8);
    const int t_row = n * 256 + wave * 32 + r32;
    bf16x8 qf[4];
#pragma unroll
    for (int s = 0; s < 4; ++s) qf[s] = *(const bf16x8*)(QA + ((size_t)b * SEQ + t_row) * 384 + h * 64 + 16 * s + 8 * hi);
    __syncthreads();
    AttnState st;
    attn_256<1>(qf, lds, t_row, n * 256, lut, wsf, st);
    const float ltot = half_sum(st.l);
    float rl[16]; rows_to_regs(1.f / ltot, wsf, rl);
    __syncthreads();
    if (hi == 0) lse_own[wave * 32 + r32] = st.mhat + __builtin_amdgcn_logf(ltot);
#pragma unroll
    for (int r = 0; r < 16; ++r) {
        oown[(wave * 32 + crow(r, hi)) * 64 + r32] = st.o0[r] * rl[r];
        oown[(wave * 32 + crow(r, hi)) * 64 + 32 + r32] = st.o1[r] * rl[r];
    }
    __syncthreads();
    const bf16_t* PO = (const bf16_t*)(p.ws + WS_PO);
    const float* PL = (const float*)(p.ws + WS_PL);
    const bf16_t* ZA = (const bf16_t*)(p.ws + WS_ACT8 + 3 * ACT_STRIDE);
    const int nsel = n < 3 ? n : 3;
#pragma unroll 1
    for (int k = 0; k < 4; ++k) {
        const int task = tid + 512 * k, row = task >> 3, ch = task & 7;
        const size_t grow = row0 + row;
        const float lo = lse_own[row];
        float ls[3]; float M = lo;
#pragma unroll
        for (int s = 0; s < 3; ++s) { ls[s] = (s < nsel) ? PL[(grow * HA + h) * 4 + s] : -INFINITY; M = fmaxf(M, ls[s]); }
        const float w_own = fexp2(lo - M);
        float wsum = w_own, o[8];
#pragma unroll
        for (int e = 0; e < 8; ++e) o[e] = w_own * oown[row * 64 + ch * 8 + e];
#pragma unroll
        for (int s = 0; s < 3; ++s) {
            if (s < nsel) {
                const float w = fexp2(ls[s] - M); wsum += w;
                const u32x4 pv = *(const u32x4*)(PO + ((grow * HA + h) * 4 + s) * 64 + ch * 8);
                o[0] += w * bf_lo(pv.x); o[1] += w * bf_hi(pv.x); o[2] += w * bf_lo(pv.y); o[3] += w * bf_hi(pv.y);
                o[4] += w * bf_lo(pv.z); o[5] += w * bf_hi(pv.z); o[6] += w * bf_lo(pv.w); o[7] += w * bf_hi(pv.w);
            }
        }
        const float inv = 1.f / wsum;
        const u32x4 zv = *(const u32x4*)(ZA + grow * 384 + h * 64 + ch * 8);
        u32x4 w;
        w.x = cvtpk(o[0] * inv * bf_lo(zv.x), o[1] * inv * bf_hi(zv.x)); w.y = cvtpk(o[2] * inv * bf_lo(zv.y), o[3] * inv * bf_hi(zv.y));
        w.z = cvtpk(o[4] * inv * bf_lo(zv.z), o[5] * inv * bf_hi(zv.z)); w.w = cvtpk(o[6] * inv * bf_lo(zv.w), o[7] * inv * bf_hi(zv.w));
        *(u32x4*)(QA + grow * 384 + h * 64 + ch * 8) = w;
    }
    __syncthreads();
}

DEVINL void phase2(const Params& p, char* lds) {
#ifndef SKIP2A
    if (blockIdx.x < 256) {
        const int slot = blockIdx.x;
        float* scratch = slot < 192 ? (float*)(p.ws + WS_GATES + (size_t)slot * MiB) : (float*)((char*)p.out + 64 * MiB + (size_t)(slot - 192) * MiB);
        const int nslots = gridDim.x < 256 ? gridDim.x : 256;
        for (int it = slot; it < NB * 256; it += nslots) indexer_item(p, lds, it, scratch);
    }
    __syncthreads();
#endif
#ifndef SKIP2B
    for (int it = blockIdx.x; it < NB * HA * 16; it += gridDim.x) moba_select_item(p, lds, it);
#endif
    for (int it = blockIdx.x; it < NB * HM * 32; it += gridDim.x) mem_attn_item(p, lds, it);
}
DEVINL void phase3(const Params& p, char* lds) {
    for (int it = blockIdx.x; it < 768; it += gridDim.x) dsa_item(p, lds, it);
    const unsigned* ctl = (const unsigned*)(p.ws + WS_CTL);
    unsigned* pre = (unsigned*)(lds + AT_END + 2048 + 8 * 4096);
    __syncthreads();
    for (int i = threadIdx.x; i < 744; i += NTHR) pre[i + 1] = (ctl[(i / 31) * 32 + (i % 31)] + 255u) >> 8;
    __syncthreads();
    if (threadIdx.x == 0) { unsigned a = 0; pre[0] = 0; for (int i = 1; i <= 744; ++i) { a += pre[i]; pre[i] = a; } }
    __syncthreads();
    const int total = (int)pre[744];
    for (int ri = blockIdx.x; ri < total; ri += gridDim.x) {
        int lo = 0, hi2 = 744;
        while (hi2 - lo > 1) { const int mid = (lo + hi2) >> 1; if ((int)pre[mid] <= ri) lo = mid; else hi2 = mid; }
        const int bh = lo / 31, n = lo % 31, c = ri - (int)pre[lo];
        moba_past_item(p, lds, bh / HA, bh % HA, n, c, (int)ctl[bh * 32 + n]);
    }
}
DEVINL void phase4(const Params& p, char* lds) {
    for (int it = blockIdx.x; it < NB * HA * 32; it += gridDim.x) moba_own_item(p, lds, it);
}

constexpr int LDS_BYTES = 106496;
#define KERNEL_PROLOGUE __shared__ __attribute__((aligned(16))) char lds[LDS_BYTES];
#ifdef MULTI_LAUNCH
__global__ void __launch_bounds__(NTHR) k_phase0(Params p) { KERNEL_PROLOGUE phase0(p, lds); }
__global__ void __launch_bounds__(NTHR) k_phase1(Params p) { KERNEL_PROLOGUE phase1(p, lds); }
__global__ void __launch_bounds__(NTHR) k_phase2(Params p) { KERNEL_PROLOGUE phase2(p, lds); }
__global__ void __launch_bounds__(NTHR) k_phase3(Params p) { KERNEL_PROLOGUE phase3(p, lds); }
__global__ void __launch_bounds__(NTHR) k_phase4(Params p) { KERNEL_PROLOGUE phase4(p, lds); }
__global__ void __launch_bounds__(NTHR) k_phase5(Params p) { KERNEL_PROLOGUE phase_gates(p, lds); }
__global__ void __launch_bounds__(NTHR) k_phase6(Params p) { KERNEL_PROLOGUE phase_merge(p, lds); }
__global__ void __launch_bounds__(NTHR) k_phase7(Params p) { KERNEL_PROLOGUE phase_out(p, lds); }
__global__ void __launch_bounds__(NTHR) k_phase8(Params p) { phase_final(p); }
#else
__global__ void __launch_bounds__(NTHR) k_mega(Params p) {
    KERNEL_PROLOGUE
    cg::grid_group grid = cg::this_grid();
    phase0(p, lds);      grid.sync();
    phase1(p, lds);      grid.sync();
    phase2(p, lds);      grid.sync();
    phase3(p, lds);      grid.sync();
    phase4(p, lds);      grid.sync();
    phase_gates(p, lds); grid.sync();
    phase_merge(p, lds); grid.sync();
    phase_out(p, lds);   grid.sync();
    phase_final(p);
}
#endif

extern "C" void kernel_launch(void* const* d_in, const int* in_sizes, int n_in, void* d_out, int out_size, void* d_ws, size_t ws_size, hipStream_t stream) {
    Params p{};
    p.x = (const float*)d_in[0]; p.mem = (const float*)d_in[1]; p.norm_gain = (const float*)d_in[2]; p.w_in = (const float*)d_in[3];
    p.rel_bias = (const float*)d_in[4]; p.mem_gain = (const float*)d_in[5]; p.w_mem_kv = (const float*)d_in[6]; p.w_branch = (const float*)d_in[7];
    p.w_out = (const float*)d_in[8]; p.final_gain = (const float*)d_in[9];
    p.out = (float*)d_out; p.ws = (unsigned char*)d_ws;
#ifdef MULTI_LAUNCH
    const int G = 256;
    hipLaunchKernelGGL(k_phase0, dim3(G), dim3(NTHR), 0, stream, p);
    hipLaunchKernelGGL(k_phase1, dim3(G), dim3(NTHR), 0, stream, p);
    hipLaunchKernelGGL(k_phase2, dim3(G), dim3(NTHR), 0, stream, p);
    hipLaunchKernelGGL(k_phase3, dim3(G), dim3(NTHR), 0, stream, p);
    hipLaunchKernelGGL(k_phase4, dim3(G), dim3(NTHR), 0, stream, p);
    hipLaunchKernelGGL(k_phase5, dim3(G), dim3(NTHR), 0, stream, p);
    hipLaunchKernelGGL(k_phase6, dim3(G), dim3(NTHR), 0, stream, p);
    hipLaunchKernelGGL(k_phase7, dim3(G), dim3(NTHR), 0, stream, p);
    hipLaunchKernelGGL(k_phase8, dim3(G), dim3(NTHR), 0, stream, p);
#else
    static int grid = 0;
    if (!grid) {
        int dev = 0, cus = 0, per_cu = 0;
        (void)hipGetDevice(&dev);
        (void)hipDeviceGetAttribute(&cus, hipDeviceAttributeMultiprocessorCount, dev);
        (void)hipOccupancyMaxActiveBlocksPerMultiprocessor(&per_cu, (const void*)k_mega, NTHR, 0);
        if (per_cu < 1) { fprintf(stderr, "kernel_launch: occupancy query says %d blocks/CU\n", per_cu); per_cu = 1; }
        grid = cus;
        if (ws_size < WS_END) fprintf(stderr, "kernel_launch: workspace too small: %zu < %zu\n", ws_size, (size_t)WS_END);
    }
    void* args[] = {&p};
    hipError_t e = hipLaunchCooperativeKernel((const void*)k_mega, dim3(grid), dim3(NTHR), args, 0, stream);
    if (e != hipSuccess) fprintf(stderr, "kernel_launch: cooperative launch failed: %s (grid %d)\n", hipGetErrorString(e), grid);
#endif
}
```

```cpp
#include <hip/hip_runtime.h>
#include <hip/hip_cooperative_groups.h>
#include <stdint.h>
#include <stdio.h>
namespace cg = cooperative_groups;

#define DEVINL __device__ __forceinline__
#define LAS __attribute__((address_space(3)))

typedef unsigned short bf16_t;
typedef short bf16x8 __attribute__((ext_vector_type(8)));
typedef short s16x4 __attribute__((ext_vector_type(4)));
typedef float f32x16 __attribute__((ext_vector_type(16)));
typedef float f32x4 __attribute__((ext_vector_type(4)));
typedef unsigned u32x4 __attribute__((ext_vector_type(4)));
typedef unsigned u32x2 __attribute__((ext_vector_type(2)));

constexpr int NB = 4, SEQ = 8192, DM = 1024, NT = NB * SEQ;
constexpr int HD = 64, HA = 6, HB = 6, HM = 4, WA = 384, WB = 384, WM = 256;
constexpr int NMEM = 256, INW = 7240;
constexpr int NWIN = 7296;
constexpr int NG1 = 33;
constexpr int GATE0 = 4224;
constexpr float EPS = 1e-6f;
constexpr float LOG2E = 1.4426950408889634f;
constexpr float QSCALE = 0.125f * LOG2E;
constexpr float CSCALE = 0.35355339059327373f * 0.125f;
constexpr int NTHR = 512;

constexpr size_t MiB = 1u << 20;
constexpr size_t WS_CTL = 0, WS_WIN = 1 * MiB, WS_WBR = 16 * MiB, WS_WOUT = 18 * MiB, WS_WMEM = 20 * MiB, WS_MEMN = 21 * MiB,
                 WS_MK = 23 * MiB, WS_MV = 23 * MiB + 512 * 1024, WS_KMEAN = 24 * MiB, WS_IW = 25 * MiB, WS_IK = 26 * MiB,
                 WS_LIST = 30 * MiB, WS_IDX = 36 * MiB, WS_IQ = 52 * MiB, WS_QM = 84 * MiB, WS_ZM = 100 * MiB, WS_ACT8 = 116 * MiB,
                 WS_GATES = 308 * MiB, WS_SSQ = 500 * MiB, WS_END = 501 * MiB;
constexpr size_t ACT_STRIDE = (size_t)NT * 384 * 2;
constexpr size_t WS_MERGED = WS_ACT8 + ACT_STRIDE;
constexpr size_t WS_PO = WS_GATES, WS_PL = WS_GATES + 96 * MiB;
constexpr int CTL_WORDS = 2048, CTL_QUEUE = 1024, CTL_XBAR = 8192, XCD_BAR_WORDS = 3456;
constexpr int LIST_PER_BH = 126976;

struct Params {
    const float *x, *mem, *norm_gain, *w_in, *rel_bias, *mem_gain, *w_mem_kv, *w_branch, *w_out, *final_gain;
    float* out; unsigned char* ws;
};

typedef __bf16 bf16x2_t __attribute__((ext_vector_type(2)));
DEVINL unsigned cvtpk(float lo, float hi) { bf16x2_t v; v.x = (__bf16)lo; v.y = (__bf16)hi; return __builtin_bit_cast(unsigned, v); }
DEVINL float bf_lo(unsigned u) { return __uint_as_float(u << 16); }
DEVINL float bf_hi(unsigned u) { return __uint_as_float(u & 0xffff0000u); }
DEVINL float bf2f(bf16_t b) { return __uint_as_float(((unsigned)b) << 16); }
DEVINL float wave_sum(float v) {
#pragma unroll
    for (int o = 1; o < 64; o <<= 1) v += __shfl_xor(v, o);
    return v;
}
DEVINL float wave_max(float v) {
#pragma unroll
    for (int o = 1; o < 64; o <<= 1) v = fmaxf(v, __shfl_xor(v, o));
    return v;
}
DEVINL float fexp2(float x) { return __builtin_amdgcn_exp2f(x); }
DEVINL float fsigm(float z) { return 1.f / (1.f + fexp2(-z * LOG2E)); }
DEVINL float fsilu(float z) { return z * fsigm(z); }
#define LDS_WAIT() asm volatile("s_waitcnt lgkmcnt(0)" ::: "memory")
#define MFMA32(a, b, c) __builtin_amdgcn_mfma_f32_32x32x16_bf16(a, b, c, 0, 0, 0)
DEVINL int crow(int r, int hi) { return (r & 3) + 8 * (r >> 2) + 4 * hi; }
DEVINL int rel_bucket(int d) {
    if (d < 16) return d;
    return 16 + (d >= 19) + (d >= 21) + (d >= 24) + (d >= 27) + (d >= 31) + (d >= 35) + (d >= 40) + (d >= 46) + (d >= 52) + (d >= 59) +
           (d >= 67) + (d >= 77) + (d >= 87) + (d >= 99) + (d >= 113);
}
DEVINL int list_off(int n) { return 8192 * n - 128 * n * (n + 1); }

DEVINL int win_srccol(int n) {
    if (n < 3584) return n;
    if (n < 3840) return n - 3584 + 3656;
    if (n < 4096) return n - 3840 + 3912;
    if (n < 4160) return n - 4096 + 3584;
    if (n < 4168) return n - 4160 + 3648;
    if (n < GATE0) return -1;
    return n - GATE0 + 4168;
}
template <int KIND>
DEVINL void p0_transpose_item(const float* __restrict__ W, int ldw, const float* __restrict__ gain, bf16_t* WT, int K, int item, int nblk, float* scr, int lane) {
    const int kb = item / nblk, nb = item % nblk, k0 = kb * 64, n0 = nb * 32;
    const int n = n0 + (lane & 31);
    const int sc = (KIND == 0) ? win_srccol(n) : n;
#pragma unroll 8
    for (int i = 0; i < 32; ++i) {
        const int kk = 2 * i + (lane >> 5);
        float v = 0.f;
        if (sc >= 0) v = W[(size_t)(k0 + kk) * ldw + sc];
        if (gain) v *= gain[k0 + kk];
        scr[kk * 33 + (lane & 31)] = v;
    }
    LDS_WAIT();
    const int c = lane & 7;
#pragma unroll
    for (int j = 0; j < 4; ++j) {
        const int nn = (lane >> 3) + 8 * j;
        const float* s = scr + (8 * c) * 33 + nn;
        u32x4 o;
        o.x = cvtpk(s[0 * 33], s[1 * 33]); o.y = cvtpk(s[2 * 33], s[3 * 33]); o.z = cvtpk(s[4 * 33], s[5 * 33]); o.w = cvtpk(s[6 * 33], s[7 * 33]);
        *(u32x4*)(WT + (size_t)(n0 + nn) * K + k0 + 8 * c) = o;
    }
    LDS_WAIT();
}
DEVINL void norm_row_bf16(const float* xrow, bf16_t* orow, int lane) {
    const f32x4* xr = (const f32x4*)xrow + lane;
    f32x4 v[4]; float s = 0.f;
#pragma unroll
    for (int j = 0; j < 4; ++j) { v[j] = xr[64 * j]; s += (v[j].x * v[j].x + v[j].y * v[j].y) + (v[j].z * v[j].z + v[j].w * v[j].w); }
    const float rstd = rsqrtf(wave_sum(s) * (1.f / DM) + EPS);
    u32x2* o8 = (u32x2*)orow + lane;
#pragma unroll
    for (int j = 0; j < 4; ++j) { u32x2 w; w.x = cvtpk(v[j].x * rstd, v[j].y * rstd); w.y = cvtpk(v[j].z * rstd, v[j].w * rstd); o8[64 * j] = w; }
}
DEVINL void phase0(const Params& p, char* lds) {
    const int tid = threadIdx.x, lane = tid & 63, wave = tid >> 6;
    const int gw = blockIdx.x * 8 + wave, NGW = gridDim.x * 8;
    unsigned* ctl = (unsigned*)(p.ws + WS_CTL);
    for (int i = blockIdx.x * NTHR + tid; i < CTL_WORDS + XCD_BAR_WORDS; i += gridDim.x * NTHR) ctl[i < CTL_WORDS ? i : CTL_XBAR + (i - CTL_WORDS)] = 0u;
    bf16_t* XN = (bf16_t*)p.out;
    bf16_t* MEMN = (bf16_t*)(p.ws + WS_MEMN);
    for (int r = gw; r < NT + NB * NMEM; r += NGW) {
        if (r < NT) norm_row_bf16(p.x + (size_t)r * DM, XN + (size_t)r * DM, lane);
        else norm_row_bf16(p.mem + (size_t)(r - NT) * DM, MEMN + (size_t)(r - NT) * DM, lane);
    }
    float* scr = (float*)(lds + wave * 8448);
    constexpr int I_WIN = 16 * (NWIN / 32), I_BR = 16 * 32, I_OUT = 16 * 32, I_MEM = 16 * 16;
    for (int it = gw; it < I_WIN + I_BR + I_OUT + I_MEM; it += NGW) {
        int r = it;
        if (r < I_WIN) { p0_transpose_item<0>(p.w_in, INW, p.norm_gain, (bf16_t*)(p.ws + WS_WIN), DM, r, NWIN / 32, scr, lane); continue; } r -= I_WIN;
        if (r < I_BR) { p0_transpose_item<1>(p.w_branch, DM, nullptr, (bf16_t*)(p.ws + WS_WBR), DM, r, 32, scr, lane); continue; } r -= I_BR;
        if (r < I_OUT) { p0_transpose_item<1>(p.w_out, DM, nullptr, (bf16_t*)(p.ws + WS_WOUT), DM, r, 32, scr, lane); continue; } r -= I_OUT;
        p0_transpose_item<1>(p.w_mem_kv, 512, p.mem_gain, (bf16_t*)(p.ws + WS_WMEM), DM, r, 16, scr, lane);
    }
}

constexpr int G_STAGE = 49152, G_AOFF = 0, G_BOFF = 32768;
DEVINL int swz128(int row, int chunk) { return row * 128 + ((chunk ^ ((row >> 1) & 7)) << 4); }
DEVINL void gemm_tile(const bf16_t* __restrict__ A, int lda, const bf16_t* __restrict__ Bt, int ldb, int K, f32x16 (&acc)[2][2], char* lds) {
    const int tid = threadIdx.x, lane = tid & 63, wave = tid >> 6, wm = wave >> 1, wn = wave & 1, r32 = lane & 31, hi = lane >> 5;
    const int lr = tid >> 3, lc = tid & 7;
    const bf16_t* ga = A + (size_t)lr * lda + lc * 8;
    const bf16_t* gb = Bt + (size_t)lr * ldb + lc * 8;
    u32x4 ra[4], rb[2];
#pragma unroll
    for (int j = 0; j < 4; ++j) ra[j] = *(const u32x4*)(ga + (size_t)(64 * j) * lda);
#pragma unroll
    for (int j = 0; j < 2; ++j) rb[j] = *(const u32x4*)(gb + (size_t)(64 * j) * ldb);
#pragma unroll
    for (int j = 0; j < 4; ++j) *(u32x4*)(lds + G_AOFF + swz128(lr + 64 * j, lc)) = ra[j];
#pragma unroll
    for (int j = 0; j < 2; ++j) *(u32x4*)(lds + G_BOFF + swz128(lr + 64 * j, lc)) = rb[j];
    __syncthreads();
    const int nk = K / 64;
    for (int kt = 0; kt < nk; ++kt) {
        const char* st = lds + (kt & 1) * G_STAGE;
        if (kt + 1 < nk) {
#pragma unroll
            for (int j = 0; j < 4; ++j) ra[j] = *(const u32x4*)(ga + (size_t)(64 * j) * lda + (kt + 1) * 64);
#pragma unroll
            for (int j = 0; j < 2; ++j) rb[j] = *(const u32x4*)(gb + (size_t)(64 * j) * ldb + (kt + 1) * 64);
        }
#pragma unroll
        for (int s = 0; s < 4; ++s) {
            const bf16x8 a0 = *(const bf16x8*)(st + G_AOFF + swz128(wm * 64 + r32, 2 * s + hi));
            const bf16x8 a1 = *(const bf16x8*)(st + G_AOFF + swz128(wm * 64 + 32 + r32, 2 * s + hi));
            const bf16x8 b0 = *(const bf16x8*)(st + G_BOFF + swz128(wn * 64 + r32, 2 * s + hi));
            const bf16x8 b1 = *(const bf16x8*)(st + G_BOFF + swz128(wn * 64 + 32 + r32, 2 * s + hi));
            acc[0][0] = MFMA32(b0, a0, acc[0][0]); acc[0][1] = MFMA32(b1, a0, acc[0][1]);
            acc[1][0] = MFMA32(b0, a1, acc[1][0]); acc[1][1] = MFMA32(b1, a1, acc[1][1]);
        }
        if (kt + 1 < nk) {
            char* sn = lds + ((kt + 1) & 1) * G_STAGE;
#pragma unroll
            for (int j = 0; j < 4; ++j) *(u32x4*)(sn + G_AOFF + swz128(lr + 64 * j, lc)) = ra[j];
#pragma unroll
            for (int j = 0; j < 2; ++j) *(u32x4*)(sn + G_BOFF + swz128(lr + 64 * j, lc)) = rb[j];
        }
        __syncthreads();
    }
}
DEVINL void zero_acc(f32x16 (&acc)[2][2]) {
#pragma unroll
    for (int i = 0; i < 2; ++i)
#pragma unroll
        for (int j = 0; j < 2; ++j)
#pragma unroll
            for (int r = 0; r < 16; ++r) acc[i][j][r] = 0.f;
}
constexpr int STG_PITCH = 272;
template <int ACT>
DEVINL void epi_to_lds(const f32x16 (&acc)[2][2], char* lds, float sc) {
    const int tid = threadIdx.x, lane = tid & 63, wave = tid >> 6, wm = wave >> 1, wn = wave & 1, r32 = lane & 31, hi = lane >> 5;
#pragma unroll
    for (int i = 0; i < 2; ++i)
#pragma unroll
        for (int j = 0; j < 2; ++j)
#pragma unroll
            for (int g = 0; g < 4; ++g) {
                float v[4];
#pragma unroll
                for (int e = 0; e < 4; ++e) {
                    float t = acc[i][j][4 * g + e];
                    if (ACT == 1) t *= sc;
                    if (ACT == 2) t = fsilu(t);
                    if (ACT == 3) t = fsigm(t);
                    v[e] = t;
                }
                u32x2 w; w.x = cvtpk(v[0], v[1]); w.y = cvtpk(v[2], v[3]);
                *(u32x2*)(lds + (wm * 64 + 32 * i + r32) * STG_PITCH + (wn * 64 + 32 * j + 8 * g + 4 * hi) * 2) = w;
            }
}
DEVINL void lds_tile_store(char* lds, bf16_t* C, int ldc) {
    const int tid = threadIdx.x;
#pragma unroll
    for (int j = 0; j < 8; ++j) {
        const int row = (tid >> 4) + 32 * j, ch = tid & 15;
        const u32x4 v = *(const u32x4*)(lds + row * STG_PITCH + ch * 16);
        *(u32x4*)(C + (size_t)row * ldc + ch * 8) = v;
    }
}

DEVINL void phase1(const Params& p, char* lds) {
    const int tid = threadIdx.x, lane = tid & 63, wave = tid >> 6, wm = wave >> 1, wn = wave & 1, r32 = lane & 31, hi = lane >> 5;
    const bf16_t* XN = (const bf16_t*)p.out;
    const bf16_t* WIN = (const bf16_t*)(p.ws + WS_WIN);
    constexpr int NMAIN = 128 * NG1, NMEMT = 4 * 4;
    for (int it = blockIdx.x; it < NMAIN + NMEMT; it += gridDim.x) {
        f32x16 acc[2][2]; zero_acc(acc);
        if (it < NMAIN) {
            const int grp = it / (8 * NG1), rem = it % (8 * NG1), nt = rem / 8, mt = grp * 8 + (rem & 7);
            gemm_tile(XN + (size_t)mt * 256 * DM, DM, WIN + (size_t)nt * 128 * DM, DM, DM, acc, lds);
            const size_t m0 = (size_t)mt * 256;
            if (nt < 24) {
                const int g8 = nt / 3, co = (nt % 3) * 128;
                bf16_t* dst = (bf16_t*)(p.ws + WS_ACT8 + (size_t)g8 * ACT_STRIDE) + m0 * 384 + co;
                if (g8 == 0 || g8 == 4) epi_to_lds<1>(acc, lds, QSCALE);
                else if (g8 == 3 || g8 == 7) epi_to_lds<2>(acc, lds, 1.f);
                else epi_to_lds<0>(acc, lds, 1.f);
                __syncthreads();
                lds_tile_store(lds, dst, 384);
                if (g8 == 1 && tid < 128) {
                    float s = 0.f;
                    for (int r = 0; r < 256; ++r) s += bf2f(*(const bf16_t*)(lds + r * STG_PITCH + tid * 2));
                    ((float*)(p.ws + WS_KMEAN))[(size_t)mt * 384 + co + tid] = s * (1.f / 256.f);
                }
                __syncthreads();
            } else if (nt < 28) {
                epi_to_lds<0>(acc, lds, 1.f); __syncthreads();
                lds_tile_store(lds, (bf16_t*)(p.ws + WS_IQ) + m0 * 512 + (nt - 24) * 128, 512); __syncthreads();
            } else if (nt < 30) {
                epi_to_lds<1>(acc, lds, QSCALE); __syncthreads();
                lds_tile_store(lds, (bf16_t*)(p.ws + WS_QM) + m0 * 256 + (nt - 28) * 128, 256); __syncthreads();
            } else if (nt < 32) {
                epi_to_lds<2>(acc, lds, 1.f); __syncthreads();
                lds_tile_store(lds, (bf16_t*)(p.ws + WS_ZM) + m0 * 256 + (nt - 30) * 128, 256); __syncthreads();
            } else {
                epi_to_lds<0>(acc, lds, 1.f); __syncthreads();
                {
                    bf16_t* IK = (bf16_t*)(p.ws + WS_IK) + m0 * 64;
#pragma unroll
                    for (int j = 0; j < 4; ++j) {
                        const int idx = tid + 512 * j, row = idx >> 3, ch = idx & 7;
                        *(u32x4*)(IK + (size_t)row * 64 + ch * 8) = *(const u32x4*)(lds + row * STG_PITCH + ch * 16);
                    }
                }
                if (wn == 1) {
                    float* IW = (float*)(p.ws + WS_IW) + m0 * 8;
#pragma unroll
                    for (int i = 0; i < 2; ++i) {
                        f32x4 v; v.x = acc[i][0][0] * CSCALE; v.y = acc[i][0][1] * CSCALE; v.z = acc[i][0][2] * CSCALE; v.w = acc[i][0][3] * CSCALE;
                        *(f32x4*)(IW + (size_t)(wm * 64 + 32 * i + r32) * 8 + 4 * hi) = v;
                    }
                }
                __syncthreads();
            }
        } else {
            const int mi = it - NMAIN, mt = mi >> 2, nt = mi & 3;
            gemm_tile((const bf16_t*)(p.ws + WS_MEMN) + (size_t)mt * 256 * DM, DM, (const bf16_t*)(p.ws + WS_WMEM) + (size_t)nt * 128 * DM, DM, DM, acc, lds);
            epi_to_lds<0>(acc, lds, 1.f); __syncthreads();
            bf16_t* dst = (bf16_t*)(p.ws + (nt < 2 ? WS_MK : WS_MV)) + (size_t)mt * 256 * 256 + (nt & 1) * 128;
            lds_tile_store(lds, dst, 256); __syncthreads();
        }
    }
}

DEVINL void phase_gates(const Params& p, char* lds) {
    const bf16_t* XN = (const bf16_t*)p.out;
    const bf16_t* WIN = (const bf16_t*)(p.ws + WS_WIN);
    for (int it = blockIdx.x; it < 128 * 24; it += gridDim.x) {
        const int grp = it / (8 * 24), rem = it % (8 * 24), nt = rem / 8, mt = grp * 8 + (rem & 7);
        f32x16 acc[2][2]; zero_acc(acc);
        gemm_tile(XN + (size_t)mt * 256 * DM, DM, WIN + (size_t)(GATE0 + nt * 128) * DM, DM, DM, acc, lds);
        epi_to_lds<3>(acc, lds, 1.f); __syncthreads();
        lds_tile_store(lds, (bf16_t*)(p.ws + WS_GATES) + (size_t)mt * 256 * 3072 + nt * 128, 3072); __syncthreads();
    }
}

DEVINL void phase_merge(const Params& p, char* lds) {
    const int tid = threadIdx.x, lane = tid & 63, wave = tid >> 6, wm = wave >> 1, wn = wave & 1, r32 = lane & 31, hi = lane >> 5;
    const bf16_t* WBR = (const bf16_t*)(p.ws + WS_WBR);
    const bf16_t* GATES = (const bf16_t*)(p.ws + WS_GATES);
    for (int it = blockIdx.x; it < 128 * 8; it += gridDim.x) {
        const int nt = it >> 7, mt = it & 127;
        const size_t m0 = (size_t)mt * 256;
        f32x16 acc[2][2]; zero_acc(acc);
#pragma unroll 1
        for (int br = 0; br < 3; ++br) {
            const bf16_t* Y; int ldy, K, koff;
            if (br == 0) { Y = (const bf16_t*)(p.ws + WS_ACT8) + m0 * 384; ldy = 384; K = 384; koff = 0; }
            else if (br == 1) { Y = (const bf16_t*)(p.ws + WS_ACT8 + 4 * ACT_STRIDE) + m0 * 384; ldy = 384; K = 384; koff = 384; }
            else { Y = (const bf16_t*)(p.ws + WS_QM) + m0 * 256; ldy = 256; K = 256; koff = 768; }
            gemm_tile(Y, ldy, WBR + (size_t)nt * 128 * DM + koff, DM, K, acc, lds);
#pragma unroll
            for (int i = 0; i < 2; ++i)
#pragma unroll
                for (int j = 0; j < 2; ++j)
#pragma unroll
                    for (int g = 0; g < 4; ++g) {
                        const size_t m = m0 + wm * 64 + 32 * i + r32;
                        const int n = nt * 128 + wn * 64 + 32 * j + 8 * g + 4 * hi;
                        const u32x2 gw = *(const u32x2*)(GATES + m * 3072 + br * 1024 + n);
                        float f0 = bf_lo(gw.x), f1 = bf_hi(gw.x), f2 = bf_lo(gw.y), f3 = bf_hi(gw.y);
                        if (br < 2) {
                            const u32x2 gn = *(const u32x2*)(GATES + m * 3072 + (br + 1) * 1024 + n);
                            f0 = f0 / bf_lo(gn.x); f1 = f1 / bf_hi(gn.x); f2 = f2 / bf_lo(gn.y); f3 = f3 / bf_hi(gn.y);
                        }
                        acc[i][j][4 * g + 0] *= f0; acc[i][j][4 * g + 1] *= f1; acc[i][j][4 * g + 2] *= f2; acc[i][j][4 * g + 3] *= f3;
                    }
        }
        epi_to_lds<0>(acc, lds, 1.f); __syncthreads();
        lds_tile_store(lds, (bf16_t*)(p.ws + WS_MERGED) + m0 * DM + nt * 128, DM); __syncthreads();
    }
}

DEVINL void phase_out(const Params& p, char* lds) {
    const int tid = threadIdx.x, lane = tid & 63, wave = tid >> 6, wm = wave >> 1, wn = wave & 1, r32 = lane & 31, hi = lane >> 5;
    float* SSQ = (float*)(p.ws + WS_SSQ);
    for (int it = blockIdx.x; it < 128 * 8; it += gridDim.x) {
        const int nt = it >> 7, mt = it & 127;
        const size_t m0 = (size_t)mt * 256;
        f32x16 acc[2][2]; zero_acc(acc);
        gemm_tile((const bf16_t*)(p.ws + WS_MERGED) + m0 * DM, DM, (const bf16_t*)(p.ws + WS_WOUT) + (size_t)nt * 128 * DM, DM, DM, acc, lds);
        float* ssl = (float*)lds;
#pragma unroll
        for (int i = 0; i < 2; ++i) {
            const size_t m = m0 + wm * 64 + 32 * i + r32;
            float ss = 0.f;
#pragma unroll
            for (int j = 0; j < 2; ++j)
#pragma unroll
                for (int g = 0; g < 4; ++g) {
                    const int n = nt * 128 + wn * 64 + 32 * j + 8 * g + 4 * hi;
                    const f32x4 xv = *(const f32x4*)(p.x + m * DM + n);
                    f32x4 y; y.x = xv.x + acc[i][j][4 * g + 0]; y.y = xv.y + acc[i][j][4 * g + 1]; y.z = xv.z + acc[i][j][4 * g + 2]; y.w = xv.w + acc[i][j][4 * g + 3];
                    ss += (y.x * y.x + y.y * y.y) + (y.z * y.z + y.w * y.w);
                    *(f32x4*)(p.out + m * DM + n) = y;
                }
            ss += __shfl_xor(ss, 32);
            if (hi == 0) ssl[(wm * 64 + 32 * i + r32) * 2 + wn] = ss;
        }
        __syncthreads();
        if (tid < 256) SSQ[(m0 + tid) * 8 + nt] = ssl[tid * 2] + ssl[tid * 2 + 1];
        __syncthreads();
    }
}
DEVINL void phase_final(const Params& p) {
    const int tid = threadIdx.x, lane = tid & 63, wave = tid >> 6;
#ifdef PROBE_A
    const unsigned* tsw = (const unsigned*)(p.ws + WS_CTL) + 4096;
    const float probeA = (float)(tsw[PROBE_A + 1] - tsw[PROBE_A]) * 1e-4f;
    const float probeB = (float)(tsw[PROBE_B + 1] - tsw[PROBE_B]) * 1e-5f;
#endif
    const float* SSQ = (const float*)(p.ws + WS_SSQ);
    for (int r = blockIdx.x * 8 + wave; r < NT; r += gridDim.x * 8) {
        const f32x4 s0 = *(const f32x4*)(SSQ + (size_t)r * 8), s1 = *(const f32x4*)(SSQ + (size_t)r * 8 + 4);
        const float ss = ((s0.x + s0.y) + (s0.z + s0.w)) + ((s1.x + s1.y) + (s1.z + s1.w));
        const float rstd = rsqrtf(ss * (1.f / DM) + EPS);
        f32x4* yr = (f32x4*)(p.out + (size_t)r * DM) + lane;
        const f32x4* gr = (const f32x4*)p.final_gain + lane;
#pragma unroll
        for (int j = 0; j < 4; ++j) { f32x4 y = yr[64 * j]; const f32x4 g = gr[64 * j]; y.x *= rstd * g.x; y.y *= rstd * g.y; y.z *= rstd * g.z; y.w *= rstd * g.w;
#ifdef PROBE_A
            y.x += probeB; y.y += probeB; y.z += probeB; y.w += probeB; if (r == 0 && j == 0 && lane == 0) y.x += probeA;
#endif
            yr[64 * j] = y; }
    }
}

constexpr int AT_K = 0, AT_V = 32768, AT_VPLANE = 16384 + 64, AT_END = AT_V + 2 * AT_VPLANE;
DEVINL void load_kv_block(const bf16_t* __restrict__ Kg, const bf16_t* __restrict__ Vg, int ld, char* lds) {
    const int tid = threadIdx.x, c = tid & 7, kr = tid >> 3;
    u32x4 kk[4], vv[4];
#pragma unroll
    for (int j = 0; j < 4; ++j) { kk[j] = *(const u32x4*)(Kg + (size_t)(kr + 64 * j) * ld + c * 8); vv[j] = *(const u32x4*)(Vg + (size_t)(kr + 64 * j) * ld + c * 8); }
#pragma unroll
    for (int j = 0; j < 4; ++j) {
        const int key = kr + 64 * j;
        *(u32x4*)(lds + AT_K + swz128(key, c)) = kk[j];
        *(u32x4*)(lds + AT_V + (c >> 2) * AT_VPLANE + key * 64 + (c & 3) * 16) = vv[j];
    }
}
DEVINL s16x4 tr_read(const char* p) {
    typedef short v4i16_t __attribute__((ext_vector_type(4)));
    return __builtin_bit_cast(s16x4, __builtin_amdgcn_ds_read_tr16_b64_v4i16((LAS v4i16_t*)(uintptr_t)(unsigned)(uintptr_t)p));
}
struct AttnState { float mhat, l; f32x16 o0, o1; };
constexpr float ATT_THR = 8.f;
template <int MODE>
DEVINL void attn_256(const bf16x8 (&qf)[4], const char* lds, int t_row, int pos0, const float* lut, float* wsf, AttnState& st) {
    const int lane = threadIdx.x & 63, r32 = lane & 31, hi = lane >> 5;
    const char* KL = lds + AT_K;
    const char* vbase = lds + AT_V + (4 * hi + ((lane & 15) >> 2)) * 64 + ((lane >> 4) & 1) * 32 + (lane & 3) * 8;
    float mhat = 0.f, l = 0.f;
    f32x16 o0, o1;
#pragma unroll
    for (int r = 0; r < 16; ++r) { o0[r] = 0.f; o1[r] = 0.f; }
#pragma unroll 1
    for (int stp = 0; stp < 4; ++stp) {
        f32x16 s0, s1;
#pragma unroll
        for (int r = 0; r < 16; ++r) { s0[r] = 0.f; s1[r] = 0.f; }
#pragma unroll
        for (int s = 0; s < 4; ++s) {
            const bf16x8 k0 = *(const bf16x8*)(KL + swz128(64 * stp + r32, 2 * s + hi));
            const bf16x8 k1 = *(const bf16x8*)(KL + swz128(64 * stp + 32 + r32, 2 * s + hi));
            s0 = MFMA32(k0, qf[s], s0); s1 = MFMA32(k1, qf[s], s1);
        }
        if (MODE == 1) {
#pragma unroll
            for (int r = 0; r < 16; ++r) {
                const int d0 = t_row - (pos0 + 64 * stp + crow(r, hi)), d1 = d0 - 32;
                s0[r] = d0 < 0 ? -INFINITY : s0[r] + lut[d0 > 127 ? 127 : d0];
                s1[r] = d1 < 0 ? -INFINITY : s1[r] + lut[d1 > 127 ? 127 : d1];
            }
        }
        float rm = fmaxf(s0[0], s1[0]);
#pragma unroll
        for (int r = 1; r < 16; ++r) rm = fmaxf(rm, fmaxf(s0[r], s1[r]));
        { auto rr = __builtin_amdgcn_permlane32_swap(__float_as_uint(rm), __float_as_uint(rm), false, false); rm = fmaxf(__uint_as_float(rr[0]), __uint_as_float(rr[1])); }
        if (stp == 0) { mhat = fmaxf(rm, -1e30f); }
        else {
            const float grow = rm - mhat;
            if (__any(grow > ATT_THR)) {
                const float dl = fmaxf(grow, 0.f); mhat += dl;
                const float f = fexp2(-dl); l *= f;
                if (hi == 0) wsf[r32] = f;
                LDS_WAIT();
#pragma unroll
                for (int g = 0; g < 4; ++g) {
                    const f32x4 fv = *(const f32x4*)(wsf + 8 * g + 4 * hi);
                    o0[4 * g + 0] *= fv.x; o0[4 * g + 1] *= fv.y; o0[4 * g + 2] *= fv.z; o0[4 * g + 3] *= fv.w;
                    o1[4 * g + 0] *= fv.x; o1[4 * g + 1] *= fv.y; o1[4 * g + 2] *= fv.z; o1[4 * g + 3] *= fv.w;
                }
                LDS_WAIT();
            }
        }
        float ps = 0.f;
#pragma unroll
        for (int r = 0; r < 16; ++r) { s0[r] = fexp2(s0[r] - mhat); s1[r] = fexp2(s1[r] - mhat); ps += s0[r] + s1[r]; }
        l += ps;
#pragma unroll
        for (int sub = 0; sub < 2; ++sub)
#pragma unroll
            for (int sp = 0; sp < 2; ++sp) {
                u32x4 pw;
                if (sub == 0) { pw.x = cvtpk(s0[8 * sp + 0], s0[8 * sp + 1]); pw.y = cvtpk(s0[8 * sp + 2], s0[8 * sp + 3]); pw.z = cvtpk(s0[8 * sp + 4], s0[8 * sp + 5]); pw.w = cvtpk(s0[8 * sp + 6], s0[8 * sp + 7]); }
                else { pw.x = cvtpk(s1[8 * sp + 0], s1[8 * sp + 1]); pw.y = cvtpk(s1[8 * sp + 2], s1[8 * sp + 3]); pw.z = cvtpk(s1[8 * sp + 4], s1[8 * sp + 5]); pw.w = cvtpk(s1[8 * sp + 6], s1[8 * sp + 7]); }
                const bf16x8 pf = __builtin_bit_cast(bf16x8, pw);
                const int keybase = 64 * stp + 32 * sub + 16 * sp;
                const char* va = vbase + keybase * 64;
                const s16x4 a0 = tr_read(va), a1 = tr_read(va + 512);
                const s16x4 b0 = tr_read(va + AT_VPLANE), b1 = tr_read(va + AT_VPLANE + 512);
                const bf16x8 vf0 = (bf16x8){a0[0], a0[1], a0[2], a0[3], a1[0], a1[1], a1[2], a1[3]};
                const bf16x8 vf1 = (bf16x8){b0[0], b0[1], b0[2], b0[3], b1[0], b1[1], b1[2], b1[3]};
                o0 = MFMA32(pf, vf0, o0); o1 = MFMA32(pf, vf1, o1);
            }
    }
    st.mhat = mhat; st.l = l; st.o0 = o0; st.o1 = o1;
}
DEVINL float half_sum(float v) { auto rr = __builtin_amdgcn_permlane32_swap(__float_as_uint(v), __float_as_uint(v), false, false); return __uint_as_float(rr[0]) + __uint_as_float(rr[1]); }
DEVINL void rows_to_regs(float v, float* wsf, float (&out)[16]) {
    const int lane = threadIdx.x & 63, r32 = lane & 31, hi = lane >> 5;
    LDS_WAIT();
    if (hi == 0) wsf[r32] = v;
    LDS_WAIT();
#pragma unroll
    for (int g = 0; g < 4; ++g) { const f32x4 fv = *(const f32x4*)(wsf + 8 * g + 4 * hi); out[4 * g] = fv.x; out[4 * g + 1] = fv.y; out[4 * g + 2] = fv.z; out[4 * g + 3] = fv.w; }
    LDS_WAIT();
}
DEVINL void build_lut(float* lut, const float* rel_bias, int col) {
    const int tid = threadIdx.x;
    if (tid < 128) lut[tid] = rel_bias[rel_bucket(tid) * 12 + col] * LOG2E;
}

DEVINL void moba_select_item(const Params& p, char* lds, int item) {
    const int tid = threadIdx.x;
    const int b = item / (HA * 16), h = (item / 16) % HA, t = (item % 16) * 512 + tid, own = t >> 8;
    float* km = (float*)lds;
    unsigned* lcnt = (unsigned*)(lds + 8192);
    unsigned* lbase = lcnt + 32;
    const float* KMEAN = (const float*)(p.ws + WS_KMEAN);
    for (int i = tid; i < 2048; i += NTHR) km[i] = KMEAN[(size_t)(b * 32 + (i >> 6)) * 384 + h * 64 + (i & 63)];
    if (tid < 32) lcnt[tid] = 0u;
    __syncthreads();
    const bf16_t* q = (const bf16_t*)(p.ws + WS_ACT8) + (size_t)(b * SEQ + t) * 384 + h * 64;
    float qv[64];
#pragma unroll
    for (int c = 0; c < 8; ++c) {
        const u32x4 w = *(const u32x4*)(q + c * 8);
        qv[8 * c + 0] = bf_lo(w.x); qv[8 * c + 1] = bf_hi(w.x); qv[8 * c + 2] = bf_lo(w.y); qv[8 * c + 3] = bf_hi(w.y);
        qv[8 * c + 4] = bf_lo(w.z); qv[8 * c + 5] = bf_hi(w.z); qv[8 * c + 6] = bf_lo(w.w); qv[8 * c + 7] = bf_hi(w.w);
    }
    float v0 = -INFINITY, v1 = -INFINITY, v2 = -INFINITY; int i0 = 0, i1 = 1, i2 = 2;
    const int nmax = (((item % 16) * 512 + 511) >> 8);
#pragma unroll 1
    for (int n = 0; n < nmax; ++n) {
        float g = 0.f;
#pragma unroll
        for (int c = 0; c < 16; ++c) { const f32x4 kv = *(const f32x4*)(km + n * 64 + 4 * c); g += qv[4 * c] * kv.x + qv[4 * c + 1] * kv.y + qv[4 * c + 2] * kv.z + qv[4 * c + 3] * kv.w; }
        if (n < own) {
            if (g > v0) { v2 = v1; i2 = i1; v1 = v0; i1 = i0; v0 = g; i0 = n; }
            else if (g > v1) { v2 = v1; i2 = i1; v1 = g; i1 = n; }
            else if (g > v2) { v2 = g; i2 = n; }
        }
    }
    const int nsel = own < 3 ? own : 3;
    unsigned o0 = 0, o1 = 0, o2 = 0;
    if (nsel > 0) o0 = atomicAdd(&lcnt[i0], 1u);
    if (nsel > 1) o1 = atomicAdd(&lcnt[i1], 1u);
    if (nsel > 2) o2 = atomicAdd(&lcnt[i2], 1u);
    __syncthreads();
    unsigned* gcnt = (unsigned*)(p.ws + WS_CTL) + (b * HA + h) * 32;
    if (tid < 32) lbase[tid] = lcnt[tid] ? atomicAdd(&gcnt[tid], lcnt[tid]) : 0u;
    __syncthreads();
    bf16_t* L = (bf16_t*)(p.ws + WS_LIST) + (size_t)(b * HA + h) * LIST_PER_BH;
    if (nsel > 0) L[list_off(i0) + lbase[i0] + o0] = (bf16_t)(t | (0 << 13));
    if (nsel > 1) L[list_off(i1) + lbase[i1] + o1] = (bf16_t)(t | (1 << 13));
    if (nsel > 2) L[list_off(i2) + lbase[i2] + o2] = (bf16_t)(t | (2 << 13));
    __syncthreads();
}

DEVINL void mem_attn_item(const Params& p, char* lds, int item) {
    const int tid = threadIdx.x, lane = tid & 63, wave = tid >> 6, r32 = lane & 31, hi = lane >> 5;
    const int b = item / (HM * 32), h = (item / 32) % HM, qt = item % 32;
    float* wsf = (float*)(lds + AT_END) + wave * 32;
    char* ostg = lds + AT_END + 1024 + wave * 4096;
    load_kv_block((const bf16_t*)(p.ws + WS_MK) + (size_t)b * 256 * 256 + h * 64, (const bf16_t*)(p.ws + WS_MV) + (size_t)b * 256 * 256 + h * 64, 256, lds);
    const size_t row0 = (size_t)b * SEQ + qt * 256 + wave * 32;
    bf16_t* QM = (bf16_t*)(p.ws + WS_QM);
    bf16x8 qf[4];
#pragma unroll
    for (int s = 0; s < 4; ++s) qf[s] = *(const bf16x8*)(QM + (row0 + r32) * 256 + h * 64 + 16 * s + 8 * hi);
    __syncthreads();
    AttnState st;
    attn_256<0>(qf, lds, 0, 0, nullptr, wsf, st);
    const float ltot = half_sum(st.l);
    float rl[16]; rows_to_regs(1.f / ltot, wsf, rl);
#pragma unroll
    for (int r = 0; r < 16; ++r) {
        *(bf16_t*)(ostg + crow(r, hi) * 128 + r32 * 2) = (bf16_t)(cvtpk(st.o0[r] * rl[r], 0.f) & 0xffffu);
        *(bf16_t*)(ostg + crow(r, hi) * 128 + (32 + r32) * 2) = (bf16_t)(cvtpk(st.o1[r] * rl[r], 0.f) & 0xffffu);
    }
    LDS_WAIT();
    const bf16_t* ZM = (const bf16_t*)(p.ws + WS_ZM);
#pragma unroll
    for (int i = 0; i < 4; ++i) {
        const int row = i * 8 + (lane >> 3), ch = lane & 7;
        const u32x4 ov = *(const u32x4*)(ostg + row * 128 + ch * 16);
        const u32x4 zv = *(const u32x4*)(ZM + (row0 + row) * 256 + h * 64 + ch * 8);
        u32x4 w;
        w.x = cvtpk(bf_lo(ov.x) * bf_lo(zv.x), bf_hi(ov.x) * bf_hi(zv.x)); w.y = cvtpk(bf_lo(ov.y) * bf_lo(zv.y), bf_hi(ov.y) * bf_hi(zv.y));
        w.z = cvtpk(bf_lo(ov.z) * bf_lo(zv.z), bf_hi(ov.z) * bf_hi(zv.z)); w.w = cvtpk(bf_lo(ov.w) * bf_lo(zv.w), bf_hi(ov.w) * bf_hi(zv.w));
        *(u32x4*)(QM + (row0 + row) * 256 + h * 64 + ch * 8) = w;
    }
    __syncthreads();
}

constexpr int IXL_META = 0, IXL_CAND = 2048, IX_CAP = 64, IXL_HIST = IXL_CAND + 32 * IX_CAP * 8, IXL_STAGE = IXL_HIST + 65536, IXL_END = IXL_STAGE + 2 * 32768;
struct IxMeta { int need[32]; int nr[32]; int done[32]; int ccnt[32]; int lcnt[32]; int B[3][32]; float lo[3][32]; int flag; };
DEVINL int ix_bin(float s, float lo, float sc) { float v = (s - lo) * sc; v = fminf(fmaxf(v, 0.f), 511.f); return (int)v; }
DEVINL int ix_bin0(float s) { return (int)__builtin_amdgcn_fmed3f(__builtin_fmaf(s, 32.f, 256.f), 0.f, 511.f); }
DEVINL float ix_sc(int r) { return r == 0 ? 32.f : (r == 1 ? 16384.f : 8388608.f); }
DEVINL float relu1(float x) { return __builtin_amdgcn_fmed3f(x, 0.f, 3.0e38f); }
DEVINL f32x16 ix_mma(const bf16x8 (&a)[4], const bf16x8 (&b)[4]) {
    f32x16 acc;
#pragma unroll
    for (int r = 0; r < 16; ++r) acc[r] = 0.f;
#pragma unroll
    for (int s = 0; s < 4; ++s) acc = MFMA32(a[s], b[s], acc);
    return acc;
}
DEVINL void ix_reduce(const f32x16& acc, const f32x4 (&cv)[4], float& sA, float& sB) {
    float pj[4];
#pragma unroll
    for (int j = 0; j < 4; ++j) pj[j] = cv[j].x * relu1(acc[4 * j]) + cv[j].y * relu1(acc[4 * j + 1]) + cv[j].z * relu1(acc[4 * j + 2]) + cv[j].w * relu1(acc[4 * j + 3]);
    auto r02 = __builtin_amdgcn_permlane32_swap(__float_as_uint(pj[0]), __float_as_uint(pj[2]), false, false);
    auto r13 = __builtin_amdgcn_permlane32_swap(__float_as_uint(pj[1]), __float_as_uint(pj[3]), false, false);
    sA = __uint_as_float(r02[0]) + __uint_as_float(r02[1]);
    sB = __uint_as_float(r13[0]) + __uint_as_float(r13[1]);
}
template <int MODE, bool CAUSAL>
DEVINL void ix_tile(const f32x16& acc, const f32x4 (&cv)[4], int t0, int kt, int (&B0r)[2], int (&cnt)[2], IxMeta* meta, char* lds, int round) {
    const int lane = threadIdx.x & 63, wave = threadIdx.x >> 6, r32 = lane & 31, hi = lane >> 5;
    char* histb = lds + IXL_HIST;
    float* cand_s = (float*)(lds + IXL_CAND);
    int* cand_k = (int*)(lds + IXL_CAND + 32 * IX_CAP * 4);
    const int k = 32 * kt + r32;
    float sc2[2];
    ix_reduce(acc, cv, sc2[0], sc2[1]);
#pragma unroll
    for (int q = 0; q < 2; ++q) {
        const float sv = sc2[q];
        const int row = 4 * wave + 2 * hi + q;
        const bool adm = CAUSAL ? (k <= t0 + row) : true;
        const int b0 = ix_bin0(sv);
        if (MODE == 0) {
            if (adm) atomicAdd((unsigned*)(histb + row * 2048 + b0 * 4), 1u);
        } else if (MODE == 2) {
            if (adm && !meta->done[row]) {
                bool eq = (b0 == meta->B[0][row]);
                for (int j = 1; j < round; ++j) eq = eq && (ix_bin(sv, meta->lo[j][row], ix_sc(j)) == meta->B[j][row]);
                if (eq) { const int bb = ix_bin(sv, meta->lo[round][row], ix_sc(round)); atomicAdd((unsigned*)(histb + row * 2048 + bb * 4), 1u); }
            }
        } else {
            const int B0 = B0r[q] & 0xffff;
            bool above = adm && b0 > B0, eqv = adm && b0 == B0;
            if (B0r[q] & 0x10000) {
                if (eqv) {
                    const int nr = meta->nr[row]; int cls = 1;
                    for (int j = 1; j < nr && cls == 1; ++j) { const int bj = ix_bin(sv, meta->lo[j][row], ix_sc(j)), Bj = meta->B[j][row]; if (bj > Bj) cls = 2; else if (bj < Bj) cls = 0; }
                    above = cls == 2; eqv = cls == 1;
                }
            }
            const unsigned long long bal = __ballot(above);
            const unsigned hm = (unsigned)(bal >> (32 * hi));
            const int pos = cnt[q] + __popc(hm & ((1u << r32) - 1u));
            if (above && pos < 256) *(bf16_t*)(histb + row * 2048 + pos * 2) = (bf16_t)k;
            cnt[q] += __popc(hm);
            if (eqv) { const int c = atomicAdd(&meta->ccnt[row], 1); if (c < IX_CAP) { cand_s[row * IX_CAP + c] = sv; cand_k[row * IX_CAP + c] = k; } }
        }
    }
}
template <int MODE, bool LAST>
DEVINL void ix_chunk(const bf16x8 (&af)[4], const f32x4 (&cv)[4], const char* buf, int t0, int kt0, int ktend, int (&B0r)[2], int (&cnt)[2], IxMeta* meta, char* lds, int round) {
    const int lane = threadIdx.x & 63, r32 = lane & 31, hi = lane >> 5;
    bf16x8 bf[4];
#pragma unroll
    for (int s = 0; s < 4; ++s) bf[s] = *(const bf16x8*)(buf + swz128(r32, 2 * s + hi));
    f32x16 acc = ix_mma(af, bf);
#pragma unroll
    for (int t8 = 0; t8 < 8; ++t8) {
        if (!LAST || t8 < ktend) {
            f32x16 accn = acc;
            if (t8 + 1 < 8 && (!LAST || t8 + 1 < ktend)) {
#pragma unroll
                for (int s = 0; s < 4; ++s) bf[s] = *(const bf16x8*)(buf + swz128(32 * (t8 + 1) + r32, 2 * s + hi));
                accn = ix_mma(af, bf);
            }
            ix_tile<MODE, LAST>(acc, cv, t0, kt0 + t8, B0r, cnt, meta, lds, round);
            acc = accn;
        }
    }
}
template <int MODE>
DEVINL void ix_pass(const bf16x8 (&af)[4], const f32x4 (&cv)[4], const bf16_t* IK, int t0, int nkt, int (&B0r)[2], int (&cnt)[2], IxMeta* meta, char* lds, int round) {
    const int tid = threadIdx.x;
    const int lc = tid & 7, lr = tid >> 3;
    const int nch = (nkt + 7) >> 3;
    u32x4 st[4];
#pragma unroll
    for (int j = 0; j < 4; ++j) st[j] = *(const u32x4*)(IK + (size_t)(lr + 64 * j) * 64 + lc * 8);
#pragma unroll
    for (int j = 0; j < 4; ++j) *(u32x4*)(lds + IXL_STAGE + swz128(lr + 64 * j, lc)) = st[j];
    __syncthreads();
#pragma unroll 1
    for (int ch = 0; ch < nch; ++ch) {
        const char* buf = lds + IXL_STAGE + (ch & 1) * 32768;
        if (ch + 1 < nch) {
#pragma unroll
            for (int j = 0; j < 4; ++j) st[j] = *(const u32x4*)(IK + (size_t)(256 * (ch + 1) + lr + 64 * j) * 64 + lc * 8);
            ix_chunk<MODE, false>(af, cv, buf, t0, 8 * ch, 8, B0r, cnt, meta, lds, round);
            char* nb = lds + IXL_STAGE + ((ch + 1) & 1) * 32768;
#pragma unroll
            for (int j = 0; j < 4; ++j) *(u32x4*)(nb + swz128(lr + 64 * j, lc)) = st[j];
        } else {
            ix_chunk<MODE, true>(af, cv, buf, t0, 8 * ch, nkt - 8 * ch, B0r, cnt, meta, lds, round);
        }
        __syncthreads();
    }
}
DEVINL void indexer_item(const Params& p, char* lds, int item) {
    const int tid = threadIdx.x, lane = tid & 63, wave = tid >> 6, r32 = lane & 31, hi = lane >> 5;
    const int b = item >> 8, u = item & 255, qt = (b & 1) ? u : 255 - u, t0 = qt * 32;
    bf16_t* IDX = (bf16_t*)(p.ws + WS_IDX) + ((size_t)b * SEQ + t0) * 256;
    if (t0 < 256) {
#pragma unroll 1
        for (int rr = 0; rr < 4; ++rr) {
            const int row = 4 * wave + rr, n = t0 + row + 1;
#pragma unroll
            for (int k = 0; k < 4; ++k) { const int i = lane + 64 * k; IDX[row * 256 + i] = (bf16_t)(i < n ? i : 0xFFFF); }
        }
        return;
    }
    IxMeta* meta = (IxMeta*)(lds + IXL_META);
    unsigned* hist = (unsigned*)(lds + IXL_HIST);
    __syncthreads();
    if (tid < 32) { meta->need[tid] = 256; meta->nr[tid] = 0; meta->done[tid] = 0; meta->ccnt[tid] = 0; meta->lo[0][tid] = -8.f; }
    const bf16_t* IQ = (const bf16_t*)(p.ws + WS_IQ) + ((size_t)b * SEQ + t0) * 512;
    const bf16_t* IK = (const bf16_t*)(p.ws + WS_IK) + (size_t)b * SEQ * 64;
    const float* IW = (const float*)(p.ws + WS_IW) + ((size_t)b * SEQ + t0) * 8;
    bf16x8 af[4]; f32x4 cv[4];
#pragma unroll
    for (int s = 0; s < 4; ++s) af[s] = *(const bf16x8*)(IQ + (size_t)(4 * wave + (r32 >> 3)) * 512 + (r32 & 7) * 64 + 16 * s + 8 * hi);
#pragma unroll
    for (int j = 0; j < 4; ++j) cv[j] = *(const f32x4*)(IW + (size_t)(4 * wave + j) * 8 + 4 * hi);
    int B0r[2] = {0, 0}, cnt[2] = {0, 0};
    const int nkt = (t0 + 32) / 32;
#pragma unroll 1
    for (int round = 0; round < 3; ++round) {
#pragma unroll
        for (int k = 0; k < 8; ++k) *(u32x4*)(lds + IXL_HIST + (tid + 512 * k) * 16) = (u32x4){0u, 0u, 0u, 0u};
        if (tid == 0) meta->flag = 0;
        __syncthreads();
        if (round == 0) ix_pass<0>(af, cv, IK, t0, nkt, B0r, cnt, meta, lds, 0);
        else ix_pass<2>(af, cv, IK, t0, nkt, B0r, cnt, meta, lds, round);
#pragma unroll 1
        for (int rr = 0; rr < 4; ++rr) {
            const int row = 4 * wave + rr;
            if (meta->done[row]) continue;
            const int need = meta->need[row];
            const u32x4 h0 = *(const u32x4*)(hist + row * 512 + 8 * lane), h1 = *(const u32x4*)(hist + row * 512 + 8 * lane + 4);
            const unsigned c = ((h0[0] + h0[1]) + (h0[2] + h0[3])) + ((h1[0] + h1[1]) + (h1[2] + h1[3]));
            unsigned suf = c;
#pragma unroll
            for (int o = 1; o < 64; o <<= 1) { const unsigned tv = __shfl_down(suf, o); if (lane + o < 64) suf += tv; }
            const unsigned long long bal = __ballot(suf >= (unsigned)need);
            const int Ls = bal ? 63 - __builtin_clzll(bal) : 0;
            const unsigned sufL = __shfl(suf, Ls), cL = __shfl(c, Ls);
            unsigned cum = sufL - cL; int Bs = 8 * Ls; unsigned cb = 0; bool found = false;
#pragma unroll 1
            for (int e = 7; e >= 0; --e) {
                const unsigned hv = hist[row * 512 + 8 * Ls + e];
                if (!found) { if (cum + hv >= (unsigned)need) { Bs = 8 * Ls + e; cb = hv; found = true; } else cum += hv; }
            }
            if (lane == 0) {
                meta->B[round][row] = Bs; meta->need[row] = need - (int)cum; meta->nr[row] = round + 1;
                if (cb > (unsigned)IX_CAP && round < 2) { meta->lo[round + 1][row] = meta->lo[round][row] + (float)Bs / ix_sc(round); meta->flag = 1; }
                else meta->done[row] = 1;
            }
        }
        __syncthreads();
        const int more = meta->flag;
        __syncthreads();
        if (!more) break;
    }
#pragma unroll
    for (int q = 0; q < 2; ++q) { const int row = 4 * wave + 2 * hi + q; B0r[q] = meta->B[0][row] | (meta->nr[row] > 1 ? 0x10000 : 0); }
    ix_pass<1>(af, cv, IK, t0, nkt, B0r, cnt, meta, lds, 0);
    if (r32 == 0) {
#pragma unroll
        for (int q = 0; q < 2; ++q) meta->lcnt[4 * wave + 2 * hi + q] = cnt[q] < 256 ? cnt[q] : 256;
    }
    LDS_WAIT();
    {
        const float* cand_s = (const float*)(lds + IXL_CAND);
        const int* cand_k = (const int*)(lds + IXL_CAND + 32 * IX_CAP * 4);
#pragma unroll 1
        for (int rr = 0; rr < 4; ++rr) {
            const int row = 4 * wave + rr;
            const int c = meta->lcnt[row];
            for (int i = lane; i < c; i += 64) IDX[row * 256 + i] = *(const bf16_t*)(lds + IXL_HIST + row * 2048 + i * 2);
            const int m = meta->ccnt[row] < IX_CAP ? meta->ccnt[row] : IX_CAP, r = meta->need[row], base = 256 - r;
            for (int i = lane; i < m; i += 64) {
                const float si = cand_s[row * IX_CAP + i]; const int ki = cand_k[row * IX_CAP + i];
                int rank = 0;
                for (int j = 0; j < m; ++j) { const float sj = cand_s[row * IX_CAP + j]; const int kj = cand_k[row * IX_CAP + j]; rank += (sj > si || (sj == si && kj < ki)) ? 1 : 0; }
                if (rank < r) IDX[row * 256 + base + rank] = (bf16_t)ki;
            }
        }
    }
    __syncthreads();
}

DEVINL float dot2bf(unsigned a, unsigned b, float c) {
    typedef __bf16 bf2 __attribute__((ext_vector_type(2)));
    return __builtin_amdgcn_fdot2_f32_bf16(__builtin_bit_cast(bf2, a), __builtin_bit_cast(bf2, b), c, false);
}
DEVINL void dsa_item(const Params& p, char* lds, int item, bool dry = false) {
    const int tid = threadIdx.x, lane = tid & 63, wave = tid >> 6, g = lane >> 3, j = lane & 7;
    const int pair = (item & 7) + 8 * (item >> 8), chunk = (item >> 3) & 31;
    const int b = pair / HB, h = pair % HB;
    float* lut = (float*)lds;
    float* pbuf = (float*)(lds + 512) + wave * 256;
    __syncthreads();
    build_lut(lut, p.rel_bias, 6 + h);
    __syncthreads();
    bf16_t* QB = (bf16_t*)(p.ws + WS_ACT8 + 4 * ACT_STRIDE);
    const bf16_t* KB = (const bf16_t*)(p.ws + WS_ACT8 + 5 * ACT_STRIDE) + (size_t)b * SEQ * 384 + h * 64 + 8 * j;
    const bf16_t* VB = (const bf16_t*)(p.ws + WS_ACT8 + 6 * ACT_STRIDE) + (size_t)b * SEQ * 384 + h * 64 + 8 * j;
    const bf16_t* ZB = (const bf16_t*)(p.ws + WS_ACT8 + 7 * ACT_STRIDE);
    const bf16_t* IDX = (const bf16_t*)(p.ws + WS_IDX);
#pragma unroll 1
    for (int qi = 0; qi < 32; ++qi) {
        const int t = chunk * 256 + wave * 32 + qi;
        const size_t row = (size_t)b * SEQ + t;
        const u32x4 qv = *(const u32x4*)(QB + row * 384 + h * 64 + 8 * j);
        const bf16_t* irow = IDX + row * 256 + g * 32;
        u32x4 iv[4];
#pragma unroll
        for (int k = 0; k < 4; ++k) iv[k] = *(const u32x4*)(irow + 8 * k);
        int myk[4];
#pragma unroll
        for (int bt = 0; bt < 4; ++bt) myk[bt] = irow[8 * bt + j];
        float lg[4];
#pragma unroll
        for (int bt = 0; bt < 4; ++bt) {
            float part[8];
#pragma unroll
            for (int i = 0; i < 8; ++i) {
                const int ii = 8 * bt + i;
                const unsigned w = (ii & 1) ? (iv[ii >> 3][(ii >> 1) & 3] >> 16) : (iv[ii >> 3][(ii >> 1) & 3] & 0xffffu);
                const int key = w == 0xFFFFu ? 0 : (int)w;
                const u32x4 kv = *(const u32x4*)(KB + (size_t)key * 384);
                part[i] = dot2bf(kv.w, qv.w, dot2bf(kv.z, qv.z, dot2bf(kv.y, qv.y, dot2bf(kv.x, qv.x, 0.f))));
            }
            float v4[4];
#pragma unroll
            for (int a = 0; a < 4; ++a) { const float keep = (j & 4) ? part[4 + a] : part[a], send = (j & 4) ? part[a] : part[4 + a]; v4[a] = keep + __shfl_xor(send, 4); }
            float v2[2];
#pragma unroll
            for (int a = 0; a < 2; ++a) { const float keep = (j & 2) ? v4[2 + a] : v4[a], send = (j & 2) ? v4[a] : v4[2 + a]; v2[a] = keep + __shfl_xor(send, 2); }
            { const float keep = (j & 1) ? v2[1] : v2[0], send = (j & 1) ? v2[0] : v2[1]; lg[bt] = keep + __shfl_xor(send, 1); }
        }
        float mx = -INFINITY;
#pragma unroll
        for (int bt = 0; bt < 4; ++bt) {
            const int d = t - myk[bt];
            lg[bt] = (myk[bt] == 0xFFFF || d < 0) ? -INFINITY : lg[bt] + lut[d > 127 ? 127 : d];
            mx = fmaxf(mx, lg[bt]);
        }
        mx = wave_max(mx);
        float ls = 0.f;
#pragma unroll
        for (int bt = 0; bt < 4; ++bt) { lg[bt] = fexp2(lg[bt] - mx); ls += lg[bt]; pbuf[g * 32 + 8 * bt + j] = lg[bt]; }
        ls = wave_sum(ls);
        LDS_WAIT();
        float acc[8];
#pragma unroll
        for (int e = 0; e < 8; ++e) acc[e] = 0.f;
#pragma unroll
        for (int k = 0; k < 4; ++k) {
            const f32x4 pa = *(const f32x4*)(pbuf + g * 32 + 8 * k), pb = *(const f32x4*)(pbuf + g * 32 + 8 * k + 4);
            const float pp[8] = {pa.x, pa.y, pa.z, pa.w, pb.x, pb.y, pb.z, pb.w};
#pragma unroll
            for (int i2 = 0; i2 < 4; ++i2) {
                const unsigned wpair = iv[k][i2];
                const unsigned w0 = wpair & 0xffffu, w1 = wpair >> 16;
                const int key0 = w0 == 0xFFFFu ? 0 : (int)w0, key1 = w1 == 0xFFFFu ? 0 : (int)w1;
                const u32x4 va = *(const u32x4*)(VB + (size_t)key0 * 384), vb = *(const u32x4*)(VB + (size_t)key1 * 384);
                const unsigned ppk = cvtpk(pp[2 * i2], pp[2 * i2 + 1]);
#pragma unroll
                for (int w = 0; w < 4; ++w) {
                    const unsigned lo = __builtin_amdgcn_perm(vb[w], va[w], 0x05040100u), hh = __builtin_amdgcn_perm(vb[w], va[w], 0x07060302u);
                    acc[2 * w] = dot2bf(lo, ppk, acc[2 * w]); acc[2 * w + 1] = dot2bf(hh, ppk, acc[2 * w + 1]);
                }
            }
        }
        LDS_WAIT();
        float a4[4];
#pragma unroll
        for (int a = 0; a < 4; ++a) { const float keep = (g & 4) ? acc[4 + a] : acc[a], send = (g & 4) ? acc[a] : acc[4 + a]; a4[a] = keep + __shfl_xor(send, 32); }
        float a2[2];
#pragma unroll
        for (int a = 0; a < 2; ++a) { const float keep = (g & 2) ? a4[2 + a] : a4[a], send = (g & 2) ? a4[a] : a4[2 + a]; a2[a] = keep + __shfl_xor(send, 16); }
        float a1;
        { const float keep = (g & 1) ? a2[1] : a2[0], send = (g & 1) ? a2[0] : a2[1]; a1 = keep + __shfl_xor(send, 8); }
        const int dim = 8 * j + g;
        const float z = bf2f(ZB[row * 384 + h * 64 + dim]);
        bf16_t* dstp = dry ? (bf16_t*)(p.ws + WS_END) + ((row * 384 + h * 64 + dim) & 0x3fffff) : QB + row * 384 + h * 64 + dim;
        *dstp = (bf16_t)(cvtpk(a1 / ls * z, 0.f) & 0xffffu);
    }
}

DEVINL void moba_past_item(const Params& p, char* lds, int b, int h, int n, int c, int cnt) {
    const int tid = threadIdx.x, lane = tid & 63, wave = tid >> 6, r32 = lane & 31, hi = lane >> 5;
    float* lut = (float*)(lds + AT_END);
    float* wsf = (float*)(lds + AT_END + 512) + wave * 32;
    bf16_t* ent = (bf16_t*)(lds + AT_END + 1536);
    char* ostg = lds + AT_END + 2048 + wave * 4096;
    const bf16_t* L = (const bf16_t*)(p.ws + WS_LIST) + (size_t)(b * HA + h) * LIST_PER_BH + list_off(n) + c * 256;
    __syncthreads();
    const int nvalid = cnt - c * 256 < 256 ? cnt - c * 256 : 256;
    if (tid < 256) ent[tid] = tid < nvalid ? L[tid] : L[0];
    build_lut(lut, p.rel_bias, h);
    load_kv_block((const bf16_t*)(p.ws + WS_ACT8 + 1 * ACT_STRIDE) + ((size_t)b * SEQ + n * 256) * 384 + h * 64,
                  (const bf16_t*)(p.ws + WS_ACT8 + 2 * ACT_STRIDE) + ((size_t)b * SEQ + n * 256) * 384 + h * 64, 384, lds);
    __syncthreads();
    if (wave * 32 < nvalid) {
        const int e = ent[wave * 32 + r32], t_row = e & 8191;
        const bf16_t* QA = (const bf16_t*)(p.ws + WS_ACT8);
        bf16x8 qf[4];
#pragma unroll
        for (int s = 0; s < 4; ++s) qf[s] = *(const bf16x8*)(QA + ((size_t)b * SEQ + t_row) * 384 + h * 64 + 16 * s + 8 * hi);
        AttnState st;
        attn_256<1>(qf, lds, t_row, n * 256, lut, wsf, st);
        const float ltot = half_sum(st.l);
        float rl[16]; rows_to_regs(1.f / ltot, wsf, rl);
#pragma unroll
        for (int r = 0; r < 16; ++r) {
            *(bf16_t*)(ostg + crow(r, hi) * 128 + r32 * 2) = (bf16_t)(cvtpk(st.o0[r] * rl[r], 0.f) & 0xffffu);
            *(bf16_t*)(ostg + crow(r, hi) * 128 + (32 + r32) * 2) = (bf16_t)(cvtpk(st.o1[r] * rl[r], 0.f) & 0xffffu);
        }
        LDS_WAIT();
        bf16_t* PO = (bf16_t*)(p.ws + WS_PO);
        float* PL = (float*)(p.ws + WS_PL);
        if (hi == 0 && wave * 32 + r32 < nvalid) PL[(((size_t)b * SEQ + t_row) * HA + h) * 4 + (e >> 13)] = st.mhat + __builtin_amdgcn_logf(ltot);
#pragma unroll
        for (int i = 0; i < 4; ++i) {
            const int row = i * 8 + (lane >> 3), ch = lane & 7;
            if (wave * 32 + row < nvalid) {
                const int e2 = ent[wave * 32 + row];
                *(u32x4*)(PO + ((((size_t)b * SEQ + (e2 & 8191)) * HA + h) * 4 + (e2 >> 13)) * 64 + ch * 8) = *(const u32x4*)(ostg + row * 128 + ch * 16);
            }
        }
    }
    __syncthreads();
}

DEVINL void moba_own_item(const Params& p, char* lds, int item) {
    const int tid = threadIdx.x, lane = tid & 63, wave = tid >> 6, r32 = lane & 31, hi = lane >> 5;
    const int b = item / (HA * 32), h = (item / 32) % HA, n = item % 32;
    float* lut = (float*)(lds + AT_END);
    float* wsf = (float*)(lds + AT_END + 512) + wave * 32;
    float* lse_own = (float*)(lds + AT_END + 1536);
    float* oown = (float*)lds;
    __syncthreads();
    build_lut(lut, p.rel_bias, h);
    const size_t row0 = (size_t)b * SEQ + n * 256;
    load_kv_block((const bf16_t*)(p.ws + WS_ACT8 + 1 * ACT_STRIDE) + row0 * 384 + h * 64, (const bf16_t*)(p.ws + WS_ACT8 + 2 * ACT_STRIDE) + row0 * 384 + h * 64, 384, lds);
    bf16_t* QA = (bf16_t*)(p.ws + WS_ACT8);
    const int t_row = n * 256 + wave * 32 + r32;
    bf16x8 qf[4];
#pragma unroll
    for (int s = 0; s < 4; ++s) qf[s] = *(const bf16x8*)(QA + ((size_t)b * SEQ + t_row) * 384 + h * 64 + 16 * s + 8 * hi);
    __syncthreads();
    AttnState st;
    attn_256<1>(qf, lds, t_row, n * 256, lut, wsf, st);
    const float ltot = half_sum(st.l);
    float rl[16]; rows_to_regs(1.f / ltot, wsf, rl);
    __syncthreads();
    if (hi == 0) lse_own[wave * 32 + r32] = st.mhat + __builtin_amdgcn_logf(ltot);
#pragma unroll
    for (int r = 0; r < 16; ++r) {
        oown[(wave * 32 + crow(r, hi)) * 64 + r32] = st.o0[r] * rl[r];
        oown[(wave * 32 + crow(r, hi)) * 64 + 32 + r32] = st.o1[r] * rl[r];
    }
    __syncthreads();
    const bf16_t* PO = (const bf16_t*)(p.ws + WS_PO);
    const float* PL = (const float*)(p.ws + WS_PL);
    const bf16_t* ZA = (const bf16_t*)(p.ws + WS_ACT8 + 3 * ACT_STRIDE);
    const int nsel = n < 3 ? n : 3;
#pragma unroll 1
    for (int k = 0; k < 4; ++k) {
        const int task = tid + 512 * k, row = task >> 3, ch = task & 7;
        const size_t grow = row0 + row;
        const float lo = lse_own[row];
        float ls[3]; float M = lo;
#pragma unroll
        for (int s = 0; s < 3; ++s) { ls[s] = (s < nsel) ? PL[(grow * HA + h) * 4 + s] : -INFINITY; M = fmaxf(M, ls[s]); }
        const float w_own = fexp2(lo - M);
        float wsum = w_own, o[8];
#pragma unroll
        for (int e = 0; e < 8; ++e) o[e] = w_own * oown[row * 64 + ch * 8 + e];
#pragma unroll
        for (int s = 0; s < 3; ++s) {
            if (s < nsel) {
                const float w = fexp2(ls[s] - M); wsum += w;
                const u32x4 pv = *(const u32x4*)(PO + ((grow * HA + h) * 4 + s) * 64 + ch * 8);
                o[0] += w * bf_lo(pv.x); o[1] += w * bf_hi(pv.x); o[2] += w * bf_lo(pv.y); o[3] += w * bf_hi(pv.y);
                o[4] += w * bf_lo(pv.z); o[5] += w * bf_hi(pv.z); o[6] += w * bf_lo(pv.w); o[7] += w * bf_hi(pv.w);
            }
        }
        const float inv = 1.f / wsum;
        const u32x4 zv = *(const u32x4*)(ZA + grow * 384 + h * 64 + ch * 8);
        u32x4 w;
        w.x = cvtpk(o[0] * inv * bf_lo(zv.x), o[1] * inv * bf_hi(zv.x)); w.y = cvtpk(o[2] * inv * bf_lo(zv.y), o[3] * inv * bf_hi(zv.y));
        w.z = cvtpk(o[4] * inv * bf_lo(zv.z), o[5] * inv * bf_hi(zv.z)); w.w = cvtpk(o[6] * inv * bf_lo(zv.w), o[7] * inv * bf_hi(zv.w));
        *(u32x4*)(QA + grow * 384 + h * 64 + ch * 8) = w;
    }
    __syncthreads();
}

DEVINL void phase2(const Params& p, char* lds) {
    for (int it = blockIdx.x; it < NB * 256; it += gridDim.x) indexer_item(p, lds, it);
#if defined(REP) && REP == 3
    for (int it = blockIdx.x; it < NB * 256; it += gridDim.x) indexer_item(p, lds, it);
#endif
    __syncthreads();
    for (int it = blockIdx.x; it < NB * HA * 16; it += gridDim.x) moba_select_item(p, lds, it);
    for (int it = blockIdx.x; it < NB * HM * 32; it += gridDim.x) mem_attn_item(p, lds, it);
}
DEVINL void phase3(const Params& p, char* lds) {
    for (int it = blockIdx.x; it < 768; it += gridDim.x) dsa_item(p, lds, it);
#if defined(REP) && REP == 4
    for (int it = blockIdx.x; it < 768; it += gridDim.x) dsa_item(p, lds, it, true);
#endif
    const unsigned* ctl = (const unsigned*)(p.ws + WS_CTL);
    unsigned* pre = (unsigned*)(lds + AT_END + 2048 + 8 * 4096);
    __syncthreads();
    for (int i = threadIdx.x; i < 744; i += NTHR) pre[i + 1] = (ctl[(i / 31) * 32 + (i % 31)] + 255u) >> 8;
    __syncthreads();
    if (threadIdx.x == 0) { unsigned a = 0; pre[0] = 0; for (int i = 1; i <= 744; ++i) { a += pre[i]; pre[i] = a; } }
    __syncthreads();
    const int total = (int)pre[744];
    for (int ri = blockIdx.x; ri < total; ri += gridDim.x) {
        int lo = 0, hi2 = 744;
        while (hi2 - lo > 1) { const int mid = (lo + hi2) >> 1; if ((int)pre[mid] <= ri) lo = mid; else hi2 = mid; }
        const int bh = lo / 31, n = lo % 31, c = ri - (int)pre[lo];
        moba_past_item(p, lds, bh / HA, bh % HA, n, c, (int)ctl[bh * 32 + n]);
    }
#if defined(REP) && REP == 5
    for (int ri = blockIdx.x; ri < total; ri += gridDim.x) {
        int lo = 0, hi2 = 744;
        while (hi2 - lo > 1) { const int mid = (lo + hi2) >> 1; if ((int)pre[mid] <= ri) lo = mid; else hi2 = mid; }
        const int bh = lo / 31, n = lo % 31, c = ri - (int)pre[lo];
        moba_past_item(p, lds, bh / HA, bh % HA, n, c, (int)ctl[bh * 32 + n]);
    }
#endif
}
DEVINL void phase4(const Params& p, char* lds) {
    for (int it = blockIdx.x; it < NB * HA * 32; it += gridDim.x) moba_own_item(p, lds, it);
}


#define XB_TMO      128
#define XB_XCNT(j)  (256  + 64 * (j))
#define XB_XSUB(j)  (1280 + 64 * (j))
#define XB_XGEN(j)  (2304 + 64 * (j))
#define XB_TOP      3328
#define XB_TOPGEN   3392
#define XB_SPIN_CAP (1u << 22)
DEVINL unsigned xb_ld(unsigned* p)              { return __hip_atomic_load(p, __ATOMIC_RELAXED, __HIP_MEMORY_SCOPE_AGENT); }
DEVINL unsigned xb_add(unsigned* p, unsigned v) { return __hip_atomic_fetch_add(p, v, __ATOMIC_RELAXED, __HIP_MEMORY_SCOPE_AGENT); }
DEVINL unsigned xb_xcc_id() { return (unsigned)__builtin_amdgcn_s_getreg((3 << 11) | 20) & 0xFu; }
#define XB_SPIN(cond, bar) do { unsigned _sp = 0; while (cond) { __builtin_amdgcn_s_sleep(1); \
    if ((++_sp & 255u) == 0u) { if (xb_ld(&(bar)[XB_TMO])) break; if (_sp > XB_SPIN_CAP) { atomicAdd(&(bar)[XB_TMO], 1u); break; } } } } while (0)
struct XcdBarrier { unsigned* bar; unsigned x; volatile LAS unsigned* st; };
DEVINL XcdBarrier xcd_barrier_post(unsigned* bar, volatile LAS unsigned* st) {
    XcdBarrier b; b.bar = bar; b.x = xb_xcc_id(); b.st = st;
    if (threadIdx.x == 0) (void)xb_add(&bar[XB_XCNT(b.x)], 1u);
    return b;
}
DEVINL void xcd_barrier_complete(unsigned* bar, unsigned x, unsigned& nloc, unsigned& nx) {
    const unsigned G = gridDim.x * gridDim.y * gridDim.z;
    unsigned sum, cnt, mine, sp = 0u;
    for (;;) {
        sum = 0u; cnt = 0u; mine = 0u;
#pragma unroll
        for (unsigned j = 0; j < 16; ++j) { const unsigned c = xb_ld(&bar[XB_XCNT(j)]); sum += c; cnt += (c > 0u) ? 1u : 0u; mine = (j == x) ? c : mine; }
        if (sum == G) break;
        __builtin_amdgcn_s_sleep(1);
        if ((++sp & 255u) == 0u) { if (xb_ld(&bar[XB_TMO])) break; if (sp > XB_SPIN_CAP) { atomicAdd(&bar[XB_TMO], 1u); break; } }
    }
    nloc = mine > 0u ? mine : 1u; nx = cnt > 0u ? cnt : 1u;
}
DEVINL void xcd_barrier(const XcdBarrier& b) {
    asm volatile("s_waitcnt vmcnt(0)" ::: "memory");
    __syncthreads();
    if (threadIdx.x == 0) {
        unsigned* bar = b.bar;
        __builtin_amdgcn_s_waitcnt(0);
        unsigned nloc = b.st[0], nx = b.st[1];
        if (nloc == 0u) { xcd_barrier_complete(bar, b.x, nloc, nx); b.st[0] = nloc; b.st[1] = nx; }
        const unsigned old = xb_add(&bar[XB_XSUB(b.x)], 1u);
        const unsigned gen = old / nloc;
        if (old + 1u == (gen + 1u) * nloc) {
            __builtin_amdgcn_fence(__ATOMIC_RELEASE, "agent");
            asm volatile("s_waitcnt vmcnt(0)" ::: "memory");
            const unsigned og = xb_add(&bar[XB_TOP], 1u);
            const unsigned tg = og / nx;
            if (og + 1u == (tg + 1u) * nx) xb_add(&bar[XB_TOPGEN], 1u);
            else XB_SPIN(xb_ld(&bar[XB_TOPGEN]) == tg, bar);
            __builtin_amdgcn_fence(__ATOMIC_ACQUIRE, "agent");
            xb_add(&bar[XB_XGEN(b.x)], 1u);
            asm volatile("s_waitcnt vmcnt(0)" ::: "memory");
        } else {
            XB_SPIN(xb_ld(&bar[XB_XGEN(b.x)]) == gen, bar);
            __builtin_amdgcn_fence(__ATOMIC_ACQUIRE, "agent");
            asm volatile("s_waitcnt vmcnt(0)" ::: "memory");
        }
    }
    __syncthreads();
}

constexpr int LDS_BYTES = 149504 + 64, LDS_XB = 149504;
#define KERNEL_PROLOGUE __shared__ __attribute__((aligned(16))) char lds[LDS_BYTES];
#ifdef MULTI_LAUNCH
__global__ void __launch_bounds__(NTHR) k_phase0(Params p) { KERNEL_PROLOGUE phase0(p, lds); }
__global__ void __launch_bounds__(NTHR) k_phase1(Params p) { KERNEL_PROLOGUE phase1(p, lds); }
__global__ void __launch_bounds__(NTHR) k_phase2(Params p) { KERNEL_PROLOGUE phase2(p, lds); }
__global__ void __launch_bounds__(NTHR) k_phase3(Params p) { KERNEL_PROLOGUE phase3(p, lds); }
__global__ void __launch_bounds__(NTHR) k_phase4(Params p) { KERNEL_PROLOGUE phase4(p, lds); }
__global__ void __launch_bounds__(NTHR) k_phase5(Params p) { KERNEL_PROLOGUE phase_gates(p, lds); }
__global__ void __launch_bounds__(NTHR) k_phase6(Params p) { KERNEL_PROLOGUE phase_merge(p, lds); }
__global__ void __launch_bounds__(NTHR) k_phase7(Params p) { KERNEL_PROLOGUE phase_out(p, lds); }
__global__ void __launch_bounds__(NTHR) k_phase8(Params p) { phase_final(p); }
#else
__global__ void __launch_bounds__(NTHR) k_mega(Params p) {
    KERNEL_PROLOGUE
    cg::grid_group grid = cg::this_grid();
#ifdef PROBE_A
    int nst = 0;
#define STAMP() do { if (blockIdx.x == 0 && threadIdx.x == 0) ((unsigned*)(p.ws + WS_CTL))[4096 + nst] = (unsigned)__builtin_amdgcn_s_memrealtime(); ++nst; } while (0)
#else
#define STAMP() do { } while (0)
#endif
    volatile LAS unsigned* xst = (volatile LAS unsigned*)(LAS char*)(uintptr_t)(unsigned)(uintptr_t)(lds + LDS_XB);
    if (threadIdx.x == 0) { xst[0] = 0u; xst[1] = 0u; }
    __syncthreads();
    phase0(p, lds);      grid.sync();
    const XcdBarrier bar = xcd_barrier_post((unsigned*)(p.ws + WS_CTL) + CTL_XBAR, xst);
    phase1(p, lds);      xcd_barrier(bar);
    phase2(p, lds);      xcd_barrier(bar);
    phase3(p, lds);      xcd_barrier(bar);
    phase4(p, lds);      xcd_barrier(bar);
    phase_gates(p, lds); xcd_barrier(bar);
    phase_merge(p, lds); xcd_barrier(bar);
    phase_out(p, lds);   xcd_barrier(bar);
    phase_final(p);
}
#endif

extern "C" void kernel_launch(void* const* d_in, const int* in_sizes, int n_in, void* d_out, int out_size, void* d_ws, size_t ws_size, hipStream_t stream) {
    Params p{};
    p.x = (const float*)d_in[0]; p.mem = (const float*)d_in[1]; p.norm_gain = (const float*)d_in[2]; p.w_in = (const float*)d_in[3];
    p.rel_bias = (const float*)d_in[4]; p.mem_gain = (const float*)d_in[5]; p.w_mem_kv = (const float*)d_in[6]; p.w_branch = (const float*)d_in[7];
    p.w_out = (const float*)d_in[8]; p.final_gain = (const float*)d_in[9];
    p.out = (float*)d_out; p.ws = (unsigned char*)d_ws;
#ifdef MULTI_LAUNCH
    const int G = 256;
    hipLaunchKernelGGL(k_phase0, dim3(G), dim3(NTHR), 0, stream, p);
    hipLaunchKernelGGL(k_phase1, dim3(G), dim3(NTHR), 0, stream, p);
    hipLaunchKernelGGL(k_phase2, dim3(G), dim3(NTHR), 0, stream, p);
    hipLaunchKernelGGL(k_phase3, dim3(G), dim3(NTHR), 0, stream, p);
    hipLaunchKernelGGL(k_phase4, dim3(G), dim3(NTHR), 0, stream, p);
    hipLaunchKernelGGL(k_phase5, dim3(G), dim3(NTHR), 0, stream, p);
    hipLaunchKernelGGL(k_phase6, dim3(G), dim3(NTHR), 0, stream, p);
    hipLaunchKernelGGL(k_phase7, dim3(G), dim3(NTHR), 0, stream, p);
    hipLaunchKernelGGL(k_phase8, dim3(G), dim3(NTHR), 0, stream, p);
#else
    static int grid = 0;
    if (!grid) {
        int dev = 0, cus = 0, per_cu = 0;
        (void)hipGetDevice(&dev);
        (void)hipDeviceGetAttribute(&cus, hipDeviceAttributeMultiprocessorCount, dev);
        (void)hipOccupancyMaxActiveBlocksPerMultiprocessor(&per_cu, (const void*)k_mega, NTHR, 0);
        if (per_cu < 1) { fprintf(stderr, "kernel_launch: occupancy query says %d blocks/CU\n", per_cu); per_cu = 1; }
        grid = cus;
        if (ws_size < WS_END) fprintf(stderr, "kernel_launch: workspace too small: %zu < %zu\n", ws_size, (size_t)WS_END);
    }
    void* args[] = {&p};
    hipError_t e = hipLaunchCooperativeKernel((const void*)k_mega, dim3(grid), dim3(NTHR), args, 0, stream);
    if (e != hipSuccess) fprintf(stderr, "kernel_launch: cooperative launch failed: %s (grid %d)\n", hipGetErrorString(e), grid);
#endif
}
```

```cpp
#include <hip/hip_runtime.h>
#include <hip/hip_cooperative_groups.h>
#include <stdint.h>
#include <stdio.h>
namespace cg = cooperative_groups;

#define DEVINL __device__ __forceinline__
#define LAS __attribute__((address_space(3)))

typedef unsigned short bf16_t;
typedef short bf16x8 __attribute__((ext_vector_type(8)));
typedef short s16x4 __attribute__((ext_vector_type(4)));
typedef float f32x16 __attribute__((ext_vector_type(16)));
typedef float f32x4 __attribute__((ext_vector_type(4)));
typedef unsigned u32x4 __attribute__((ext_vector_type(4)));
typedef unsigned u32x2 __attribute__((ext_vector_type(2)));

constexpr int NB = 4, SEQ = 8192, DM = 1024, NT = NB * SEQ;
constexpr int HD = 64, HA = 6, HB = 6, HM = 4, WA = 384, WB = 384, WM = 256;
constexpr int NMEM = 256, INW = 7240;
constexpr int NWIN = 7424;
constexpr int NG1 = 33;
constexpr int GATE0 = 4224;
constexpr float EPS = 1e-6f;
constexpr float LOG2E = 1.4426950408889634f;
constexpr float QSCALE = 0.125f * LOG2E;
constexpr float CSCALE = 0.35355339059327373f * 0.125f;
constexpr int NTHR = 512;

constexpr size_t MiB = 1u << 20;
constexpr size_t WS_CTL = 0, WS_WIN = 1 * MiB, WS_WBR = 16 * MiB, WS_WOUT = 18 * MiB, WS_WMEM = 20 * MiB, WS_MEMN = 21 * MiB,
                 WS_MK = 23 * MiB, WS_MV = 23 * MiB + 512 * 1024, WS_KMEAN = 24 * MiB, WS_IW = 25 * MiB, WS_IK = 26 * MiB,
                 WS_LIST = 30 * MiB, WS_IDX = 36 * MiB, WS_IQ = 52 * MiB, WS_QM = 84 * MiB, WS_ZM = 100 * MiB, WS_ACT8 = 116 * MiB,
                 WS_GATES = 308 * MiB, WS_SSQ = 500 * MiB, WS_END = 502 * MiB;
constexpr size_t ACT_STRIDE = (size_t)NT * 384 * 2;
constexpr size_t WS_MERGED = WS_ACT8 + ACT_STRIDE;
constexpr size_t OUT_PO = 0, OUT_PL = 96 * MiB;
constexpr int CTL_WORDS = 2048, CTL_QUEUE = 1024, CTL_XBAR = 8192, XCD_BAR_WORDS = 3456;
constexpr int LIST_PER_BH = 126976;

struct Params {
    const float *x, *mem, *norm_gain, *w_in, *rel_bias, *mem_gain, *w_mem_kv, *w_branch, *w_out, *final_gain;
    float* out; unsigned char* ws;
};

typedef __bf16 bf16x2_t __attribute__((ext_vector_type(2)));
DEVINL unsigned cvtpk(float lo, float hi) { bf16x2_t v; v.x = (__bf16)lo; v.y = (__bf16)hi; return __builtin_bit_cast(unsigned, v); }
DEVINL float bf_lo(unsigned u) { return __uint_as_float(u << 16); }
DEVINL float bf_hi(unsigned u) { return __uint_as_float(u & 0xffff0000u); }
DEVINL float bf2f(bf16_t b) { return __uint_as_float(((unsigned)b) << 16); }
DEVINL float wave_sum(float v) {
#pragma unroll
    for (int o = 1; o < 64; o <<= 1) v += __shfl_xor(v, o);
    return v;
}
DEVINL float wave_max(float v) {
#pragma unroll
    for (int o = 1; o < 64; o <<= 1) v = fmaxf(v, __shfl_xor(v, o));
    return v;
}
DEVINL float fexp2(float x) { return __builtin_amdgcn_exp2f(x); }
DEVINL float fsigm(float z) { return 1.f / (1.f + fexp2(-z * LOG2E)); }
DEVINL float fsilu(float z) { return z * fsigm(z); }
#define LDS_WAIT() asm volatile("s_waitcnt lgkmcnt(0)" ::: "memory")
#define MFMA32(a, b, c) __builtin_amdgcn_mfma_f32_32x32x16_bf16(a, b, c, 0, 0, 0)
DEVINL int crow(int r, int hi) { return (r & 3) + 8 * (r >> 2) + 4 * hi; }
DEVINL int rel_bucket(int d) {
    if (d < 16) return d;
    return 16 + (d >= 19) + (d >= 21) + (d >= 24) + (d >= 27) + (d >= 31) + (d >= 35) + (d >= 40) + (d >= 46) + (d >= 52) + (d >= 59) +
           (d >= 67) + (d >= 77) + (d >= 87) + (d >= 99) + (d >= 113);
}
DEVINL int list_off(int n) { return 8192 * n - 128 * n * (n + 1); }

DEVINL int win_srccol(int n) {
    if (n < 3584) return n;
    if (n < 3840) return n - 3584 + 3656;
    if (n < 4096) return n - 3840 + 3912;
    if (n < 4160) return n - 4096 + 3584;
    if (n < 4168) return n - 4160 + 3648;
    if (n < GATE0) return -1;
    if (n >= GATE0 + 3072) return -1;
    return n - GATE0 + 4168;
}
template <int KIND>
DEVINL void p0_transpose_item(const float* __restrict__ W, int ldw, const float* __restrict__ gain, bf16_t* WT, int K, int item, int nblk, float* scr, int lane) {
    const int kb = item / nblk, nb = item % nblk, k0 = kb * 64, n0 = nb * 32;
    const int n = n0 + (lane & 31);
    const int sc = (KIND == 0) ? win_srccol(n) : n;
#pragma unroll 8
    for (int i = 0; i < 32; ++i) {
        const int kk = 2 * i + (lane >> 5);
        float v = 0.f;
        if (sc >= 0) v = W[(size_t)(k0 + kk) * ldw + sc];
        if (gain) v *= gain[k0 + kk];
        scr[kk * 33 + (lane & 31)] = v;
    }
    LDS_WAIT();
    const int c = lane & 7;
#pragma unroll
    for (int j = 0; j < 4; ++j) {
        const int nn = (lane >> 3) + 8 * j;
        const float* s = scr + (8 * c) * 33 + nn;
        u32x4 o;
        o.x = cvtpk(s[0 * 33], s[1 * 33]); o.y = cvtpk(s[2 * 33], s[3 * 33]); o.z = cvtpk(s[4 * 33], s[5 * 33]); o.w = cvtpk(s[6 * 33], s[7 * 33]);
        *(u32x4*)(WT + (size_t)(n0 + nn) * K + k0 + 8 * c) = o;
    }
    LDS_WAIT();
}
DEVINL void norm_row_bf16(const float* xrow, bf16_t* orow, int lane) {
    const f32x4* xr = (const f32x4*)xrow + lane;
    f32x4 v[4]; float s = 0.f;
#pragma unroll
    for (int j = 0; j < 4; ++j) { v[j] = xr[64 * j]; s += (v[j].x * v[j].x + v[j].y * v[j].y) + (v[j].z * v[j].z + v[j].w * v[j].w); }
    const float rstd = rsqrtf(wave_sum(s) * (1.f / DM) + EPS);
    u32x2* o8 = (u32x2*)orow + lane;
#pragma unroll
    for (int j = 0; j < 4; ++j) { u32x2 w; w.x = cvtpk(v[j].x * rstd, v[j].y * rstd); w.y = cvtpk(v[j].z * rstd, v[j].w * rstd); o8[64 * j] = w; }
}
DEVINL void phase0(const Params& p, char* lds) {
    const int tid = threadIdx.x, lane = tid & 63, wave = tid >> 6;
    const int gw = blockIdx.x * 8 + wave, NGW = gridDim.x * 8;
    unsigned* ctl = (unsigned*)(p.ws + WS_CTL);
    for (int i = blockIdx.x * NTHR + tid; i < CTL_WORDS + XCD_BAR_WORDS; i += gridDim.x * NTHR) ctl[i < CTL_WORDS ? i : CTL_XBAR + (i - CTL_WORDS)] = 0u;
    bf16_t* XN = (bf16_t*)p.out;
    bf16_t* MEMN = (bf16_t*)(p.ws + WS_MEMN);
    for (int r = gw; r < NT + NB * NMEM; r += NGW) {
        if (r < NT) norm_row_bf16(p.x + (size_t)r * DM, XN + (size_t)r * DM, lane);
        else norm_row_bf16(p.mem + (size_t)(r - NT) * DM, MEMN + (size_t)(r - NT) * DM, lane);
    }
    float* scr = (float*)(lds + wave * 8448);
    constexpr int I_WIN = 16 * (NWIN / 32), I_BR = 16 * 32, I_OUT = 16 * 32, I_MEM = 16 * 16;
    for (int it = gw; it < I_WIN + I_BR + I_OUT + I_MEM; it += NGW) {
        int r = it;
        if (r < I_WIN) { p0_transpose_item<0>(p.w_in, INW, p.norm_gain, (bf16_t*)(p.ws + WS_WIN), DM, r, NWIN / 32, scr, lane); continue; } r -= I_WIN;
        if (r < I_BR) { p0_transpose_item<1>(p.w_branch, DM, nullptr, (bf16_t*)(p.ws + WS_WBR), DM, r, 32, scr, lane); continue; } r -= I_BR;
        if (r < I_OUT) { p0_transpose_item<1>(p.w_out, DM, nullptr, (bf16_t*)(p.ws + WS_WOUT), DM, r, 32, scr, lane); continue; } r -= I_OUT;
        p0_transpose_item<1>(p.w_mem_kv, 512, p.mem_gain, (bf16_t*)(p.ws + WS_WMEM), DM, r, 16, scr, lane);
    }
}

constexpr int G_STAGE = 49152, G_AOFF = 0, G_BOFF = 32768;
DEVINL int swz128(int row, int chunk) { return row * 128 + ((chunk ^ ((row >> 1) & 7)) << 4); }
DEVINL void gemm_tile(const bf16_t* __restrict__ A, int lda, const bf16_t* __restrict__ Bt, int ldb, int K, f32x16 (&acc)[2][2], char* lds) {
    const int tid = threadIdx.x, lane = tid & 63, wave = tid >> 6, wm = wave >> 1, wn = wave & 1, r32 = lane & 31, hi = lane >> 5;
    const int lr = tid >> 3, lc = tid & 7;
    const bf16_t* ga = A + (size_t)lr * lda + lc * 8;
    const bf16_t* gb = Bt + (size_t)lr * ldb + lc * 8;
    u32x4 ra[4], rb[2];
#pragma unroll
    for (int j = 0; j < 4; ++j) ra[j] = *(const u32x4*)(ga + (size_t)(64 * j) * lda);
#pragma unroll
    for (int j = 0; j < 2; ++j) rb[j] = *(const u32x4*)(gb + (size_t)(64 * j) * ldb);
#pragma unroll
    for (int j = 0; j < 4; ++j) *(u32x4*)(lds + G_AOFF + swz128(lr + 64 * j, lc)) = ra[j];
#pragma unroll
    for (int j = 0; j < 2; ++j) *(u32x4*)(lds + G_BOFF + swz128(lr + 64 * j, lc)) = rb[j];
    __syncthreads();
    const int nk = K / 64;
    for (int kt = 0; kt < nk; ++kt) {
        const char* st = lds + (kt & 1) * G_STAGE;
        if (kt + 1 < nk) {
#pragma unroll
            for (int j = 0; j < 4; ++j) ra[j] = *(const u32x4*)(ga + (size_t)(64 * j) * lda + (kt + 1) * 64);
#pragma unroll
            for (int j = 0; j < 2; ++j) rb[j] = *(const u32x4*)(gb + (size_t)(64 * j) * ldb + (kt + 1) * 64);
        }
#pragma unroll
        for (int s = 0; s < 4; ++s) {
            const bf16x8 a0 = *(const bf16x8*)(st + G_AOFF + swz128(wm * 64 + r32, 2 * s + hi));
            const bf16x8 a1 = *(const bf16x8*)(st + G_AOFF + swz128(wm * 64 + 32 + r32, 2 * s + hi));
            const bf16x8 b0 = *(const bf16x8*)(st + G_BOFF + swz128(wn * 64 + r32, 2 * s + hi));
            const bf16x8 b1 = *(const bf16x8*)(st + G_BOFF + swz128(wn * 64 + 32 + r32, 2 * s + hi));
            acc[0][0] = MFMA32(b0, a0, acc[0][0]); acc[0][1] = MFMA32(b1, a0, acc[0][1]);
            acc[1][0] = MFMA32(b0, a1, acc[1][0]); acc[1][1] = MFMA32(b1, a1, acc[1][1]);
        }
        if (kt + 1 < nk) {
            char* sn = lds + ((kt + 1) & 1) * G_STAGE;
#pragma unroll
            for (int j = 0; j < 4; ++j) *(u32x4*)(sn + G_AOFF + swz128(lr + 64 * j, lc)) = ra[j];
#pragma unroll
            for (int j = 0; j < 2; ++j) *(u32x4*)(sn + G_BOFF + swz128(lr + 64 * j, lc)) = rb[j];
        }
        __syncthreads();
    }
}
DEVINL void zero_acc(f32x16 (&acc)[2][2]) {
#pragma unroll
    for (int i = 0; i < 2; ++i)
#pragma unroll
        for (int j = 0; j < 2; ++j)
#pragma unroll
            for (int r = 0; r < 16; ++r) acc[i][j][r] = 0.f;
}
constexpr int STG_PITCH = 272;
template <int ACT>
DEVINL void epi_to_lds(const f32x16 (&acc)[2][2], char* lds, float sc) {
    const int tid = threadIdx.x, lane = tid & 63, wave = tid >> 6, wm = wave >> 1, wn = wave & 1, r32 = lane & 31, hi = lane >> 5;
#pragma unroll
    for (int i = 0; i < 2; ++i)
#pragma unroll
        for (int j = 0; j < 2; ++j)
#pragma unroll
            for (int g = 0; g < 4; ++g) {
                float v[4];
#pragma unroll
                for (int e = 0; e < 4; ++e) {
                    float t = acc[i][j][4 * g + e];
                    if (ACT == 1) t *= sc;
                    if (ACT == 2) t = fsilu(t);
                    if (ACT == 3) t = fsigm(t);
                    v[e] = t;
                }
                u32x2 w; w.x = cvtpk(v[0], v[1]); w.y = cvtpk(v[2], v[3]);
                *(u32x2*)(lds + (wm * 64 + 32 * i + r32) * STG_PITCH + (wn * 64 + 32 * j + 8 * g + 4 * hi) * 2) = w;
            }
}
DEVINL void lds_tile_store(char* lds, bf16_t* C, int ldc) {
    const int tid = threadIdx.x;
#pragma unroll
    for (int j = 0; j < 8; ++j) {
        const int row = (tid >> 4) + 32 * j, ch = tid & 15;
        const u32x4 v = *(const u32x4*)(lds + row * STG_PITCH + ch * 16);
        *(u32x4*)(C + (size_t)row * ldc + ch * 8) = v;
    }
}


namespace pg8 {
#define PG8_LAS __attribute__((address_space(3)))
typedef float f32x4 __attribute__((ext_vector_type(4)));
typedef unsigned u32x4 __attribute__((ext_vector_type(4)));
constexpr int BM = 256, BK = 64, HALF = 128, HTB = HALF * BK * 2  , STAGE_BYTES = 8 * HTB, NXCD = 8, WGM = 8;

__host__ __device__ __forceinline__ int lds_byte(int r, int c) { const int st = (r >> 4) * 2 + (c >> 5), rr = r & 15, cc = c & 31, ob = rr * 64 + cc * 2; return st * 1024 + (ob ^ (((ob >> 9) & 1) << 5)); }
__host__ __device__ __forceinline__ void stage_rc(int b, int& R, int& C) { const int st = b / 1024, sb = b % 1024, swz = sb ^ (((sb >> 9) & 1) << 5); R = (st >> 1) * 16 + swz / 64; C = (st & 1) * 32 + (swz % 64) / 2; }
__host__ __device__ __forceinline__ int perm32(int rho) { const int n = rho >> 4, i = rho & 15; return 8 * (i >> 2) + 4 * n + (i & 3); }

struct Unit { int pm, pn; };
struct Gemm { const bf16_t* A; const bf16_t* Bt; int M, N, K; };

struct StaticOrder {
    int nM, nN, nwg, G, c;
    __host__ __device__ void init(int M, int N, int G_, int c_) { nM = M / BM; nN = N / BM; nwg = nM * nN; G = G_; c = c_; }
    __host__ __device__ bool next(int i, Unit& u) const {
        const long L = (long)i * G + c; if (L >= nwg) return false;
        int wgid = (int)L; { const int q = nwg / NXCD, r = nwg % NXCD, xcd = wgid % NXCD, off = wgid / NXCD; wgid = (xcd < r ? xcd * (q + 1) : r * (q + 1) + (xcd - r) * q) + off; }
        const int nig = WGM * nN, gid = wgid / nig, fm = gid * WGM, gsz = (nM - fm) < WGM ? (nM - fm) : WGM;
        u.pm = fm + ((wgid % nig) % gsz); u.pn = (wgid % nig) / gsz; return true;
    }
    __device__ __forceinline__ void a_ready(const Unit&) const {}
    __device__ __forceinline__ void done(const Unit&) const {}
};
template <class Epi, class Sched, bool ALIGN_EPI = false, bool SP2 = false>
__device__ __forceinline__ void gemm_phase(PG8_LAS unsigned char* lds, const Gemm g, const Sched& S, const Epi& E) {
    int tid_ = threadIdx.x; asm volatile("" : "+v"(tid_));
    const int tid = tid_, wid = __builtin_amdgcn_readfirstlane(tid >> 6), lane = tid & 63, wr = wid >> 2, wc = wid & 3, fr = lane & 15, fq = lane >> 4;
    const int K = g.K, nt = K / BK;
    unsigned voffA[2], voffB[2];
#pragma unroll
    for (int i = 0; i < 2; ++i) { int R, C; stage_rc(tid * 16 + i * 8192, R, C); const int Rb = Epi::PERM ? ((R & ~31) + perm32(R & 31)) : R;
        voffA[i] = (unsigned)(R * K + C) * 2u; voffB[i] = (unsigned)(Rb * K + C) * 2u; }
    const size_t kstep = (size_t)(BK * 2);
    const size_t hstep = (size_t)HALF * K * 2;
    const size_t tstep = 2 * hstep;
    const unsigned ldsw = (unsigned)wid * 1024u;
    const int aoff = lds_byte(wr * 64 + fr, fq * 8), boff = lds_byte(wc * 32 + fr, fq * 8);
#define PG8_SA(b, h) (((b) * 2 + (h)) * HTB)
#define PG8_SB(b, h) ((4 + (b) * 2 + (h)) * HTB)
#define PG8_STAGE(bufoff, gbase, voff) do { _Pragma("unroll") for (int _i = 0; _i < 2; ++_i) \
        __builtin_amdgcn_global_load_lds((const unsigned*)((const char*)(gbase) + (voff)[_i]), (PG8_LAS unsigned*)(lds + (bufoff) + ldsw + _i * 8192), 16, 0, 0); } while (0)
#define PG8_LDA(dst, b, h) do { _Pragma("unroll") for (int m = 0; m < 4; ++m) _Pragma("unroll") for (int k = 0; k < 2; ++k) dst[m][k] = *(const PG8_LAS bf16x8*)(lds + PG8_SA(b, h) + aoff + m * 2048 + k * 1024); } while (0)
#define PG8_LDB(dst, b, h) do { _Pragma("unroll") for (int n = 0; n < 2; ++n) _Pragma("unroll") for (int k = 0; k < 2; ++k) dst[n][k] = *(const PG8_LAS bf16x8*)(lds + PG8_SB(b, h) + boff + n * 2048 + k * 1024); } while (0)
#define PG8_MMA(ai, bj, At, Bt) do { __builtin_amdgcn_s_setprio(1); _Pragma("unroll") for (int m = 0; m < 4; ++m) _Pragma("unroll") for (int n = 0; n < 2; ++n) _Pragma("unroll") for (int k = 0; k < 2; ++k) \
        acc[ai][bj][m][n] = __builtin_amdgcn_mfma_f32_16x16x32_bf16(Bt[n][k], At[m][k], acc[ai][bj][m][n], 0, 0, 0); __builtin_amdgcn_s_setprio(0); } while (0)
#define PG8_WAIT_V(n) asm volatile("s_waitcnt vmcnt(" #n ")" ::: "memory")
#define PG8_WAIT_L(n) asm volatile("s_waitcnt lgkmcnt(" #n ")" ::: "memory")
#define PG8_BAR __builtin_amdgcn_s_barrier()
#define PG8_SCHED __builtin_amdgcn_sched_barrier(0)
    Unit cur, nxt; int ui = 0;
    if (!S.next(0, cur)) return;
    f32x4 acc[2][2][4][2];
#pragma unroll
    for (int a = 0; a < 2; ++a)
#pragma unroll
        for (int b = 0; b < 2; ++b)
#pragma unroll
            for (int m = 0; m < 4; ++m)
#pragma unroll
                for (int n = 0; n < 2; ++n) acc[a][b][m][n] = (f32x4){0.f, 0.f, 0.f, 0.f};
    bf16x8 At[4][2], B0[2][2], B1[2][2];
    const char* cA = (const char*)g.A + (size_t)cur.pm * tstep; const char* cB = (const char*)g.Bt + (size_t)cur.pn * tstep;
    S.a_ready(cur);
    if constexpr (SP2) {
        PG8_STAGE(PG8_SB(0, 0), cB, voffB); PG8_STAGE(PG8_SB(0, 1), cB + hstep, voffB); PG8_STAGE(PG8_SA(0, 0), cA, voffA); PG8_STAGE(PG8_SA(0, 1), cA + hstep, voffA);
        if (wr == 1) PG8_BAR;
        PG8_WAIT_V(2); PG8_BAR;
        PG8_STAGE(PG8_SB(1, 0), cB + kstep, voffB); PG8_STAGE(PG8_SA(1, 0), cA + kstep, voffA); PG8_STAGE(PG8_SB(1, 1), cB + hstep + kstep, voffB);
        PG8_WAIT_V(6); PG8_BAR;
    } else {
        PG8_STAGE(PG8_SB(0, 0), cB, voffB); PG8_STAGE(PG8_SA(0, 0), cA, voffA); PG8_STAGE(PG8_SB(0, 1), cB + hstep, voffB); PG8_STAGE(PG8_SA(0, 1), cA + hstep, voffA);
        if (wr == 1) PG8_BAR;
        PG8_WAIT_V(4); PG8_BAR;
        PG8_STAGE(PG8_SB(1, 0), cB + kstep, voffB); PG8_STAGE(PG8_SA(1, 0), cA + kstep, voffA); PG8_STAGE(PG8_SB(1, 1), cB + hstep + kstep, voffB);
        PG8_WAIT_V(6); PG8_BAR;
    }
    for (;;) {
        const bool has_next = S.next(ui + 1, nxt);
        const char* nA = has_next ? (const char*)g.A + (size_t)nxt.pm * tstep : cA; const char* nB = has_next ? (const char*)g.Bt + (size_t)nxt.pn * tstep : cB;
        for (int t = 0; t < nt; t += 2) {
            const bool last = (t == nt - 2);
            const char* a1 = cA + (size_t)(t + 1) * kstep;
            const char* a2 = last ? nA : cA + (size_t)(t + 2) * kstep; const char* b2 = last ? nB : cB + (size_t)(t + 2) * kstep;
            const char* a3 = a2 + kstep; const char* b3 = b2 + kstep;
            if (last && has_next) S.a_ready(nxt);
            if constexpr (SP2) {
            PG8_LDB(B0, 0, 0); PG8_LDB(B1, 0, 1); PG8_SCHED; PG8_LDA(At, 0, 0); PG8_STAGE(PG8_SA(1, 1), a1 + hstep, voffA);
            PG8_WAIT_V(8); PG8_WAIT_L(0); PG8_BAR; PG8_MMA(0, 0, At, B0); PG8_MMA(0, 1, At, B1); PG8_BAR; PG8_SCHED;
            PG8_LDA(At, 0, 1); PG8_STAGE(PG8_SB(0, 0), b2, voffB); PG8_STAGE(PG8_SB(0, 1), b2 + hstep, voffB); PG8_STAGE(PG8_SA(0, 0), a2, voffA);
            PG8_WAIT_V(8); PG8_WAIT_L(0); PG8_BAR; PG8_MMA(1, 0, At, B0); PG8_MMA(1, 1, At, B1); PG8_BAR; PG8_SCHED;
            PG8_LDB(B0, 1, 0); PG8_LDB(B1, 1, 1); PG8_SCHED; PG8_LDA(At, 1, 0); PG8_STAGE(PG8_SA(0, 1), a2 + hstep, voffA);
            PG8_WAIT_V(8); PG8_WAIT_L(0); PG8_BAR; PG8_MMA(0, 0, At, B0); PG8_MMA(0, 1, At, B1); PG8_BAR; PG8_SCHED;
            PG8_LDA(At, 1, 1); PG8_STAGE(PG8_SB(1, 0), b3, voffB); PG8_STAGE(PG8_SB(1, 1), b3 + hstep, voffB); PG8_STAGE(PG8_SA(1, 0), a3, voffA);
            PG8_WAIT_V(8); PG8_WAIT_L(0); PG8_BAR; PG8_MMA(1, 0, At, B0); PG8_MMA(1, 1, At, B1); PG8_BAR; PG8_SCHED;
            } else {
            PG8_LDB(B0, 0, 0); PG8_SCHED; PG8_LDA(At, 0, 0); PG8_STAGE(PG8_SA(1, 1), a1 + hstep, voffA);
            PG8_WAIT_L(8); PG8_BAR; PG8_WAIT_L(0); PG8_MMA(0, 0, At, B0); PG8_BAR; PG8_SCHED;
            PG8_LDB(B1, 0, 1); PG8_STAGE(PG8_SB(0, 0), b2, voffB);
            PG8_BAR; PG8_WAIT_L(0); PG8_MMA(0, 1, At, B1); PG8_BAR;
            PG8_LDA(At, 0, 1); PG8_STAGE(PG8_SA(0, 0), a2, voffA);
            PG8_BAR; PG8_WAIT_L(0); PG8_MMA(1, 0, At, B0); PG8_BAR; PG8_SCHED;
            PG8_STAGE(PG8_SB(0, 1), b2 + hstep, voffB);
            PG8_WAIT_V(6); PG8_BAR; PG8_MMA(1, 1, At, B1); PG8_BAR;
            PG8_LDB(B0, 1, 0); PG8_SCHED; PG8_LDA(At, 1, 0); PG8_STAGE(PG8_SA(0, 1), a2 + hstep, voffA);
            PG8_WAIT_L(8); PG8_BAR; PG8_WAIT_L(0); PG8_MMA(0, 0, At, B0); PG8_BAR; PG8_SCHED;
            PG8_LDB(B1, 1, 1); PG8_STAGE(PG8_SB(1, 0), b3, voffB);
            PG8_BAR; PG8_WAIT_L(0); PG8_MMA(0, 1, At, B1); PG8_BAR;
            PG8_LDA(At, 1, 1); PG8_STAGE(PG8_SA(1, 0), a3, voffA);
            PG8_BAR; PG8_WAIT_L(0); PG8_MMA(1, 0, At, B0); PG8_BAR; PG8_SCHED;
            PG8_STAGE(PG8_SB(1, 1), b3 + hstep, voffB);
            PG8_WAIT_V(6); PG8_BAR; PG8_MMA(1, 1, At, B1); PG8_BAR;
            }
        }
        if constexpr (ALIGN_EPI) { if (wr == 0) PG8_BAR; }
        if constexpr (!Epi::AFTER_DRAIN) { E(acc, cur, wr, wc, fr, fq); S.done(cur); }
        if (!has_next) break;
#pragma unroll
        for (int a = 0; a < 2; ++a)
#pragma unroll
            for (int b = 0; b < 2; ++b)
#pragma unroll
                for (int m = 0; m < 4; ++m)
#pragma unroll
                    for (int n = 0; n < 2; ++n) acc[a][b][m][n] = (f32x4){0.f, 0.f, 0.f, 0.f};
        cur = nxt; cA = nA; cB = nB; ++ui;
        if constexpr (ALIGN_EPI) { if (wr == 1) PG8_BAR; }
    }
    PG8_WAIT_V(0);
    if constexpr (!ALIGN_EPI) { if (wr == 0) PG8_BAR; }
    PG8_BAR;
    if constexpr (Epi::AFTER_DRAIN) { E.fused(acc, cur, wr, wc, fr, fq, lds, wid, lane); S.done(cur); }
#undef PG8_SA
#undef PG8_SB
#undef PG8_STAGE
#undef PG8_LDA
#undef PG8_LDB
#undef PG8_MMA
#undef PG8_WAIT_V
#undef PG8_WAIT_L
#undef PG8_BAR
#undef PG8_SCHED
}
}

DEVINL void proj_store_group(const pg8::f32x4 (&acc)[2][2][4][2], int bj, bf16_t* dst, int ld, int act, size_t row0, int cl0) {
    bf16_t* dp = dst + row0 * ld + cl0;
#pragma unroll
    for (int ai = 0; ai < 2; ++ai)
#pragma unroll
        for (int m = 0; m < 4; ++m) {
            float v[8];
#pragma unroll
            for (int e = 0; e < 4; ++e) { v[e] = bj == 0 ? acc[ai][0][m][0][e] : acc[ai][1][m][0][e]; v[4 + e] = bj == 0 ? acc[ai][0][m][1][e] : acc[ai][1][m][1][e]; }
            if (act == 1) {
#pragma unroll
                for (int e = 0; e < 8; ++e) v[e] *= QSCALE;
            } else if (act == 2) {
#pragma unroll
                for (int e = 0; e < 8; ++e) v[e] = fsilu(v[e]);
            } else if (act == 3) {
#pragma unroll
                for (int e = 0; e < 8; ++e) v[e] = fsigm(v[e]);
            }
            u32x4 w; w.x = cvtpk(v[0], v[1]); w.y = cvtpk(v[2], v[3]); w.z = cvtpk(v[4], v[5]); w.w = cvtpk(v[6], v[7]);
            *(u32x4*)(dp + (size_t)(ai * 128 + m * 16) * ld) = w;
            asm volatile("" ::: "memory");
        }
}
struct EpiProj {
    static constexpr bool PERM = true, AFTER_DRAIN = false;
    unsigned char* ws;
    DEVINL void operator()(const pg8::f32x4 (&acc)[2][2][4][2], const pg8::Unit& u, int wr, int wc, int fr, int fq) const {
#pragma unroll
        for (int bj = 0; bj < 2; ++bj) {
            const int idx = 2 * u.pn + bj;
            if (idx >= 57) continue;
            const size_t row0 = (size_t)u.pm * 256 + wr * 64 + fr;
            const int cl0 = wc * 32 + 8 * fq;
            size_t boff; int ld, act = 0;
            if (idx < 24) { const int g8 = idx / 3; boff = WS_ACT8 + (size_t)g8 * ACT_STRIDE + (idx % 3) * 256; ld = 384; act = (g8 == 0 || g8 == 4) ? 1 : ((g8 == 3 || g8 == 7) ? 2 : 0); }
            else if (idx < 28) { boff = WS_IQ + (idx - 24) * 256; ld = 512; }
            else if (idx < 30) { boff = WS_QM + (idx - 28) * 256; ld = 256; act = 1; }
            else if (idx < 32) { boff = WS_ZM + (idx - 30) * 256; ld = 256; act = 2; }
            else if (idx == 32) { boff = WS_IK; ld = 64; }
            else { boff = WS_GATES + (idx - 33) * 256; ld = 3072; act = 3; }
            if (idx != 32 || wc < 2) proj_store_group(acc, bj, (bf16_t*)(ws + boff), ld, act, row0, cl0);
            if (idx == 32 && wc == 2 && fq == 0) {
                float* IW = (float*)(ws + WS_IW);
#pragma unroll
                for (int ai = 0; ai < 2; ++ai)
#pragma unroll
                    for (int m = 0; m < 4; ++m) {
                        const size_t r = row0 + ai * 128 + m * 16;
                        *(f32x4*)(IW + r * 8) = acc[ai][bj][m][0] * CSCALE; *(f32x4*)(IW + r * 8 + 4) = acc[ai][bj][m][1] * CSCALE;
                    }
            }
            if (idx >= 3 && idx < 6) {
                float cs[8];
#pragma unroll
                for (int e = 0; e < 8; ++e) cs[e] = 0.f;
#pragma unroll
                for (int ai = 0; ai < 2; ++ai)
#pragma unroll
                    for (int m = 0; m < 4; ++m)
#pragma unroll
                        for (int e = 0; e < 4; ++e) { cs[e] += acc[ai][bj][m][0][e]; cs[4 + e] += acc[ai][bj][m][1][e]; }
#pragma unroll
                for (int e = 0; e < 8; ++e) { cs[e] += __shfl_xor(cs[e], 1); cs[e] += __shfl_xor(cs[e], 2); cs[e] += __shfl_xor(cs[e], 4); cs[e] += __shfl_xor(cs[e], 8); }
                if (fr == 0) {
                    float* KM = (float*)(ws + WS_KMEAN) + ((size_t)u.pm * 2 + wr) * 384 + (idx - 3) * 128 + cl0;
                    *(f32x4*)KM = (f32x4){cs[0], cs[1], cs[2], cs[3]}; *(f32x4*)(KM + 4) = (f32x4){cs[4], cs[5], cs[6], cs[7]};
                }
            }
            asm volatile("" ::: "memory");
        }
    }
};
struct EpiOut {
    static constexpr bool PERM = false, AFTER_DRAIN = false;
    const float* x; float* out; float* ssq;
    DEVINL void operator()(const pg8::f32x4 (&acc)[2][2][4][2], const pg8::Unit& u, int wr, int wc, int fr, int fq) const {
#pragma unroll
        for (int ai = 0; ai < 2; ++ai)
#pragma unroll
            for (int m = 0; m < 4; ++m) {
                const size_t row = (size_t)u.pm * 256 + ai * 128 + wr * 64 + m * 16 + fr;
                float ss = 0.f;
#pragma unroll
                for (int bj = 0; bj < 2; ++bj)
#pragma unroll
                    for (int n = 0; n < 2; ++n) {
                        const int col = u.pn * 256 + bj * 128 + wc * 32 + n * 16 + 4 * fq;
                        const f32x4 xv = *(const f32x4*)(x + row * DM + col);
                        const f32x4 y = xv + acc[ai][bj][m][n];
                        ss += (y.x * y.x + y.y * y.y) + (y.z * y.z + y.w * y.w);
                        *(f32x4*)(out + row * DM + col) = y;
                    }
                ss += __shfl_xor(ss, 16); ss += __shfl_xor(ss, 32);
                if (fq == 0) ssq[row * 16 + u.pn * 4 + wc] = ss;
            }
    }
};
DEVINL void phase1(const Params& p, char* lds) {
    {
        pg8::Gemm g{(const bf16_t*)p.out, (const bf16_t*)(p.ws + WS_WIN), NT, NWIN, DM};
        pg8::StaticOrder S; S.init(NT, NWIN, (int)gridDim.x, (int)blockIdx.x);
        EpiProj E{p.ws};
        pg8::gemm_phase<EpiProj, pg8::StaticOrder, true, true>((LAS unsigned char*)lds, g, S, E);
    }
    __syncthreads();
    for (int it = blockIdx.x; it < 16; it += gridDim.x) {
        const int mt = it >> 2, nt = it & 3;
        f32x16 acc[2][2]; zero_acc(acc);
        gemm_tile((const bf16_t*)(p.ws + WS_MEMN) + (size_t)mt * 256 * DM, DM, (const bf16_t*)(p.ws + WS_WMEM) + (size_t)nt * 128 * DM, DM, DM, acc, lds);
        epi_to_lds<0>(acc, lds, 1.f); __syncthreads();
        bf16_t* dst = (bf16_t*)(p.ws + (nt < 2 ? WS_MK : WS_MV)) + (size_t)mt * 256 * 256 + (nt & 1) * 128;
        lds_tile_store(lds, dst, 256); __syncthreads();
    }
}

DEVINL void phase_merge(const Params& p, char* lds) {
    const int tid = threadIdx.x, lane = tid & 63, wave = tid >> 6, wm = wave >> 1, wn = wave & 1, r32 = lane & 31, hi = lane >> 5;
    const bf16_t* WBR = (const bf16_t*)(p.ws + WS_WBR);
    const bf16_t* GATES = (const bf16_t*)(p.ws + WS_GATES);
    for (int it = blockIdx.x; it < 128 * 8; it += gridDim.x) {
        const int nt = it >> 7, mt = it & 127;
        const size_t m0 = (size_t)mt * 256;
        f32x16 acc[2][2]; zero_acc(acc);
#pragma unroll 1
        for (int br = 0; br < 3; ++br) {
            const bf16_t* Y; int ldy, K, koff;
            if (br == 0) { Y = (const bf16_t*)(p.ws + WS_ACT8) + m0 * 384; ldy = 384; K = 384; koff = 0; }
            else if (br == 1) { Y = (const bf16_t*)(p.ws + WS_ACT8 + 4 * ACT_STRIDE) + m0 * 384; ldy = 384; K = 384; koff = 384; }
            else { Y = (const bf16_t*)(p.ws + WS_QM) + m0 * 256; ldy = 256; K = 256; koff = 768; }
            gemm_tile(Y, ldy, WBR + (size_t)nt * 128 * DM + koff, DM, K, acc, lds);
#pragma unroll
            for (int i = 0; i < 2; ++i)
#pragma unroll
                for (int j = 0; j < 2; ++j)
#pragma unroll
                    for (int g = 0; g < 4; ++g) {
                        const size_t m = m0 + wm * 64 + 32 * i + r32;
                        const int n = nt * 128 + wn * 64 + 32 * j + 8 * g + 4 * hi;
                        const u32x2 gw = *(const u32x2*)(GATES + m * 3072 + br * 1024 + n);
                        float f0 = bf_lo(gw.x), f1 = bf_hi(gw.x), f2 = bf_lo(gw.y), f3 = bf_hi(gw.y);
                        if (br < 2) {
                            const u32x2 gn = *(const u32x2*)(GATES + m * 3072 + (br + 1) * 1024 + n);
                            f0 = f0 / bf_lo(gn.x); f1 = f1 / bf_hi(gn.x); f2 = f2 / bf_lo(gn.y); f3 = f3 / bf_hi(gn.y);
                        }
                        acc[i][j][4 * g + 0] *= f0; acc[i][j][4 * g + 1] *= f1; acc[i][j][4 * g + 2] *= f2; acc[i][j][4 * g + 3] *= f3;
                    }
        }
        epi_to_lds<0>(acc, lds, 1.f); __syncthreads();
        lds_tile_store(lds, (bf16_t*)(p.ws + WS_MERGED) + m0 * DM + nt * 128, DM); __syncthreads();
    }
}

DEVINL void phase_out(const Params& p, char* lds) {
    pg8::Gemm g{(const bf16_t*)(p.ws + WS_MERGED), (const bf16_t*)(p.ws + WS_WOUT), NT, DM, DM};
    pg8::StaticOrder S; S.init(NT, DM, (int)gridDim.x, (int)blockIdx.x);
    EpiOut E{p.x, p.out, (float*)(p.ws + WS_SSQ)};
    pg8::gemm_phase<EpiOut, pg8::StaticOrder, true, true>((LAS unsigned char*)lds, g, S, E);
    __syncthreads();
}
DEVINL void phase_final(const Params& p) {
    const int tid = threadIdx.x, lane = tid & 63, wave = tid >> 6;
#ifdef PROBE_A
    const unsigned* tsw = (const unsigned*)(p.ws + WS_CTL) + 4096;
    const float probeA = (float)(tsw[PROBE_A + 1] - tsw[PROBE_A]) * 1e-4f;
    const float probeB = (float)(tsw[PROBE_B + 1] - tsw[PROBE_B]) * 1e-5f;
#endif
    const float* SSQ = (const float*)(p.ws + WS_SSQ);
    for (int r = blockIdx.x * 8 + wave; r < NT; r += gridDim.x * 8) {
        float ss = 0.f;
#pragma unroll
        for (int k = 0; k < 4; ++k) { const f32x4 sv = *(const f32x4*)(SSQ + (size_t)r * 16 + 4 * k); ss += (sv.x + sv.y) + (sv.z + sv.w); }
        const float rstd = rsqrtf(ss * (1.f / DM) + EPS);
        f32x4* yr = (f32x4*)(p.out + (size_t)r * DM) + lane;
        const f32x4* gr = (const f32x4*)p.final_gain + lane;
#pragma unroll
        for (int j = 0; j < 4; ++j) { f32x4 y = yr[64 * j]; const f32x4 g = gr[64 * j]; y.x *= rstd * g.x; y.y *= rstd * g.y; y.z *= rstd * g.z; y.w *= rstd * g.w;
#ifdef PROBE_A
            y.x += probeB; y.y += probeB; y.z += probeB; y.w += probeB; if (r == 0 && j == 0 && lane == 0) y.x += probeA;
#endif
            yr[64 * j] = y; }
    }
}

constexpr int AT_K = 0, AT_V = 32768, AT_VPLANE = 16384 + 64, AT_END = AT_V + 2 * AT_VPLANE;
DEVINL void load_kv_block(const bf16_t* __restrict__ Kg, const bf16_t* __restrict__ Vg, int ld, char* lds) {
    const int tid = threadIdx.x, c = tid & 7, kr = tid >> 3;
    u32x4 kk[4], vv[4];
#pragma unroll
    for (int j = 0; j < 4; ++j) { kk[j] = *(const u32x4*)(Kg + (size_t)(kr + 64 * j) * ld + c * 8); vv[j] = *(const u32x4*)(Vg + (size_t)(kr + 64 * j) * ld + c * 8); }
#pragma unroll
    for (int j = 0; j < 4; ++j) {
        const int key = kr + 64 * j;
        *(u32x4*)(lds + AT_K + swz128(key, c)) = kk[j];
        *(u32x4*)(lds + AT_V + (c >> 2) * AT_VPLANE + key * 64 + (c & 3) * 16) = vv[j];
    }
}
DEVINL s16x4 tr_read(const char* p) {
    typedef short v4i16_t __attribute__((ext_vector_type(4)));
    return __builtin_bit_cast(s16x4, __builtin_amdgcn_ds_read_tr16_b64_v4i16((LAS v4i16_t*)(uintptr_t)(unsigned)(uintptr_t)p));
}
struct AttnState { float mhat, l; f32x16 o0, o1; };
constexpr float ATT_THR = 8.f;
template <int MODE>
DEVINL void attn_256(const bf16x8 (&qf)[4], const char* lds, int t_row, int pos0, const float* lut, float* wsf, AttnState& st) {
    const int lane = threadIdx.x & 63, r32 = lane & 31, hi = lane >> 5;
    const char* KL = lds + AT_K;
    const char* vbase = lds + AT_V + (4 * hi + ((lane & 15) >> 2)) * 64 + ((lane >> 4) & 1) * 32 + (lane & 3) * 8;
    float mhat = 0.f, l = 0.f;
    f32x16 o0, o1;
#pragma unroll
    for (int r = 0; r < 16; ++r) { o0[r] = 0.f; o1[r] = 0.f; }
#pragma unroll 1
    for (int stp = 0; stp < 4; ++stp) {
        f32x16 s0, s1;
#pragma unroll
        for (int r = 0; r < 16; ++r) { s0[r] = 0.f; s1[r] = 0.f; }
#pragma unroll
        for (int s = 0; s < 4; ++s) {
            const bf16x8 k0 = *(const bf16x8*)(KL + swz128(64 * stp + r32, 2 * s + hi));
            const bf16x8 k1 = *(const bf16x8*)(KL + swz128(64 * stp + 32 + r32, 2 * s + hi));
            s0 = MFMA32(k0, qf[s], s0); s1 = MFMA32(k1, qf[s], s1);
        }
        if (MODE == 1) {
#pragma unroll
            for (int r = 0; r < 16; ++r) {
                const int d0 = t_row - (pos0 + 64 * stp + crow(r, hi)), d1 = d0 - 32;
                s0[r] = d0 < 0 ? -INFINITY : s0[r] + lut[d0 > 127 ? 127 : d0];
                s1[r] = d1 < 0 ? -INFINITY : s1[r] + lut[d1 > 127 ? 127 : d1];
            }
        }
        float rm = fmaxf(s0[0], s1[0]);
#pragma unroll
        for (int r = 1; r < 16; ++r) rm = fmaxf(rm, fmaxf(s0[r], s1[r]));
        { auto rr = __builtin_amdgcn_permlane32_swap(__float_as_uint(rm), __float_as_uint(rm), false, false); rm = fmaxf(__uint_as_float(rr[0]), __uint_as_float(rr[1])); }
        if (stp == 0) { mhat = fmaxf(rm, -1e30f); }
        else {
            const float grow = rm - mhat;
            if (__any(grow > ATT_THR)) {
                const float dl = fmaxf(grow, 0.f); mhat += dl;
                const float f = fexp2(-dl); l *= f;
                if (hi == 0) wsf[r32] = f;
                LDS_WAIT();
#pragma unroll
                for (int g = 0; g < 4; ++g) {
                    const f32x4 fv = *(const f32x4*)(wsf + 8 * g + 4 * hi);
                    o0[4 * g + 0] *= fv.x; o0[4 * g + 1] *= fv.y; o0[4 * g + 2] *= fv.z; o0[4 * g + 3] *= fv.w;
                    o1[4 * g + 0] *= fv.x; o1[4 * g + 1] *= fv.y; o1[4 * g + 2] *= fv.z; o1[4 * g + 3] *= fv.w;
                }
                LDS_WAIT();
            }
        }
        float ps = 0.f;
#pragma unroll
        for (int r = 0; r < 16; ++r) { s0[r] = fexp2(s0[r] - mhat); s1[r] = fexp2(s1[r] - mhat); ps += s0[r] + s1[r]; }
        l += ps;
#pragma unroll
        for (int sub = 0; sub < 2; ++sub)
#pragma unroll
            for (int sp = 0; sp < 2; ++sp) {
                u32x4 pw;
                if (sub == 0) { pw.x = cvtpk(s0[8 * sp + 0], s0[8 * sp + 1]); pw.y = cvtpk(s0[8 * sp + 2], s0[8 * sp + 3]); pw.z = cvtpk(s0[8 * sp + 4], s0[8 * sp + 5]); pw.w = cvtpk(s0[8 * sp + 6], s0[8 * sp + 7]); }
                else { pw.x = cvtpk(s1[8 * sp + 0], s1[8 * sp + 1]); pw.y = cvtpk(s1[8 * sp + 2], s1[8 * sp + 3]); pw.z = cvtpk(s1[8 * sp + 4], s1[8 * sp + 5]); pw.w = cvtpk(s1[8 * sp + 6], s1[8 * sp + 7]); }
                const bf16x8 pf = __builtin_bit_cast(bf16x8, pw);
                const int keybase = 64 * stp + 32 * sub + 16 * sp;
                const char* va = vbase + keybase * 64;
                const s16x4 a0 = tr_read(va), a1 = tr_read(va + 512);
                const s16x4 b0 = tr_read(va + AT_VPLANE), b1 = tr_read(va + AT_VPLANE + 512);
                const bf16x8 vf0 = (bf16x8){a0[0], a0[1], a0[2], a0[3], a1[0], a1[1], a1[2], a1[3]};
                const bf16x8 vf1 = (bf16x8){b0[0], b0[1], b0[2], b0[3], b1[0], b1[1], b1[2], b1[3]};
                o0 = MFMA32(pf, vf0, o0); o1 = MFMA32(pf, vf1, o1);
            }
    }
    st.mhat = mhat; st.l = l; st.o0 = o0; st.o1 = o1;
}
DEVINL float half_sum(float v) { auto rr = __builtin_amdgcn_permlane32_swap(__float_as_uint(v), __float_as_uint(v), false, false); return __uint_as_float(rr[0]) + __uint_as_float(rr[1]); }
DEVINL void rows_to_regs(float v, float* wsf, float (&out)[16]) {
    const int lane = threadIdx.x & 63, r32 = lane & 31, hi = lane >> 5;
    LDS_WAIT();
    if (hi == 0) wsf[r32] = v;
    LDS_WAIT();
#pragma unroll
    for (int g = 0; g < 4; ++g) { const f32x4 fv = *(const f32x4*)(wsf + 8 * g + 4 * hi); out[4 * g] = fv.x; out[4 * g + 1] = fv.y; out[4 * g + 2] = fv.z; out[4 * g + 3] = fv.w; }
    LDS_WAIT();
}
DEVINL void build_lut(float* lut, const float* rel_bias, int col) {
    const int tid = threadIdx.x;
    if (tid < 128) lut[tid] = rel_bias[rel_bucket(tid) * 12 + col] * LOG2E;
}

DEVINL void moba_select_item(const Params& p, char* lds, int item) {
    const int tid = threadIdx.x;
    const int b = item / (HA * 16), h = (item / 16) % HA, t = (item % 16) * 512 + tid, own = t >> 8;
    float* km = (float*)lds;
    unsigned* lcnt = (unsigned*)(lds + 8192);
    unsigned* lbase = lcnt + 32;
    const float* KMEAN = (const float*)(p.ws + WS_KMEAN);
    for (int i = tid; i < 2048; i += NTHR) { const size_t o = (size_t)(b * 32 + (i >> 6)) * 768 + h * 64 + (i & 63); km[i] = (KMEAN[o] + KMEAN[o + 384]) * (1.f / 256.f); }
    if (tid < 32) lcnt[tid] = 0u;
    __syncthreads();
    const bf16_t* q = (const bf16_t*)(p.ws + WS_ACT8) + (size_t)(b * SEQ + t) * 384 + h * 64;
    float qv[64];
#pragma unroll
    for (int c = 0; c < 8; ++c) {
        const u32x4 w = *(const u32x4*)(q + c * 8);
        qv[8 * c + 0] = bf_lo(w.x); qv[8 * c + 1] = bf_hi(w.x); qv[8 * c + 2] = bf_lo(w.y); qv[8 * c + 3] = bf_hi(w.y);
        qv[8 * c + 4] = bf_lo(w.z); qv[8 * c + 5] = bf_hi(w.z); qv[8 * c + 6] = bf_lo(w.w); qv[8 * c + 7] = bf_hi(w.w);
    }
    float v0 = -INFINITY, v1 = -INFINITY, v2 = -INFINITY; int i0 = 0, i1 = 1, i2 = 2;
    const int nmax = (((item % 16) * 512 + 511) >> 8);
#pragma unroll 1
    for (int n = 0; n < nmax; ++n) {
        float g = 0.f;
#pragma unroll
        for (int c = 0; c < 16; ++c) { const f32x4 kv = *(const f32x4*)(km + n * 64 + 4 * c); g += qv[4 * c] * kv.x + qv[4 * c + 1] * kv.y + qv[4 * c + 2] * kv.z + qv[4 * c + 3] * kv.w; }
        if (n < own) {
            if (g > v0) { v2 = v1; i2 = i1; v1 = v0; i1 = i0; v0 = g; i0 = n; }
            else if (g > v1) { v2 = v1; i2 = i1; v1 = g; i1 = n; }
            else if (g > v2) { v2 = g; i2 = n; }
        }
    }
    const int nsel = own < 3 ? own : 3;
    unsigned o0 = 0, o1 = 0, o2 = 0;
    if (nsel > 0) o0 = atomicAdd(&lcnt[i0], 1u);
    if (nsel > 1) o1 = atomicAdd(&lcnt[i1], 1u);
    if (nsel > 2) o2 = atomicAdd(&lcnt[i2], 1u);
    __syncthreads();
    unsigned* gcnt = (unsigned*)(p.ws + WS_CTL) + (b * HA + h) * 32;
    if (tid < 32) lbase[tid] = lcnt[tid] ? atomicAdd(&gcnt[tid], lcnt[tid]) : 0u;
    __syncthreads();
    bf16_t* L = (bf16_t*)(p.ws + WS_LIST) + (size_t)(b * HA + h) * LIST_PER_BH;
    if (nsel > 0) L[list_off(i0) + lbase[i0] + o0] = (bf16_t)(t | (0 << 13));
    if (nsel > 1) L[list_off(i1) + lbase[i1] + o1] = (bf16_t)(t | (1 << 13));
    if (nsel > 2) L[list_off(i2) + lbase[i2] + o2] = (bf16_t)(t | (2 << 13));
    __syncthreads();
}

DEVINL void mem_attn_item(const Params& p, char* lds, int item) {
    const int tid = threadIdx.x, lane = tid & 63, wave = tid >> 6, r32 = lane & 31, hi = lane >> 5;
    const int b = item / (HM * 32), h = (item / 32) % HM, qt = item % 32;
    float* wsf = (float*)(lds + AT_END) + wave * 32;
    char* ostg = lds + AT_END + 1024 + wave * 4096;
    load_kv_block((const bf16_t*)(p.ws + WS_MK) + (size_t)b * 256 * 256 + h * 64, (const bf16_t*)(p.ws + WS_MV) + (size_t)b * 256 * 256 + h * 64, 256, lds);
    const size_t row0 = (size_t)b * SEQ + qt * 256 + wave * 32;
    bf16_t* QM = (bf16_t*)(p.ws + WS_QM);
    bf16x8 qf[4];
#pragma unroll
    for (int s = 0; s < 4; ++s) qf[s] = *(const bf16x8*)(QM + (row0 + r32) * 256 + h * 64 + 16 * s + 8 * hi);
    __syncthreads();
    AttnState st;
    attn_256<0>(qf, lds, 0, 0, nullptr, wsf, st);
    const float ltot = half_sum(st.l);
    float rl[16]; rows_to_regs(1.f / ltot, wsf, rl);
#pragma unroll
    for (int r = 0; r < 16; ++r) {
        *(bf16_t*)(ostg + crow(r, hi) * 128 + r32 * 2) = (bf16_t)(cvtpk(st.o0[r] * rl[r], 0.f) & 0xffffu);
        *(bf16_t*)(ostg + crow(r, hi) * 128 + (32 + r32) * 2) = (bf16_t)(cvtpk(st.o1[r] * rl[r], 0.f) & 0xffffu);
    }
    LDS_WAIT();
    const bf16_t* ZM = (const bf16_t*)(p.ws + WS_ZM);
#pragma unroll
    for (int i = 0; i < 4; ++i) {
        const int row = i * 8 + (lane >> 3), ch = lane & 7;
        const u32x4 ov = *(const u32x4*)(ostg + row * 128 + ch * 16);
        const u32x4 zv = *(const u32x4*)(ZM + (row0 + row) * 256 + h * 64 + ch * 8);
        u32x4 w;
        w.x = cvtpk(bf_lo(ov.x) * bf_lo(zv.x), bf_hi(ov.x) * bf_hi(zv.x)); w.y = cvtpk(bf_lo(ov.y) * bf_lo(zv.y), bf_hi(ov.y) * bf_hi(zv.y));
        w.z = cvtpk(bf_lo(ov.z) * bf_lo(zv.z), bf_hi(ov.z) * bf_hi(zv.z)); w.w = cvtpk(bf_lo(ov.w) * bf_lo(zv.w), bf_hi(ov.w) * bf_hi(zv.w));
        *(u32x4*)(QM + (row0 + row) * 256 + h * 64 + ch * 8) = w;
    }
    __syncthreads();
}

constexpr int IXL_META = 0, IXL_CAND = 2048, IX_CAP = 64, IXL_HIST = IXL_CAND + 32 * IX_CAP * 8, IXL_STAGE = IXL_HIST + 65536, IXL_END = IXL_STAGE + 2 * 32768;
struct IxMeta { int need[32]; int nr[32]; int done[32]; int ccnt[32]; int lcnt[32]; int B[3][32]; float lo[3][32]; int flag; };
DEVINL int ix_bin(float s, float lo, float sc) { float v = (s - lo) * sc; v = fminf(fmaxf(v, 0.f), 511.f); return (int)v; }
DEVINL int ix_bin0(float s) { return (int)__builtin_amdgcn_fmed3f(__builtin_fmaf(s, 32.f, 256.f), 0.f, 511.f); }
DEVINL float ix_sc(int r) { return r == 0 ? 32.f : (r == 1 ? 16384.f : 8388608.f); }
DEVINL float relu1(float x) { return __builtin_amdgcn_fmed3f(x, 0.f, 3.0e38f); }
DEVINL f32x16 ix_mma(const bf16x8 (&a)[4], const bf16x8 (&b)[4]) {
    f32x16 acc;
#pragma unroll
    for (int r = 0; r < 16; ++r) acc[r] = 0.f;
#pragma unroll
    for (int s = 0; s < 4; ++s) acc = MFMA32(a[s], b[s], acc);
    return acc;
}
DEVINL void ix_reduce(const f32x16& acc, const f32x4 (&cv)[4], float& sA, float& sB) {
    float pj[4];
#pragma unroll
    for (int j = 0; j < 4; ++j) pj[j] = cv[j].x * relu1(acc[4 * j]) + cv[j].y * relu1(acc[4 * j + 1]) + cv[j].z * relu1(acc[4 * j + 2]) + cv[j].w * relu1(acc[4 * j + 3]);
    auto r02 = __builtin_amdgcn_permlane32_swap(__float_as_uint(pj[0]), __float_as_uint(pj[2]), false, false);
    auto r13 = __builtin_amdgcn_permlane32_swap(__float_as_uint(pj[1]), __float_as_uint(pj[3]), false, false);
    sA = __uint_as_float(r02[0]) + __uint_as_float(r02[1]);
    sB = __uint_as_float(r13[0]) + __uint_as_float(r13[1]);
}
template <int MODE, bool CAUSAL>
DEVINL void ix_tile(const f32x16& acc, const f32x4 (&cv)[4], int t0, int kt, int (&B0r)[2], int (&cnt)[2], IxMeta* meta, char* lds, int round) {
    const int lane = threadIdx.x & 63, wave = threadIdx.x >> 6, r32 = lane & 31, hi = lane >> 5;
    char* histb = lds + IXL_HIST;
    float* cand_s = (float*)(lds + IXL_CAND);
    int* cand_k = (int*)(lds + IXL_CAND + 32 * IX_CAP * 4);
    const int k = 32 * kt + r32;
    float sc2[2];
    ix_reduce(acc, cv, sc2[0], sc2[1]);
#pragma unroll
    for (int q = 0; q < 2; ++q) {
        const float sv = sc2[q];
        const int row = 4 * wave + 2 * hi + q;
        const bool adm = CAUSAL ? (k <= t0 + row) : true;
        const int b0 = ix_bin0(sv);
        if (MODE == 0) {
            if (adm) atomicAdd((unsigned*)(histb + row * 2048 + b0 * 4), 1u);
        } else if (MODE == 2) {
            if (adm && !meta->done[row]) {
                bool eq = (b0 == meta->B[0][row]);
                for (int j = 1; j < round; ++j) eq = eq && (ix_bin(sv, meta->lo[j][row], ix_sc(j)) == meta->B[j][row]);
                if (eq) { const int bb = ix_bin(sv, meta->lo[round][row], ix_sc(round)); atomicAdd((unsigned*)(histb + row * 2048 + bb * 4), 1u); }
            }
        } else {
            const int B0 = B0r[q] & 0xffff;
            bool above = adm && b0 > B0, eqv = adm && b0 == B0;
            if (B0r[q] & 0x10000) {
                if (eqv) {
                    const int nr = meta->nr[row]; int cls = 1;
                    for (int j = 1; j < nr && cls == 1; ++j) { const int bj = ix_bin(sv, meta->lo[j][row], ix_sc(j)), Bj = meta->B[j][row]; if (bj > Bj) cls = 2; else if (bj < Bj) cls = 0; }
                    above = cls == 2; eqv = cls == 1;
                }
            }
            const unsigned long long bal = __ballot(above);
            const unsigned hm = (unsigned)(bal >> (32 * hi));
            const int pos = cnt[q] + __popc(hm & ((1u << r32) - 1u));
            if (above && pos < 256) *(bf16_t*)(histb + row * 2048 + pos * 2) = (bf16_t)k;
            cnt[q] += __popc(hm);
            if (eqv) { const int c = atomicAdd(&meta->ccnt[row], 1); if (c < IX_CAP) { cand_s[row * IX_CAP + c] = sv; cand_k[row * IX_CAP + c] = k; } }
        }
    }
}
template <int MODE, bool LAST>
DEVINL void ix_chunk(const bf16x8 (&af)[4], const f32x4 (&cv)[4], const char* buf, int t0, int kt0, int ktend, int (&B0r)[2], int (&cnt)[2], IxMeta* meta, char* lds, int round) {
    const int lane = threadIdx.x & 63, r32 = lane & 31, hi = lane >> 5;
    bf16x8 bf[4];
#pragma unroll
    for (int s = 0; s < 4; ++s) bf[s] = *(const bf16x8*)(buf + swz128(r32, 2 * s + hi));
    f32x16 acc = ix_mma(af, bf);
#pragma unroll
    for (int t8 = 0; t8 < 8; ++t8) {
        if (!LAST || t8 < ktend) {
            f32x16 accn = acc;
            if (t8 + 1 < 8 && (!LAST || t8 + 1 < ktend)) {
#pragma unroll
                for (int s = 0; s < 4; ++s) bf[s] = *(const bf16x8*)(buf + swz128(32 * (t8 + 1) + r32, 2 * s + hi));
                accn = ix_mma(af, bf);
            }
            ix_tile<MODE, LAST>(acc, cv, t0, kt0 + t8, B0r, cnt, meta, lds, round);
            acc = accn;
        }
    }
}
template <int MODE>
DEVINL void ix_pass(const bf16x8 (&af)[4], const f32x4 (&cv)[4], const bf16_t* IK, int t0, int nkt, int (&B0r)[2], int (&cnt)[2], IxMeta* meta, char* lds, int round) {
    const int tid = threadIdx.x;
    const int lc = tid & 7, lr = tid >> 3;
    const int nch = (nkt + 7) >> 3;
    u32x4 st[4];
#pragma unroll
    for (int j = 0; j < 4; ++j) st[j] = *(const u32x4*)(IK + (size_t)(lr + 64 * j) * 64 + lc * 8);
#pragma unroll
    for (int j = 0; j < 4; ++j) *(u32x4*)(lds + IXL_STAGE + swz128(lr + 64 * j, lc)) = st[j];
    __syncthreads();
#pragma unroll 1
    for (int ch = 0; ch < nch; ++ch) {
        const char* buf = lds + IXL_STAGE + (ch & 1) * 32768;
        if (ch + 1 < nch) {
#pragma unroll
            for (int j = 0; j < 4; ++j) st[j] = *(const u32x4*)(IK + (size_t)(256 * (ch + 1) + lr + 64 * j) * 64 + lc * 8);
            ix_chunk<MODE, false>(af, cv, buf, t0, 8 * ch, 8, B0r, cnt, meta, lds, round);
            char* nb = lds + IXL_STAGE + ((ch + 1) & 1) * 32768;
#pragma unroll
            for (int j = 0; j < 4; ++j) *(u32x4*)(nb + swz128(lr + 64 * j, lc)) = st[j];
        } else {
            ix_chunk<MODE, true>(af, cv, buf, t0, 8 * ch, nkt - 8 * ch, B0r, cnt, meta, lds, round);
        }
        __syncthreads();
    }
}
DEVINL void indexer_item(const Params& p, char* lds, int item) {
    const int tid = threadIdx.x, lane = tid & 63, wave = tid >> 6, r32 = lane & 31, hi = lane >> 5;
    const int b = item >> 8, u = item & 255, qt = (b & 1) ? u : 255 - u, t0 = qt * 32;
    bf16_t* IDX = (bf16_t*)(p.ws + WS_IDX) + ((size_t)b * SEQ + t0) * 256;
    if (t0 < 256) {
#pragma unroll 1
        for (int rr = 0; rr < 4; ++rr) {
            const int row = 4 * wave + rr, n = t0 + row + 1;
#pragma unroll
            for (int k = 0; k < 4; ++k) { const int i = lane + 64 * k; IDX[row * 256 + i] = (bf16_t)(i < n ? i : 0xFFFF); }
        }
        return;
    }
    IxMeta* meta = (IxMeta*)(lds + IXL_META);
    unsigned* hist = (unsigned*)(lds + IXL_HIST);
    __syncthreads();
    if (tid < 32) { meta->need[tid] = 256; meta->nr[tid] = 0; meta->done[tid] = 0; meta->ccnt[tid] = 0; meta->lo[0][tid] = -8.f; }
    const bf16_t* IQ = (const bf16_t*)(p.ws + WS_IQ) + ((size_t)b * SEQ + t0) * 512;
    const bf16_t* IK = (const bf16_t*)(p.ws + WS_IK) + (size_t)b * SEQ * 64;
    const float* IW = (const float*)(p.ws + WS_IW) + ((size_t)b * SEQ + t0) * 8;
    bf16x8 af[4]; f32x4 cv[4];
#pragma unroll
    for (int s = 0; s < 4; ++s) af[s] = *(const bf16x8*)(IQ + (size_t)(4 * wave + (r32 >> 3)) * 512 + (r32 & 7) * 64 + 16 * s + 8 * hi);
#pragma unroll
    for (int j = 0; j < 4; ++j) cv[j] = *(const f32x4*)(IW + (size_t)(4 * wave + j) * 8 + 4 * hi);
    int B0r[2] = {0, 0}, cnt[2] = {0, 0};
    const int nkt = (t0 + 32) / 32;
#pragma unroll 1
    for (int round = 0; round < 3; ++round) {
#pragma unroll
        for (int k = 0; k < 8; ++k) *(u32x4*)(lds + IXL_HIST + (tid + 512 * k) * 16) = (u32x4){0u, 0u, 0u, 0u};
        if (tid == 0) meta->flag = 0;
        __syncthreads();
        if (round == 0) ix_pass<0>(af, cv, IK, t0, nkt, B0r, cnt, meta, lds, 0);
        else ix_pass<2>(af, cv, IK, t0, nkt, B0r, cnt, meta, lds, round);
#pragma unroll 1
        for (int rr = 0; rr < 4; ++rr) {
            const int row = 4 * wave + rr;
            if (meta->done[row]) continue;
            const int need = meta->need[row];
            const u32x4 h0 = *(const u32x4*)(hist + row * 512 + 8 * lane), h1 = *(const u32x4*)(hist + row * 512 + 8 * lane + 4);
            const unsigned c = ((h0[0] + h0[1]) + (h0[2] + h0[3])) + ((h1[0] + h1[1]) + (h1[2] + h1[3]));
            unsigned suf = c;
#pragma unroll
            for (int o = 1; o < 64; o <<= 1) { const unsigned tv = __shfl_down(suf, o); if (lane + o < 64) suf += tv; }
            const unsigned long long bal = __ballot(suf >= (unsigned)need);
            const int Ls = bal ? 63 - __builtin_clzll(bal) : 0;
            const unsigned sufL = __shfl(suf, Ls), cL = __shfl(c, Ls);
            unsigned cum = sufL - cL; int Bs = 8 * Ls; unsigned cb = 0; bool found = false;
#pragma unroll 1
            for (int e = 7; e >= 0; --e) {
                const unsigned hv = hist[row * 512 + 8 * Ls + e];
                if (!found) { if (cum + hv >= (unsigned)need) { Bs = 8 * Ls + e; cb = hv; found = true; } else cum += hv; }
            }
            if (lane == 0) {
                meta->B[round][row] = Bs; meta->need[row] = need - (int)cum; meta->nr[row] = round + 1;
                if (cb > (unsigned)IX_CAP && round < 2) { meta->lo[round + 1][row] = meta->lo[round][row] + (float)Bs / ix_sc(round); meta->flag = 1; }
                else meta->done[row] = 1;
            }
        }
        __syncthreads();
        const int more = meta->flag;
        __syncthreads();
        if (!more) break;
    }
#pragma unroll
    for (int q = 0; q < 2; ++q) { const int row = 4 * wave + 2 * hi + q; B0r[q] = meta->B[0][row] | (meta->nr[row] > 1 ? 0x10000 : 0); }
    ix_pass<1>(af, cv, IK, t0, nkt, B0r, cnt, meta, lds, 0);
    if (r32 == 0) {
#pragma unroll
        for (int q = 0; q < 2; ++q) meta->lcnt[4 * wave + 2 * hi + q] = cnt[q] < 256 ? cnt[q] : 256;
    }
    LDS_WAIT();
    {
        const float* cand_s = (const float*)(lds + IXL_CAND);
        const int* cand_k = (const int*)(lds + IXL_CAND + 32 * IX_CAP * 4);
#pragma unroll 1
        for (int rr = 0; rr < 4; ++rr) {
            const int row = 4 * wave + rr;
            const int c = meta->lcnt[row];
            for (int i = lane; i < c; i += 64) IDX[row * 256 + i] = *(const bf16_t*)(lds + IXL_HIST + row * 2048 + i * 2);
            const int m = meta->ccnt[row] < IX_CAP ? meta->ccnt[row] : IX_CAP, r = meta->need[row], base = 256 - r;
            for (int i = lane; i < m; i += 64) {
                const float si = cand_s[row * IX_CAP + i]; const int ki = cand_k[row * IX_CAP + i];
                int rank = 0;
                for (int j = 0; j < m; ++j) { const float sj = cand_s[row * IX_CAP + j]; const int kj = cand_k[row * IX_CAP + j]; rank += (sj > si || (sj == si && kj < ki)) ? 1 : 0; }
                if (rank < r) IDX[row * 256 + base + rank] = (bf16_t)ki;
            }
        }
    }
    __syncthreads();
}

DEVINL float dot2bf(unsigned a, unsigned b, float c) {
    typedef __bf16 bf2 __attribute__((ext_vector_type(2)));
    return __builtin_amdgcn_fdot2_f32_bf16(__builtin_bit_cast(bf2, a), __builtin_bit_cast(bf2, b), c, false);
}
DEVINL void dsa_item(const Params& p, char* lds, int item, bool dry = false) {
    const int tid = threadIdx.x, lane = tid & 63, wave = tid >> 6, g = lane >> 3, j = lane & 7;
    const int pair = (item & 7) + 8 * (item >> 8), chunk = (item >> 3) & 31;
    const int b = pair / HB, h = pair % HB;
    float* lut = (float*)lds;
    float* pbuf = (float*)(lds + 512) + wave * 256;
    __syncthreads();
    build_lut(lut, p.rel_bias, 6 + h);
    __syncthreads();
    bf16_t* QB = (bf16_t*)(p.ws + WS_ACT8 + 4 * ACT_STRIDE);
    const bf16_t* KB = (const bf16_t*)(p.ws + WS_ACT8 + 5 * ACT_STRIDE) + (size_t)b * SEQ * 384 + h * 64 + 8 * j;
    const bf16_t* VB = (const bf16_t*)(p.ws + WS_ACT8 + 6 * ACT_STRIDE) + (size_t)b * SEQ * 384 + h * 64 + 8 * j;
    const bf16_t* ZB = (const bf16_t*)(p.ws + WS_ACT8 + 7 * ACT_STRIDE);
    const bf16_t* IDX = (const bf16_t*)(p.ws + WS_IDX);
#pragma unroll 1
    for (int qi = 0; qi < 32; ++qi) {
        const int t = chunk * 256 + wave * 32 + qi;
        const size_t row = (size_t)b * SEQ + t;
        const u32x4 qv = *(const u32x4*)(QB + row * 384 + h * 64 + 8 * j);
        const bf16_t* irow = IDX + row * 256 + g * 32;
        u32x4 iv[4];
#pragma unroll
        for (int k = 0; k < 4; ++k) iv[k] = *(const u32x4*)(irow + 8 * k);
        int myk[4];
#pragma unroll
        for (int bt = 0; bt < 4; ++bt) myk[bt] = irow[8 * bt + j];
        float lg[4];
#pragma unroll
        for (int bt = 0; bt < 4; ++bt) {
            float part[8];
#pragma unroll
            for (int i = 0; i < 8; ++i) {
                const int ii = 8 * bt + i;
                const unsigned w = (ii & 1) ? (iv[ii >> 3][(ii >> 1) & 3] >> 16) : (iv[ii >> 3][(ii >> 1) & 3] & 0xffffu);
                const int key = w == 0xFFFFu ? 0 : (int)w;
                const u32x4 kv = *(const u32x4*)(KB + (size_t)key * 384);
                part[i] = dot2bf(kv.w, qv.w, dot2bf(kv.z, qv.z, dot2bf(kv.y, qv.y, dot2bf(kv.x, qv.x, 0.f))));
            }
            float v4[4];
#pragma unroll
            for (int a = 0; a < 4; ++a) { const float keep = (j & 4) ? part[4 + a] : part[a], send = (j & 4) ? part[a] : part[4 + a]; v4[a] = keep + __shfl_xor(send, 4); }
            float v2[2];
#pragma unroll
            for (int a = 0; a < 2; ++a) { const float keep = (j & 2) ? v4[2 + a] : v4[a], send = (j & 2) ? v4[a] : v4[2 + a]; v2[a] = keep + __shfl_xor(send, 2); }
            { const float keep = (j & 1) ? v2[1] : v2[0], send = (j & 1) ? v2[0] : v2[1]; lg[bt] = keep + __shfl_xor(send, 1); }
        }
        float mx = -INFINITY;
#pragma unroll
        for (int bt = 0; bt < 4; ++bt) {
            const int d = t - myk[bt];
            lg[bt] = (myk[bt] == 0xFFFF || d < 0) ? -INFINITY : lg[bt] + lut[d > 127 ? 127 : d];
            mx = fmaxf(mx, lg[bt]);
        }
        mx = wave_max(mx);
        float ls = 0.f;
#pragma unroll
        for (int bt = 0; bt < 4; ++bt) { lg[bt] = fexp2(lg[bt] - mx); ls += lg[bt]; pbuf[g * 32 + 8 * bt + j] = lg[bt]; }
        ls = wave_sum(ls);
        LDS_WAIT();
        float acc[8];
#pragma unroll
        for (int e = 0; e < 8; ++e) acc[e] = 0.f;
#pragma unroll
        for (int k = 0; k < 4; ++k) {
            const f32x4 pa = *(const f32x4*)(pbuf + g * 32 + 8 * k), pb = *(const f32x4*)(pbuf + g * 32 + 8 * k + 4);
            const float pp[8] = {pa.x, pa.y, pa.z, pa.w, pb.x, pb.y, pb.z, pb.w};
#pragma unroll
            for (int i2 = 0; i2 < 4; ++i2) {
                const unsigned wpair = iv[k][i2];
                const unsigned w0 = wpair & 0xffffu, w1 = wpair >> 16;
                const int key0 = w0 == 0xFFFFu ? 0 : (int)w0, key1 = w1 == 0xFFFFu ? 0 : (int)w1;
                const u32x4 va = *(const u32x4*)(VB + (size_t)key0 * 384), vb = *(const u32x4*)(VB + (size_t)key1 * 384);
                const unsigned ppk = cvtpk(pp[2 * i2], pp[2 * i2 + 1]);
#pragma unroll
                for (int w = 0; w < 4; ++w) {
                    const unsigned lo = __builtin_amdgcn_perm(vb[w], va[w], 0x05040100u), hh = __builtin_amdgcn_perm(vb[w], va[w], 0x07060302u);
                    acc[2 * w] = dot2bf(lo, ppk, acc[2 * w]); acc[2 * w + 1] = dot2bf(hh, ppk, acc[2 * w + 1]);
                }
            }
        }
        LDS_WAIT();
        float a4[4];
#pragma unroll
        for (int a = 0; a < 4; ++a) { const float keep = (g & 4) ? acc[4 + a] : acc[a], send = (g & 4) ? acc[a] : acc[4 + a]; a4[a] = keep + __shfl_xor(send, 32); }
        float a2[2];
#pragma unroll
        for (int a = 0; a < 2; ++a) { const float keep = (g & 2) ? a4[2 + a] : a4[a], send = (g & 2) ? a4[a] : a4[2 + a]; a2[a] = keep + __shfl_xor(send, 16); }
        float a1;
        { const float keep = (g & 1) ? a2[1] : a2[0], send = (g & 1) ? a2[0] : a2[1]; a1 = keep + __shfl_xor(send, 8); }
        const int dim = 8 * j + g;
        const float z = bf2f(ZB[row * 384 + h * 64 + dim]);
        bf16_t* dstp = dry ? (bf16_t*)(p.ws + WS_END) + ((row * 384 + h * 64 + dim) & 0x3fffff) : QB + row * 384 + h * 64 + dim;
        *dstp = (bf16_t)(cvtpk(a1 / ls * z, 0.f) & 0xffffu);
    }
}

DEVINL void moba_past_item(const Params& p, char* lds, int b, int h, int n, int c, int cnt) {
    const int tid = threadIdx.x, lane = tid & 63, wave = tid >> 6, r32 = lane & 31, hi = lane >> 5;
    float* lut = (float*)(lds + AT_END);
    float* wsf = (float*)(lds + AT_END + 512) + wave * 32;
    bf16_t* ent = (bf16_t*)(lds + AT_END + 1536);
    char* ostg = lds + AT_END + 2048 + wave * 4096;
    const bf16_t* L = (const bf16_t*)(p.ws + WS_LIST) + (size_t)(b * HA + h) * LIST_PER_BH + list_off(n) + c * 256;
    __syncthreads();
    const int nvalid = cnt - c * 256 < 256 ? cnt - c * 256 : 256;
    if (tid < 256) ent[tid] = tid < nvalid ? L[tid] : L[0];
    build_lut(lut, p.rel_bias, h);
    load_kv_block((const bf16_t*)(p.ws + WS_ACT8 + 1 * ACT_STRIDE) + ((size_t)b * SEQ + n * 256) * 384 + h * 64,
                  (const bf16_t*)(p.ws + WS_ACT8 + 2 * ACT_STRIDE) + ((size_t)b * SEQ + n * 256) * 384 + h * 64, 384, lds);
    __syncthreads();
    if (wave * 32 < nvalid) {
        const int e = ent[wave * 32 + r32], t_row = e & 8191;
        const bf16_t* QA = (const bf16_t*)(p.ws + WS_ACT8);
        bf16x8 qf[4];
#pragma unroll
        for (int s = 0; s < 4; ++s) qf[s] = *(const bf16x8*)(QA + ((size_t)b * SEQ + t_row) * 384 + h * 64 + 16 * s + 8 * hi);
        AttnState st;
        attn_256<1>(qf, lds, t_row, n * 256, lut, wsf, st);
        const float ltot = half_sum(st.l);
        float rl[16]; rows_to_regs(1.f / ltot, wsf, rl);
#pragma unroll
        for (int r = 0; r < 16; ++r) {
            *(bf16_t*)(ostg + crow(r, hi) * 128 + r32 * 2) = (bf16_t)(cvtpk(st.o0[r] * rl[r], 0.f) & 0xffffu);
            *(bf16_t*)(ostg + crow(r, hi) * 128 + (32 + r32) * 2) = (bf16_t)(cvtpk(st.o1[r] * rl[r], 0.f) & 0xffffu);
        }
        LDS_WAIT();
        bf16_t* PO = (bf16_t*)((char*)p.out + OUT_PO);
        float* PL = (float*)((char*)p.out + OUT_PL);
        if (hi == 0 && wave * 32 + r32 < nvalid) PL[(((size_t)b * SEQ + t_row) * HA + h) * 4 + (e >> 13)] = st.mhat + __builtin_amdgcn_logf(ltot);
#pragma unroll
        for (int i = 0; i < 4; ++i) {
            const int row = i * 8 + (lane >> 3), ch = lane & 7;
            if (wave * 32 + row < nvalid) {
                const int e2 = ent[wave * 32 + row];
                *(u32x4*)(PO + ((((size_t)b * SEQ + (e2 & 8191)) * HA + h) * 4 + (e2 >> 13)) * 64 + ch * 8) = *(const u32x4*)(ostg + row * 128 + ch * 16);
            }
        }
    }
    __syncthreads();
}

DEVINL void moba_own_item(const Params& p, char* lds, int item) {
    const int tid = threadIdx.x, lane = tid & 63, wave = tid >> 6, r32 = lane & 31, hi = lane >> 5;
    const int b = item / (HA * 32), h = (item / 32) % HA, n = item % 32;
    float* lut = (float*)(lds + AT_END);
    float* wsf = (float*)(lds + AT_END + 512) + wave * 32;
    float* lse_own = (float*)(lds + AT_END + 1536);
    float* oown = (float*)lds;
    __syncthreads();
    build_lut(lut, p.rel_bias, h);
    const size_t row0 = (size_t)b * SEQ + n * 256;
    load_kv_block((const bf16_t*)(p.ws + WS_ACT8 + 1 * ACT_STRIDE) + row0 * 384 + h * 64, (const bf16_t*)(p.ws + WS_ACT8 + 2 * ACT_STRIDE) + row0 * 384 + h * 64, 384, lds);
    bf16_t* QA = (bf16_t*)(p.ws + WS_ACT8);
    const int t_row = n * 256 + wave * 32 + r32;
    bf16x8 qf[4];
#pragma unroll
    for (int s = 0; s < 4; ++s) qf[s] = *(const bf16x8*)(QA + ((size_t)b * SEQ + t_row) * 384 + h * 64 + 16 * s + 8 * hi);
    __syncthreads();
    AttnState st;
    attn_256<1>(qf, lds, t_row, n * 256, lut, wsf, st);
    const float ltot = half_sum(st.l);
    float rl[16]; rows_to_regs(1.f / ltot, wsf, rl);
    __syncthreads();
    if (hi == 0) lse_own[wave * 32 + r32] = st.mhat + __builtin_amdgcn_logf(ltot);
#pragma unroll
    for (int r = 0; r < 16; ++r) {
        oown[(wave * 32 + crow(r, hi)) * 64 + r32] = st.o0[r] * rl[r];
        oown[(wave * 32 + crow(r, hi)) * 64 + 32 + r32] = st.o1[r] * rl[r];
    }
    __syncthreads();
    const bf16_t* PO = (const bf16_t*)((const char*)p.out + OUT_PO);
    const float* PL = (const float*)((const char*)p.out + OUT_PL);
    const bf16_t* ZA = (const bf16_t*)(p.ws + WS_ACT8 + 3 * ACT_STRIDE);
    const int nsel = n < 3 ? n : 3;
#pragma unroll 1
    for (int k = 0; k < 4; ++k) {
        const int task = tid + 512 * k, row = task >> 3, ch = task & 7;
        const size_t grow = row0 + row;
        const float lo = lse_own[row];
        float ls[3]; float M = lo;
#pragma unroll
        for (int s = 0; s < 3; ++s) { ls[s] = (s < nsel) ? PL[(grow * HA + h) * 4 + s] : -INFINITY; M = fmaxf(M, ls[s]); }
        const float w_own = fexp2(lo - M);
        float wsum = w_own, o[8];
#pragma unroll
        for (int e = 0; e < 8; ++e) o[e] = w_own * oown[row * 64 + ch * 8 + e];
#pragma unroll
        for (int s = 0; s < 3; ++s) {
            if (s < nsel) {
                const float w = fexp2(ls[s] - M); wsum += w;
                const u32x4 pv = *(const u32x4*)(PO + ((grow * HA + h) * 4 + s) * 64 + ch * 8);
                o[0] += w * bf_lo(pv.x); o[1] += w * bf_hi(pv.x); o[2] += w * bf_lo(pv.y); o[3] += w * bf_hi(pv.y);
                o[4] += w * bf_lo(pv.z); o[5] += w * bf_hi(pv.z); o[6] += w * bf_lo(pv.w); o[7] += w * bf_hi(pv.w);
            }
        }
        const float inv = 1.f / wsum;
        const u32x4 zv = *(const u32x4*)(ZA + grow * 384 + h * 64 + ch * 8);
        u32x4 w;
        w.x = cvtpk(o[0] * inv * bf_lo(zv.x), o[1] * inv * bf_hi(zv.x)); w.y = cvtpk(o[2] * inv * bf_lo(zv.y), o[3] * inv * bf_hi(zv.y));
        w.z = cvtpk(o[4] * inv * bf_lo(zv.z), o[5] * inv * bf_hi(zv.z)); w.w = cvtpk(o[6] * inv * bf_lo(zv.w), o[7] * inv * bf_hi(zv.w));
        *(u32x4*)(QA + grow * 384 + h * 64 + ch * 8) = w;
    }
    __syncthreads();
}

DEVINL void phase2(const Params& p, char* lds) {
    for (int it = blockIdx.x; it < NB * 256; it += gridDim.x) indexer_item(p, lds, it);
#if defined(REP) && REP == 3
    for (int it = blockIdx.x; it < NB * 256; it += gridDim.x) indexer_item(p, lds, it);
#endif
    __syncthreads();
    for (int it = blockIdx.x; it < NB * HA * 16; it += gridDim.x) moba_select_item(p, lds, it);
    for (int it = blockIdx.x; it < NB * HM * 32; it += gridDim.x) mem_attn_item(p, lds, it);
}
DEVINL void phase3(const Params& p, char* lds) {
    for (int it = blockIdx.x; it < 768; it += gridDim.x) dsa_item(p, lds, it);
#if defined(REP) && REP == 4
    for (int it = blockIdx.x; it < 768; it += gridDim.x) dsa_item(p, lds, it, true);
#endif
    const unsigned* ctl = (const unsigned*)(p.ws + WS_CTL);
    unsigned* pre = (unsigned*)(lds + AT_END + 2048 + 8 * 4096);
    __syncthreads();
    for (int i = threadIdx.x; i < 744; i += NTHR) pre[i + 1] = (ctl[(i / 31) * 32 + (i % 31)] + 255u) >> 8;
    __syncthreads();
    if (threadIdx.x == 0) { unsigned a = 0; pre[0] = 0; for (int i = 1; i <= 744; ++i) { a += pre[i]; pre[i] = a; } }
    __syncthreads();
    const int total = (int)pre[744];
    for (int ri = blockIdx.x; ri < total; ri += gridDim.x) {
        int lo = 0, hi2 = 744;
        while (hi2 - lo > 1) { const int mid = (lo + hi2) >> 1; if ((int)pre[mid] <= ri) lo = mid; else hi2 = mid; }
        const int bh = lo / 31, n = lo % 31, c = ri - (int)pre[lo];
        moba_past_item(p, lds, bh / HA, bh % HA, n, c, (int)ctl[bh * 32 + n]);
    }
#if defined(REP) && REP == 5
    for (int ri = blockIdx.x; ri < total; ri += gridDim.x) {
        int lo = 0, hi2 = 744;
        while (hi2 - lo > 1) { const int mid = (lo + hi2) >> 1; if ((int)pre[mid] <= ri) lo = mid; else hi2 = mid; }
        const int bh = lo / 31, n = lo % 31, c = ri - (int)pre[lo];
        moba_past_item(p, lds, bh / HA, bh % HA, n, c, (int)ctl[bh * 32 + n]);
    }
#endif
}
DEVINL void phase4(const Params& p, char* lds) {
    for (int it = blockIdx.x; it < NB * HA * 32; it += gridDim.x) moba_own_item(p, lds, it);
}


#define XB_TMO      128
#define XB_XCNT(j)  (256  + 64 * (j))
#define XB_XSUB(j)  (1280 + 64 * (j))
#define XB_XGEN(j)  (2304 + 64 * (j))
#define XB_TOP      3328
#define XB_TOPGEN   3392
#define XB_SPIN_CAP (1u << 22)
DEVINL unsigned xb_ld(unsigned* p)              { return __hip_atomic_load(p, __ATOMIC_RELAXED, __HIP_MEMORY_SCOPE_AGENT); }
DEVINL unsigned xb_add(unsigned* p, unsigned v) { return __hip_atomic_fetch_add(p, v, __ATOMIC_RELAXED, __HIP_MEMORY_SCOPE_AGENT); }
DEVINL unsigned xb_xcc_id() { return (unsigned)__builtin_amdgcn_s_getreg((3 << 11) | 20) & 0xFu; }
#define XB_SPIN(cond, bar) do { unsigned _sp = 0; while (cond) { __builtin_amdgcn_s_sleep(1); \
    if ((++_sp & 255u) == 0u) { if (xb_ld(&(bar)[XB_TMO])) break; if (_sp > XB_SPIN_CAP) { atomicAdd(&(bar)[XB_TMO], 1u); break; } } } } while (0)
struct XcdBarrier { unsigned* bar; unsigned x; volatile LAS unsigned* st; };
DEVINL XcdBarrier xcd_barrier_post(unsigned* bar, volatile LAS unsigned* st) {
    XcdBarrier b; b.bar = bar; b.x = xb_xcc_id(); b.st = st;
    if (threadIdx.x == 0) (void)xb_add(&bar[XB_XCNT(b.x)], 1u);
    return b;
}
DEVINL void xcd_barrier_complete(unsigned* bar, unsigned x, unsigned& nloc, unsigned& nx) {
    const unsigned G = gridDim.x * gridDim.y * gridDim.z;
    unsigned sum, cnt, mine, sp = 0u;
    for (;;) {
        sum = 0u; cnt = 0u; mine = 0u;
#pragma unroll
        for (unsigned j = 0; j < 16; ++j) { const unsigned c = xb_ld(&bar[XB_XCNT(j)]); sum += c; cnt += (c > 0u) ? 1u : 0u; mine = (j == x) ? c : mine; }
        if (sum == G) break;
        __builtin_amdgcn_s_sleep(1);
        if ((++sp & 255u) == 0u) { if (xb_ld(&bar[XB_TMO])) break; if (sp > XB_SPIN_CAP) { atomicAdd(&bar[XB_TMO], 1u); break; } }
    }
    nloc = mine > 0u ? mine : 1u; nx = cnt > 0u ? cnt : 1u;
}
DEVINL void xcd_barrier(const XcdBarrier& b) {
    asm volatile("s_waitcnt vmcnt(0)" ::: "memory");
    __syncthreads();
    if (threadIdx.x == 0) {
        unsigned* bar = b.bar;
        __builtin_amdgcn_s_waitcnt(0);
        unsigned nloc = b.st[0], nx = b.st[1];
        if (nloc == 0u) { xcd_barrier_complete(bar, b.x, nloc, nx); b.st[0] = nloc; b.st[1] = nx; }
        const unsigned old = xb_add(&bar[XB_XSUB(b.x)], 1u);
        const unsigned gen = old / nloc;
        if (old + 1u == (gen + 1u) * nloc) {
            __builtin_amdgcn_fence(__ATOMIC_RELEASE, "agent");
            asm volatile("s_waitcnt vmcnt(0)" ::: "memory");
            const unsigned og = xb_add(&bar[XB_TOP], 1u);
            const unsigned tg = og / nx;
            if (og + 1u == (tg + 1u) * nx) xb_add(&bar[XB_TOPGEN], 1u);
            else XB_SPIN(xb_ld(&bar[XB_TOPGEN]) == tg, bar);
            __builtin_amdgcn_fence(__ATOMIC_ACQUIRE, "agent");
            xb_add(&bar[XB_XGEN(b.x)], 1u);
            asm volatile("s_waitcnt vmcnt(0)" ::: "memory");
        } else {
            XB_SPIN(xb_ld(&bar[XB_XGEN(b.x)]) == gen, bar);
            __builtin_amdgcn_fence(__ATOMIC_ACQUIRE, "agent");
            asm volatile("s_waitcnt vmcnt(0)" ::: "memory");
        }
    }
    __syncthreads();
}

constexpr int LDS_BYTES = 149504 + 64, LDS_XB = 149504;
#define KERNEL_PROLOGUE __shared__ __attribute__((aligned(16))) char lds[LDS_BYTES];
#ifdef MULTI_LAUNCH
__global__ void __launch_bounds__(NTHR) k_phase0(Params p) { KERNEL_PROLOGUE phase0(p, lds); }
__global__ void __launch_bounds__(NTHR) k_phase1(Params p) { KERNEL_PROLOGUE phase1(p, lds); }
__global__ void __launch_bounds__(NTHR) k_phase2(Params p) { KERNEL_PROLOGUE phase2(p, lds); }
__global__ void __launch_bounds__(NTHR) k_phase3(Params p) { KERNEL_PROLOGUE phase3(p, lds); }
__global__ void __launch_bounds__(NTHR) k_phase4(Params p) { KERNEL_PROLOGUE phase4(p, lds); }
__global__ void __launch_bounds__(NTHR) k_phase5(Params p) { KERNEL_PROLOGUE phase_gates(p, lds); }
__global__ void __launch_bounds__(NTHR) k_phase6(Params p) { KERNEL_PROLOGUE phase_merge(p, lds); }
__global__ void __launch_bounds__(NTHR) k_phase7(Params p) { KERNEL_PROLOGUE phase_out(p, lds); }
__global__ void __launch_bounds__(NTHR) k_phase8(Params p) { phase_final(p); }
#else
__global__ void __launch_bounds__(NTHR) k_mega(Params p) {
    KERNEL_PROLOGUE
    cg::grid_group grid = cg::this_grid();
#ifdef PROBE_A
    int nst = 0;
#define STAMP() do { if (blockIdx.x == 0 && threadIdx.x == 0) ((unsigned*)(p.ws + WS_CTL))[4096 + nst] = (unsigned)__builtin_amdgcn_s_memrealtime(); ++nst; } while (0)
#else
#define STAMP() do { } while (0)
#endif
    volatile LAS unsigned* xst = (volatile LAS unsigned*)(LAS char*)(uintptr_t)(unsigned)(uintptr_t)(lds + LDS_XB);
    if (threadIdx.x == 0) { xst[0] = 0u; xst[1] = 0u; }
    __syncthreads();
    phase0(p, lds);      grid.sync();
    const XcdBarrier bar = xcd_barrier_post((unsigned*)(p.ws + WS_CTL) + CTL_XBAR, xst);
    phase1(p, lds);      xcd_barrier(bar);
    phase2(p, lds);      xcd_barrier(bar);
    phase3(p, lds);      xcd_barrier(bar);
    phase4(p, lds);      xcd_barrier(bar);
    phase_merge(p, lds); xcd_barrier(bar);
    phase_out(p, lds);   xcd_barrier(bar);
    phase_final(p);
}
#endif

extern "C" void kernel_launch(void* const* d_in, const int* in_sizes, int n_in, void* d_out, int out_size, void* d_ws, size_t ws_size, hipStream_t stream) {
    Params p{};
    p.x = (const float*)d_in[0]; p.mem = (const float*)d_in[1]; p.norm_gain = (const float*)d_in[2]; p.w_in = (const float*)d_in[3];
    p.rel_bias = (const float*)d_in[4]; p.mem_gain = (const float*)d_in[5]; p.w_mem_kv = (const float*)d_in[6]; p.w_branch = (const float*)d_in[7];
    p.w_out = (const float*)d_in[8]; p.final_gain = (const float*)d_in[9];
    p.out = (float*)d_out; p.ws = (unsigned char*)d_ws;
#ifdef MULTI_LAUNCH
    const int G = 256;
    hipLaunchKernelGGL(k_phase0, dim3(G), dim3(NTHR), 0, stream, p);
    hipLaunchKernelGGL(k_phase1, dim3(G), dim3(NTHR), 0, stream, p);
    hipLaunchKernelGGL(k_phase2, dim3(G), dim3(NTHR), 0, stream, p);
    hipLaunchKernelGGL(k_phase3, dim3(G), dim3(NTHR), 0, stream, p);
    hipLaunchKernelGGL(k_phase4, dim3(G), dim3(NTHR), 0, stream, p);
    hipLaunchKernelGGL(k_phase5, dim3(G), dim3(NTHR), 0, stream, p);
    hipLaunchKernelGGL(k_phase6, dim3(G), dim3(NTHR), 0, stream, p);
    hipLaunchKernelGGL(k_phase7, dim3(G), dim3(NTHR), 0, stream, p);
    hipLaunchKernelGGL(k_phase8, dim3(G), dim3(NTHR), 0, stream, p);
#else
    static int grid = 0;
    if (!grid) {
        int dev = 0, cus = 0, per_cu = 0;
        (void)hipGetDevice(&dev);
        (void)hipDeviceGetAttribute(&cus, hipDeviceAttributeMultiprocessorCount, dev);
        (void)hipOccupancyMaxActiveBlocksPerMultiprocessor(&per_cu, (const void*)k_mega, NTHR, 0);
        if (per_cu < 1) { fprintf(stderr, "kernel_launch: occupancy query says %d blocks/CU\n", per_cu); per_cu = 1; }
        grid = cus;
        if (ws_size < WS_END) fprintf(stderr, "kernel_launch: workspace too small: %zu < %zu\n", ws_size, (size_t)WS_END);
    }
    void* args[] = {&p};
    hipError_t e = hipLaunchCooperativeKernel((const void*)k_mega, dim3(grid), dim3(NTHR), args, 0, stream);
    if (e != hipSuccess) fprintf(stderr, "kernel_launch: cooperative launch failed: %s (grid %d)\n", hipGetErrorString(e), grid);
#endif
}
```

```cpp
#include <hip/hip_runtime.h>
#include <hip/hip_cooperative_groups.h>
#include <stdint.h>
#include <stdio.h>
namespace cg = cooperative_groups;

#define DEVINL __device__ __forceinline__
#define LAS __attribute__((address_space(3)))

typedef unsigned short bf16_t;
typedef short bf16x8 __attribute__((ext_vector_type(8)));
typedef short s16x4 __attribute__((ext_vector_type(4)));
typedef float f32x16 __attribute__((ext_vector_type(16)));
typedef float f32x4 __attribute__((ext_vector_type(4)));
typedef unsigned u32x4 __attribute__((ext_vector_type(4)));
typedef unsigned u32x2 __attribute__((ext_vector_type(2)));

constexpr int NB = 4, SEQ = 8192, DM = 1024, NT = NB * SEQ;
constexpr int HD = 64, HA = 6, HB = 6, HM = 4, WA = 384, WB = 384, WM = 256;
constexpr int NMEM = 256, INW = 7240;
constexpr int NWIN = 7424;
constexpr int NG1 = 33;
constexpr int GATE0 = 4224;
constexpr float EPS = 1e-6f;
constexpr float LOG2E = 1.4426950408889634f;
constexpr float QSCALE = 0.125f * LOG2E;
constexpr float CSCALE = 0.35355339059327373f * 0.125f;
constexpr int NTHR = 512;

constexpr size_t MiB = 1u << 20;
constexpr size_t WS_CTL = 0, WS_WIN = 1 * MiB, WS_WBR = 16 * MiB, WS_WOUT = 18 * MiB, WS_WMEM = 20 * MiB, WS_MEMN = 21 * MiB,
                 WS_MK = 23 * MiB, WS_MV = 23 * MiB + 512 * 1024, WS_KMEAN = 24 * MiB, WS_IW = 25 * MiB, WS_IK = 26 * MiB,
                 WS_LIST = 30 * MiB, WS_IDX = 36 * MiB, WS_IQ = 52 * MiB, WS_QM = 84 * MiB, WS_ZM = 100 * MiB, WS_ACT8 = 116 * MiB,
                 WS_GATES = 308 * MiB, WS_SSQ = 500 * MiB, WS_END = 502 * MiB;
constexpr size_t ACT_STRIDE = (size_t)NT * 384 * 2;
constexpr size_t WS_MERGED = WS_ACT8 + ACT_STRIDE;
constexpr size_t OUT_PO = 0, OUT_PL = 96 * MiB;
constexpr int CTL_WORDS = 2048, CTL_QUEUE = 1024, CTL_XBAR = 8192, XCD_BAR_WORDS = 3456;
constexpr int LIST_PER_BH = 126976;

struct Params {
    const float *x, *mem, *norm_gain, *w_in, *rel_bias, *mem_gain, *w_mem_kv, *w_branch, *w_out, *final_gain;
    float* out; unsigned char* ws;
};

typedef __bf16 bf16x2_t __attribute__((ext_vector_type(2)));
DEVINL unsigned cvtpk(float lo, float hi) { bf16x2_t v; v.x = (__bf16)lo; v.y = (__bf16)hi; return __builtin_bit_cast(unsigned, v); }
DEVINL float bf_lo(unsigned u) { return __uint_as_float(u << 16); }
DEVINL float bf_hi(unsigned u) { return __uint_as_float(u & 0xffff0000u); }
DEVINL float bf2f(bf16_t b) { return __uint_as_float(((unsigned)b) << 16); }
DEVINL float wave_sum(float v) {
#pragma unroll
    for (int o = 1; o < 64; o <<= 1) v += __shfl_xor(v, o);
    return v;
}
DEVINL float wave_max(float v) {
#pragma unroll
    for (int o = 1; o < 64; o <<= 1) v = fmaxf(v, __shfl_xor(v, o));
    return v;
}
DEVINL float fexp2(float x) { return __builtin_amdgcn_exp2f(x); }
DEVINL float fsigm(float z) { return 1.f / (1.f + fexp2(-z * LOG2E)); }
DEVINL float fsilu(float z) { return z * fsigm(z); }
#define LDS_WAIT() asm volatile("s_waitcnt lgkmcnt(0)" ::: "memory")
#define MFMA32(a, b, c) __builtin_amdgcn_mfma_f32_32x32x16_bf16(a, b, c, 0, 0, 0)
DEVINL int crow(int r, int hi) { return (r & 3) + 8 * (r >> 2) + 4 * hi; }
DEVINL int rel_bucket(int d) {
    if (d < 16) return d;
    return 16 + (d >= 19) + (d >= 21) + (d >= 24) + (d >= 27) + (d >= 31) + (d >= 35) + (d >= 40) + (d >= 46) + (d >= 52) + (d >= 59) +
           (d >= 67) + (d >= 77) + (d >= 87) + (d >= 99) + (d >= 113);
}
DEVINL int list_off(int n) { return 8192 * n - 128 * n * (n + 1); }

DEVINL int win_srccol(int n) {
    if (n < 3584) return n;
    if (n < 3840) return n - 3584 + 3656;
    if (n < 4096) return n - 3840 + 3912;
    if (n < 4160) return n - 4096 + 3584;
    if (n < 4168) return n - 4160 + 3648;
    if (n < GATE0) return -1;
    if (n >= GATE0 + 3072) return -1;
    return n - GATE0 + 4168;
}
template <int KIND>
DEVINL void p0_transpose_item(const float* __restrict__ W, int ldw, const float* __restrict__ gain, bf16_t* WT, int K, int item, int nblk, float* scr, int lane) {
    const int kb = item / nblk, nb = item % nblk, k0 = kb * 64, n0 = nb * 32;
    const int n = n0 + (lane & 31);
    const int sc = (KIND == 0) ? win_srccol(n) : n;
#pragma unroll 8
    for (int i = 0; i < 32; ++i) {
        const int kk = 2 * i + (lane >> 5);
        float v = 0.f;
        if (sc >= 0) v = W[(size_t)(k0 + kk) * ldw + sc];
        if (gain) v *= gain[k0 + kk];
        scr[kk * 33 + (lane & 31)] = v;
    }
    LDS_WAIT();
    const int c = lane & 7;
#pragma unroll
    for (int j = 0; j < 4; ++j) {
        const int nn = (lane >> 3) + 8 * j;
        const float* s = scr + (8 * c) * 33 + nn;
        u32x4 o;
        o.x = cvtpk(s[0 * 33], s[1 * 33]); o.y = cvtpk(s[2 * 33], s[3 * 33]); o.z = cvtpk(s[4 * 33], s[5 * 33]); o.w = cvtpk(s[6 * 33], s[7 * 33]);
        *(u32x4*)(WT + (size_t)(n0 + nn) * K + k0 + 8 * c) = o;
    }
    LDS_WAIT();
}
DEVINL void norm_row_bf16(const float* xrow, bf16_t* orow, int lane) {
    const f32x4* xr = (const f32x4*)xrow + lane;
    f32x4 v[4]; float s = 0.f;
#pragma unroll
    for (int j = 0; j < 4; ++j) { v[j] = xr[64 * j]; s += (v[j].x * v[j].x + v[j].y * v[j].y) + (v[j].z * v[j].z + v[j].w * v[j].w); }
    const float rstd = rsqrtf(wave_sum(s) * (1.f / DM) + EPS);
    u32x2* o8 = (u32x2*)orow + lane;
#pragma unroll
    for (int j = 0; j < 4; ++j) { u32x2 w; w.x = cvtpk(v[j].x * rstd, v[j].y * rstd); w.y = cvtpk(v[j].z * rstd, v[j].w * rstd); o8[64 * j] = w; }
}
DEVINL void phase0(const Params& p, char* lds) {
    const int tid = threadIdx.x, lane = tid & 63, wave = tid >> 6;
    const int gw = blockIdx.x * 8 + wave, NGW = gridDim.x * 8;
    unsigned* ctl = (unsigned*)(p.ws + WS_CTL);
    for (int i = blockIdx.x * NTHR + tid; i < CTL_WORDS + XCD_BAR_WORDS; i += gridDim.x * NTHR) ctl[i < CTL_WORDS ? i : CTL_XBAR + (i - CTL_WORDS)] = 0u;
    bf16_t* XN = (bf16_t*)p.out;
    bf16_t* MEMN = (bf16_t*)(p.ws + WS_MEMN);
    for (int r = gw; r < NT + NB * NMEM; r += NGW) {
        if (r < NT) norm_row_bf16(p.x + (size_t)r * DM, XN + (size_t)r * DM, lane);
        else norm_row_bf16(p.mem + (size_t)(r - NT) * DM, MEMN + (size_t)(r - NT) * DM, lane);
    }
    float* scr = (float*)(lds + wave * 8448);
    constexpr int I_WIN = 16 * (NWIN / 32), I_BR = 16 * 32, I_OUT = 16 * 32, I_MEM = 16 * 16;
    for (int it = gw; it < I_WIN + I_BR + I_OUT + I_MEM; it += NGW) {
        int r = it;
        if (r < I_WIN) { p0_transpose_item<0>(p.w_in, INW, p.norm_gain, (bf16_t*)(p.ws + WS_WIN), DM, r, NWIN / 32, scr, lane); continue; } r -= I_WIN;
        if (r < I_BR) { p0_transpose_item<1>(p.w_branch, DM, nullptr, (bf16_t*)(p.ws + WS_WBR), DM, r, 32, scr, lane); continue; } r -= I_BR;
        if (r < I_OUT) { p0_transpose_item<1>(p.w_out, DM, nullptr, (bf16_t*)(p.ws + WS_WOUT), DM, r, 32, scr, lane); continue; } r -= I_OUT;
        p0_transpose_item<1>(p.w_mem_kv, 512, p.mem_gain, (bf16_t*)(p.ws + WS_WMEM), DM, r, 16, scr, lane);
    }
}

constexpr int G_STAGE = 49152, G_AOFF = 0, G_BOFF = 32768;
DEVINL int swz128(int row, int chunk) { return row * 128 + ((chunk ^ ((row >> 1) & 7)) << 4); }
DEVINL void gemm_tile(const bf16_t* __restrict__ A, int lda, const bf16_t* __restrict__ Bt, int ldb, int K, f32x16 (&acc)[2][2], char* lds) {
    const int tid = threadIdx.x, lane = tid & 63, wave = tid >> 6, wm = wave >> 1, wn = wave & 1, r32 = lane & 31, hi = lane >> 5;
    const int lr = tid >> 3, lc = tid & 7;
    const bf16_t* ga = A + (size_t)lr * lda + lc * 8;
    const bf16_t* gb = Bt + (size_t)lr * ldb + lc * 8;
    u32x4 ra[4], rb[2];
#pragma unroll
    for (int j = 0; j < 4; ++j) ra[j] = *(const u32x4*)(ga + (size_t)(64 * j) * lda);
#pragma unroll
    for (int j = 0; j < 2; ++j) rb[j] = *(const u32x4*)(gb + (size_t)(64 * j) * ldb);
#pragma unroll
    for (int j = 0; j < 4; ++j) *(u32x4*)(lds + G_AOFF + swz128(lr + 64 * j, lc)) = ra[j];
#pragma unroll
    for (int j = 0; j < 2; ++j) *(u32x4*)(lds + G_BOFF + swz128(lr + 64 * j, lc)) = rb[j];
    __syncthreads();
    const int nk = K / 64;
    for (int kt = 0; kt < nk; ++kt) {
        const char* st = lds + (kt & 1) * G_STAGE;
        if (kt + 1 < nk) {
#pragma unroll
            for (int j = 0; j < 4; ++j) ra[j] = *(const u32x4*)(ga + (size_t)(64 * j) * lda + (kt + 1) * 64);
#pragma unroll
            for (int j = 0; j < 2; ++j) rb[j] = *(const u32x4*)(gb + (size_t)(64 * j) * ldb + (kt + 1) * 64);
        }
#pragma unroll
        for (int s = 0; s < 4; ++s) {
            const bf16x8 a0 = *(const bf16x8*)(st + G_AOFF + swz128(wm * 64 + r32, 2 * s + hi));
            const bf16x8 a1 = *(const bf16x8*)(st + G_AOFF + swz128(wm * 64 + 32 + r32, 2 * s + hi));
            const bf16x8 b0 = *(const bf16x8*)(st + G_BOFF + swz128(wn * 64 + r32, 2 * s + hi));
            const bf16x8 b1 = *(const bf16x8*)(st + G_BOFF + swz128(wn * 64 + 32 + r32, 2 * s + hi));
            acc[0][0] = MFMA32(b0, a0, acc[0][0]); acc[0][1] = MFMA32(b1, a0, acc[0][1]);
            acc[1][0] = MFMA32(b0, a1, acc[1][0]); acc[1][1] = MFMA32(b1, a1, acc[1][1]);
        }
        if (kt + 1 < nk) {
            char* sn = lds + ((kt + 1) & 1) * G_STAGE;
#pragma unroll
            for (int j = 0; j < 4; ++j) *(u32x4*)(sn + G_AOFF + swz128(lr + 64 * j, lc)) = ra[j];
#pragma unroll
            for (int j = 0; j < 2; ++j) *(u32x4*)(sn + G_BOFF + swz128(lr + 64 * j, lc)) = rb[j];
        }
        __syncthreads();
    }
}
DEVINL void zero_acc(f32x16 (&acc)[2][2]) {
#pragma unroll
    for (int i = 0; i < 2; ++i)
#pragma unroll
        for (int j = 0; j < 2; ++j)
#pragma unroll
            for (int r = 0; r < 16; ++r) acc[i][j][r] = 0.f;
}
constexpr int STG_PITCH = 272;
template <int ACT>
DEVINL void epi_to_lds(const f32x16 (&acc)[2][2], char* lds, float sc) {
    const int tid = threadIdx.x, lane = tid & 63, wave = tid >> 6, wm = wave >> 1, wn = wave & 1, r32 = lane & 31, hi = lane >> 5;
#pragma unroll
    for (int i = 0; i < 2; ++i)
#pragma unroll
        for (int j = 0; j < 2; ++j)
#pragma unroll
            for (int g = 0; g < 4; ++g) {
                float v[4];
#pragma unroll
                for (int e = 0; e < 4; ++e) {
                    float t = acc[i][j][4 * g + e];
                    if (ACT == 1) t *= sc;
                    if (ACT == 2) t = fsilu(t);
                    if (ACT == 3) t = fsigm(t);
                    v[e] = t;
                }
                u32x2 w; w.x = cvtpk(v[0], v[1]); w.y = cvtpk(v[2], v[3]);
                *(u32x2*)(lds + (wm * 64 + 32 * i + r32) * STG_PITCH + (wn * 64 + 32 * j + 8 * g + 4 * hi) * 2) = w;
            }
}
DEVINL void lds_tile_store(char* lds, bf16_t* C, int ldc) {
    const int tid = threadIdx.x;
#pragma unroll
    for (int j = 0; j < 8; ++j) {
        const int row = (tid >> 4) + 32 * j, ch = tid & 15;
        const u32x4 v = *(const u32x4*)(lds + row * STG_PITCH + ch * 16);
        *(u32x4*)(C + (size_t)row * ldc + ch * 8) = v;
    }
}


namespace pg8 {
#define PG8_LAS __attribute__((address_space(3)))
typedef float f32x4 __attribute__((ext_vector_type(4)));
typedef unsigned u32x4 __attribute__((ext_vector_type(4)));
constexpr int BM = 256, BK = 64, HALF = 128, HTB = HALF * BK * 2  , STAGE_BYTES = 8 * HTB, NXCD = 8, WGM = 8;

__host__ __device__ __forceinline__ int lds_byte(int r, int c) { const int st = (r >> 4) * 2 + (c >> 5), rr = r & 15, cc = c & 31, ob = rr * 64 + cc * 2; return st * 1024 + (ob ^ (((ob >> 9) & 1) << 5)); }
__host__ __device__ __forceinline__ void stage_rc(int b, int& R, int& C) { const int st = b / 1024, sb = b % 1024, swz = sb ^ (((sb >> 9) & 1) << 5); R = (st >> 1) * 16 + swz / 64; C = (st & 1) * 32 + (swz % 64) / 2; }
__host__ __device__ __forceinline__ int perm32(int rho) { const int n = rho >> 4, i = rho & 15; return 8 * (i >> 2) + 4 * n + (i & 3); }

struct Unit { int pm, pn; };
struct Gemm { const bf16_t* A; const bf16_t* Bt; int M, N, K; };

struct StaticOrder {
    int nM, nN, nwg, G, c;
    __host__ __device__ void init(int M, int N, int G_, int c_) { nM = M / BM; nN = N / BM; nwg = nM * nN; G = G_; c = c_; }
    __host__ __device__ bool next(int i, Unit& u) const {
        const long L = (long)i * G + c; if (L >= nwg) return false;
        int wgid = (int)L; { const int q = nwg / NXCD, r = nwg % NXCD, xcd = wgid % NXCD, off = wgid / NXCD; wgid = (xcd < r ? xcd * (q + 1) : r * (q + 1) + (xcd - r) * q) + off; }
        const int nig = WGM * nN, gid = wgid / nig, fm = gid * WGM, gsz = (nM - fm) < WGM ? (nM - fm) : WGM;
        u.pm = fm + ((wgid % nig) % gsz); u.pn = (wgid % nig) / gsz; return true;
    }
    __device__ __forceinline__ void a_ready(const Unit&) const {}
    __device__ __forceinline__ void done(const Unit&) const {}
};
template <class Epi, class Sched, bool ALIGN_EPI = false, bool SP2 = false>
__device__ __forceinline__ void gemm_phase(PG8_LAS unsigned char* lds, const Gemm g, const Sched& S, const Epi& E) {
    int tid_ = threadIdx.x; asm volatile("" : "+v"(tid_));
    const int tid = tid_, wid = __builtin_amdgcn_readfirstlane(tid >> 6), lane = tid & 63, wr = wid >> 2, wc = wid & 3, fr = lane & 15, fq = lane >> 4;
    const int K = g.K, nt = K / BK;
    unsigned voffA[2], voffB[2];
#pragma unroll
    for (int i = 0; i < 2; ++i) { int R, C; stage_rc(tid * 16 + i * 8192, R, C); const int Rb = Epi::PERM ? ((R & ~31) + perm32(R & 31)) : R;
        voffA[i] = (unsigned)(R * K + C) * 2u; voffB[i] = (unsigned)(Rb * K + C) * 2u; }
    const size_t kstep = (size_t)(BK * 2);
    const size_t hstep = (size_t)HALF * K * 2;
    const size_t tstep = 2 * hstep;
    const unsigned ldsw = (unsigned)wid * 1024u;
    const int aoff = lds_byte(wr * 64 + fr, fq * 8), boff = lds_byte(wc * 32 + fr, fq * 8);
#define PG8_SA(b, h) (((b) * 2 + (h)) * HTB)
#define PG8_SB(b, h) ((4 + (b) * 2 + (h)) * HTB)
#define PG8_STAGE(bufoff, gbase, voff) do { _Pragma("unroll") for (int _i = 0; _i < 2; ++_i) \
        __builtin_amdgcn_global_load_lds((const unsigned*)((const char*)(gbase) + (voff)[_i]), (PG8_LAS unsigned*)(lds + (bufoff) + ldsw + _i * 8192), 16, 0, 0); } while (0)
#define PG8_LDA(dst, b, h) do { _Pragma("unroll") for (int m = 0; m < 4; ++m) _Pragma("unroll") for (int k = 0; k < 2; ++k) dst[m][k] = *(const PG8_LAS bf16x8*)(lds + PG8_SA(b, h) + aoff + m * 2048 + k * 1024); } while (0)
#define PG8_LDB(dst, b, h) do { _Pragma("unroll") for (int n = 0; n < 2; ++n) _Pragma("unroll") for (int k = 0; k < 2; ++k) dst[n][k] = *(const PG8_LAS bf16x8*)(lds + PG8_SB(b, h) + boff + n * 2048 + k * 1024); } while (0)
#define PG8_MMA(ai, bj, At, Bt) do { __builtin_amdgcn_s_setprio(1); _Pragma("unroll") for (int m = 0; m < 4; ++m) _Pragma("unroll") for (int n = 0; n < 2; ++n) _Pragma("unroll") for (int k = 0; k < 2; ++k) \
        acc[ai][bj][m][n] = __builtin_amdgcn_mfma_f32_16x16x32_bf16(Bt[n][k], At[m][k], acc[ai][bj][m][n], 0, 0, 0); __builtin_amdgcn_s_setprio(0); } while (0)
#define PG8_WAIT_V(n) asm volatile("s_waitcnt vmcnt(" #n ")" ::: "memory")
#define PG8_WAIT_L(n) asm volatile("s_waitcnt lgkmcnt(" #n ")" ::: "memory")
#define PG8_BAR __builtin_amdgcn_s_barrier()
#define PG8_SCHED __builtin_amdgcn_sched_barrier(0)
    Unit cur, nxt; int ui = 0;
    if (!S.next(0, cur)) return;
    f32x4 acc[2][2][4][2];
#pragma unroll
    for (int a = 0; a < 2; ++a)
#pragma unroll
        for (int b = 0; b < 2; ++b)
#pragma unroll
            for (int m = 0; m < 4; ++m)
#pragma unroll
                for (int n = 0; n < 2; ++n) acc[a][b][m][n] = (f32x4){0.f, 0.f, 0.f, 0.f};
    bf16x8 At[4][2], B0[2][2], B1[2][2];
    const char* cA = (const char*)g.A + (size_t)cur.pm * tstep; const char* cB = (const char*)g.Bt + (size_t)cur.pn * tstep;
    S.a_ready(cur);
    if constexpr (SP2) {
        PG8_STAGE(PG8_SB(0, 0), cB, voffB); PG8_STAGE(PG8_SB(0, 1), cB + hstep, voffB); PG8_STAGE(PG8_SA(0, 0), cA, voffA); PG8_STAGE(PG8_SA(0, 1), cA + hstep, voffA);
        if (wr == 1) PG8_BAR;
        PG8_WAIT_V(2); PG8_BAR;
        PG8_STAGE(PG8_SB(1, 0), cB + kstep, voffB); PG8_STAGE(PG8_SA(1, 0), cA + kstep, voffA); PG8_STAGE(PG8_SB(1, 1), cB + hstep + kstep, voffB);
        PG8_WAIT_V(6); PG8_BAR;
    } else {
        PG8_STAGE(PG8_SB(0, 0), cB, voffB); PG8_STAGE(PG8_SA(0, 0), cA, voffA); PG8_STAGE(PG8_SB(0, 1), cB + hstep, voffB); PG8_STAGE(PG8_SA(0, 1), cA + hstep, voffA);
        if (wr == 1) PG8_BAR;
        PG8_WAIT_V(4); PG8_BAR;
        PG8_STAGE(PG8_SB(1, 0), cB + kstep, voffB); PG8_STAGE(PG8_SA(1, 0), cA + kstep, voffA); PG8_STAGE(PG8_SB(1, 1), cB + hstep + kstep, voffB);
        PG8_WAIT_V(6); PG8_BAR;
    }
    for (;;) {
        const bool has_next = S.next(ui + 1, nxt);
        const char* nA = has_next ? (const char*)g.A + (size_t)nxt.pm * tstep : cA; const char* nB = has_next ? (const char*)g.Bt + (size_t)nxt.pn * tstep : cB;
        for (int t = 0; t < nt; t += 2) {
            const bool last = (t == nt - 2);
            const char* a1 = cA + (size_t)(t + 1) * kstep;
            const char* a2 = last ? nA : cA + (size_t)(t + 2) * kstep; const char* b2 = last ? nB : cB + (size_t)(t + 2) * kstep;
            const char* a3 = a2 + kstep; const char* b3 = b2 + kstep;
            if (last && has_next) S.a_ready(nxt);
            if constexpr (SP2) {
            PG8_LDB(B0, 0, 0); PG8_LDB(B1, 0, 1); PG8_SCHED; PG8_LDA(At, 0, 0); PG8_STAGE(PG8_SA(1, 1), a1 + hstep, voffA);
            PG8_WAIT_V(8); PG8_WAIT_L(0); PG8_BAR; PG8_MMA(0, 0, At, B0); PG8_MMA(0, 1, At, B1); PG8_BAR; PG8_SCHED;
            PG8_LDA(At, 0, 1); PG8_STAGE(PG8_SB(0, 0), b2, voffB); PG8_STAGE(PG8_SB(0, 1), b2 + hstep, voffB); PG8_STAGE(PG8_SA(0, 0), a2, voffA);
            PG8_WAIT_V(8); PG8_WAIT_L(0); PG8_BAR; PG8_MMA(1, 0, At, B0); PG8_MMA(1, 1, At, B1); PG8_BAR; PG8_SCHED;
            PG8_LDB(B0, 1, 0); PG8_LDB(B1, 1, 1); PG8_SCHED; PG8_LDA(At, 1, 0); PG8_STAGE(PG8_SA(0, 1), a2 + hstep, voffA);
            PG8_WAIT_V(8); PG8_WAIT_L(0); PG8_BAR; PG8_MMA(0, 0, At, B0); PG8_MMA(0, 1, At, B1); PG8_BAR; PG8_SCHED;
            PG8_LDA(At, 1, 1); PG8_STAGE(PG8_SB(1, 0), b3, voffB); PG8_STAGE(PG8_SB(1, 1), b3 + hstep, voffB); PG8_STAGE(PG8_SA(1, 0), a3, voffA);
            PG8_WAIT_V(8); PG8_WAIT_L(0); PG8_BAR; PG8_MMA(1, 0, At, B0); PG8_MMA(1, 1, At, B1); PG8_BAR; PG8_SCHED;
            } else {
            PG8_LDB(B0, 0, 0); PG8_SCHED; PG8_LDA(At, 0, 0); PG8_STAGE(PG8_SA(1, 1), a1 + hstep, voffA);
            PG8_WAIT_L(8); PG8_BAR; PG8_WAIT_L(0); PG8_MMA(0, 0, At, B0); PG8_BAR; PG8_SCHED;
            PG8_LDB(B1, 0, 1); PG8_STAGE(PG8_SB(0, 0), b2, voffB);
            PG8_BAR; PG8_WAIT_L(0); PG8_MMA(0, 1, At, B1); PG8_BAR;
            PG8_LDA(At, 0, 1); PG8_STAGE(PG8_SA(0, 0), a2, voffA);
            PG8_BAR; PG8_WAIT_L(0); PG8_MMA(1, 0, At, B0); PG8_BAR; PG8_SCHED;
            PG8_STAGE(PG8_SB(0, 1), b2 + hstep, voffB);
            PG8_WAIT_V(6); PG8_BAR; PG8_MMA(1, 1, At, B1); PG8_BAR;
            PG8_LDB(B0, 1, 0); PG8_SCHED; PG8_LDA(At, 1, 0); PG8_STAGE(PG8_SA(0, 1), a2 + hstep, voffA);
            PG8_WAIT_L(8); PG8_BAR; PG8_WAIT_L(0); PG8_MMA(0, 0, At, B0); PG8_BAR; PG8_SCHED;
            PG8_LDB(B1, 1, 1); PG8_STAGE(PG8_SB(1, 0), b3, voffB);
            PG8_BAR; PG8_WAIT_L(0); PG8_MMA(0, 1, At, B1); PG8_BAR;
            PG8_LDA(At, 1, 1); PG8_STAGE(PG8_SA(1, 0), a3, voffA);
            PG8_BAR; PG8_WAIT_L(0); PG8_MMA(1, 0, At, B0); PG8_BAR; PG8_SCHED;
            PG8_STAGE(PG8_SB(1, 1), b3 + hstep, voffB);
            PG8_WAIT_V(6); PG8_BAR; PG8_MMA(1, 1, At, B1); PG8_BAR;
            }
        }
        if constexpr (ALIGN_EPI) { if (wr == 0) PG8_BAR; }
        if constexpr (!Epi::AFTER_DRAIN) { E(acc, cur, wr, wc, fr, fq); S.done(cur); }
        if (!has_next) break;
#pragma unroll
        for (int a = 0; a < 2; ++a)
#pragma unroll
            for (int b = 0; b < 2; ++b)
#pragma unroll
                for (int m = 0; m < 4; ++m)
#pragma unroll
                    for (int n = 0; n < 2; ++n) acc[a][b][m][n] = (f32x4){0.f, 0.f, 0.f, 0.f};
        cur = nxt; cA = nA; cB = nB; ++ui;
        if constexpr (ALIGN_EPI) { if (wr == 1) PG8_BAR; }
    }
    PG8_WAIT_V(0);
    if constexpr (!ALIGN_EPI) { if (wr == 0) PG8_BAR; }
    PG8_BAR;
    if constexpr (Epi::AFTER_DRAIN) { E.fused(acc, cur, wr, wc, fr, fq, lds, wid, lane); S.done(cur); }
#undef PG8_SA
#undef PG8_SB
#undef PG8_STAGE
#undef PG8_LDA
#undef PG8_LDB
#undef PG8_MMA
#undef PG8_WAIT_V
#undef PG8_WAIT_L
#undef PG8_BAR
#undef PG8_SCHED
}
}

DEVINL void proj_store_group(const pg8::f32x4 (&acc)[2][2][4][2], int bj, bf16_t* dst, int ld, int act, size_t row0, int cl0) {
    bf16_t* dp = dst + row0 * ld + cl0;
#pragma unroll
    for (int ai = 0; ai < 2; ++ai)
#pragma unroll
        for (int m = 0; m < 4; ++m) {
            float v[8];
#pragma unroll
            for (int e = 0; e < 4; ++e) { v[e] = bj == 0 ? acc[ai][0][m][0][e] : acc[ai][1][m][0][e]; v[4 + e] = bj == 0 ? acc[ai][0][m][1][e] : acc[ai][1][m][1][e]; }
            if (act == 1) {
#pragma unroll
                for (int e = 0; e < 8; ++e) v[e] *= QSCALE;
            } else if (act == 2) {
#pragma unroll
                for (int e = 0; e < 8; ++e) v[e] = fsilu(v[e]);
            } else if (act == 3) {
#pragma unroll
                for (int e = 0; e < 8; ++e) v[e] = fsigm(v[e]);
            }
            u32x4 w; w.x = cvtpk(v[0], v[1]); w.y = cvtpk(v[2], v[3]); w.z = cvtpk(v[4], v[5]); w.w = cvtpk(v[6], v[7]);
            *(u32x4*)(dp + (size_t)(ai * 128 + m * 16) * ld) = w;
            asm volatile("" ::: "memory");
        }
}
struct EpiProj {
    static constexpr bool PERM = true, AFTER_DRAIN = false;
    unsigned char* ws;
    DEVINL void operator()(const pg8::f32x4 (&acc)[2][2][4][2], const pg8::Unit& u, int wr, int wc, int fr, int fq) const {
#pragma unroll
        for (int bj = 0; bj < 2; ++bj) {
            const int idx = 2 * u.pn + bj;
            if (idx >= 57) continue;
            const size_t row0 = (size_t)u.pm * 256 + wr * 64 + fr;
            const int cl0 = wc * 32 + 8 * fq;
            size_t boff; int ld, act = 0;
            if (idx < 24) { const int g8 = idx / 3; boff = WS_ACT8 + (size_t)g8 * ACT_STRIDE + (idx % 3) * 256; ld = 384; act = (g8 == 0 || g8 == 4) ? 1 : ((g8 == 3 || g8 == 7) ? 2 : 0); }
            else if (idx < 28) { boff = WS_IQ + (idx - 24) * 256; ld = 512; }
            else if (idx < 30) { boff = WS_QM + (idx - 28) * 256; ld = 256; act = 1; }
            else if (idx < 32) { boff = WS_ZM + (idx - 30) * 256; ld = 256; act = 2; }
            else if (idx == 32) { boff = WS_IK; ld = 64; }
            else { boff = WS_GATES + (idx - 33) * 256; ld = 3072; act = 3; }
            if (idx != 32 || wc < 2) proj_store_group(acc, bj, (bf16_t*)(ws + boff), ld, act, row0, cl0);
            if (idx == 32 && wc == 2 && fq == 0) {
                float* IW = (float*)(ws + WS_IW);
#pragma unroll
                for (int ai = 0; ai < 2; ++ai)
#pragma unroll
                    for (int m = 0; m < 4; ++m) {
                        const size_t r = row0 + ai * 128 + m * 16;
                        *(f32x4*)(IW + r * 8) = acc[ai][bj][m][0] * CSCALE; *(f32x4*)(IW + r * 8 + 4) = acc[ai][bj][m][1] * CSCALE;
                    }
            }
            if (idx >= 3 && idx < 6) {
                float cs[8];
#pragma unroll
                for (int e = 0; e < 8; ++e) cs[e] = 0.f;
#pragma unroll
                for (int ai = 0; ai < 2; ++ai)
#pragma unroll
                    for (int m = 0; m < 4; ++m)
#pragma unroll
                        for (int e = 0; e < 4; ++e) { cs[e] += acc[ai][bj][m][0][e]; cs[4 + e] += acc[ai][bj][m][1][e]; }
#pragma unroll
                for (int e = 0; e < 8; ++e) { cs[e] += __shfl_xor(cs[e], 1); cs[e] += __shfl_xor(cs[e], 2); cs[e] += __shfl_xor(cs[e], 4); cs[e] += __shfl_xor(cs[e], 8); }
                if (fr == 0) {
                    float* KM = (float*)(ws + WS_KMEAN) + ((size_t)u.pm * 2 + wr) * 384 + (idx - 3) * 128 + cl0;
                    *(f32x4*)KM = (f32x4){cs[0], cs[1], cs[2], cs[3]}; *(f32x4*)(KM + 4) = (f32x4){cs[4], cs[5], cs[6], cs[7]};
                }
            }
            asm volatile("" ::: "memory");
        }
    }
};
struct EpiOut {
    static constexpr bool PERM = false, AFTER_DRAIN = false;
    const float* x; float* out; float* ssq;
    DEVINL void operator()(const pg8::f32x4 (&acc)[2][2][4][2], const pg8::Unit& u, int wr, int wc, int fr, int fq) const {
#pragma unroll
        for (int ai = 0; ai < 2; ++ai)
#pragma unroll
            for (int m = 0; m < 4; ++m) {
                const size_t row = (size_t)u.pm * 256 + ai * 128 + wr * 64 + m * 16 + fr;
                float ss = 0.f;
#pragma unroll
                for (int bj = 0; bj < 2; ++bj)
#pragma unroll
                    for (int n = 0; n < 2; ++n) {
                        const int col = u.pn * 256 + bj * 128 + wc * 32 + n * 16 + 4 * fq;
                        const f32x4 xv = *(const f32x4*)(x + row * DM + col);
                        const f32x4 y = xv + acc[ai][bj][m][n];
                        ss += (y.x * y.x + y.y * y.y) + (y.z * y.z + y.w * y.w);
                        *(f32x4*)(out + row * DM + col) = y;
                    }
                ss += __shfl_xor(ss, 16); ss += __shfl_xor(ss, 32);
                if (fq == 0) ssq[row * 16 + u.pn * 4 + wc] = ss;
            }
    }
};
DEVINL void phase1(const Params& p, char* lds) {
    {
        pg8::Gemm g{(const bf16_t*)p.out, (const bf16_t*)(p.ws + WS_WIN), NT, NWIN, DM};
        pg8::StaticOrder S; S.init(NT, NWIN, (int)gridDim.x, (int)blockIdx.x);
        EpiProj E{p.ws};
        pg8::gemm_phase<EpiProj, pg8::StaticOrder, true, true>((LAS unsigned char*)lds, g, S, E);
    }
    __syncthreads();
    for (int it = blockIdx.x; it < 16; it += gridDim.x) {
        const int mt = it >> 2, nt = it & 3;
        f32x16 acc[2][2]; zero_acc(acc);
        gemm_tile((const bf16_t*)(p.ws + WS_MEMN) + (size_t)mt * 256 * DM, DM, (const bf16_t*)(p.ws + WS_WMEM) + (size_t)nt * 128 * DM, DM, DM, acc, lds);
        epi_to_lds<0>(acc, lds, 1.f); __syncthreads();
        bf16_t* dst = (bf16_t*)(p.ws + (nt < 2 ? WS_MK : WS_MV)) + (size_t)mt * 256 * 256 + (nt & 1) * 128;
        lds_tile_store(lds, dst, 256); __syncthreads();
    }
}

DEVINL void phase_merge(const Params& p, char* lds) {
    const int tid = threadIdx.x, lane = tid & 63, wave = tid >> 6, wm = wave >> 1, wn = wave & 1, r32 = lane & 31, hi = lane >> 5;
    const bf16_t* WBR = (const bf16_t*)(p.ws + WS_WBR);
    const bf16_t* GATES = (const bf16_t*)(p.ws + WS_GATES);
    for (int it = blockIdx.x; it < 128 * 8; it += gridDim.x) {
        const int nt = it >> 7, mt = it & 127;
        const size_t m0 = (size_t)mt * 256;
        f32x16 acc[2][2]; zero_acc(acc);
#pragma unroll 1
        for (int br = 0; br < 3; ++br) {
            const bf16_t* Y; int ldy, K, koff;
            if (br == 0) { Y = (const bf16_t*)(p.ws + WS_ACT8) + m0 * 384; ldy = 384; K = 384; koff = 0; }
            else if (br == 1) { Y = (const bf16_t*)(p.ws + WS_ACT8 + 4 * ACT_STRIDE) + m0 * 384; ldy = 384; K = 384; koff = 384; }
            else { Y = (const bf16_t*)(p.ws + WS_QM) + m0 * 256; ldy = 256; K = 256; koff = 768; }
            gemm_tile(Y, ldy, WBR + (size_t)nt * 128 * DM + koff, DM, K, acc, lds);
#pragma unroll
            for (int i = 0; i < 2; ++i)
#pragma unroll
                for (int j = 0; j < 2; ++j)
#pragma unroll
                    for (int g = 0; g < 4; ++g) {
                        const size_t m = m0 + wm * 64 + 32 * i + r32;
                        const int n = nt * 128 + wn * 64 + 32 * j + 8 * g + 4 * hi;
                        const u32x2 gw = *(const u32x2*)(GATES + m * 3072 + br * 1024 + n);
                        float f0 = bf_lo(gw.x), f1 = bf_hi(gw.x), f2 = bf_lo(gw.y), f3 = bf_hi(gw.y);
                        if (br < 2) {
                            const u32x2 gn = *(const u32x2*)(GATES + m * 3072 + (br + 1) * 1024 + n);
                            f0 = f0 / bf_lo(gn.x); f1 = f1 / bf_hi(gn.x); f2 = f2 / bf_lo(gn.y); f3 = f3 / bf_hi(gn.y);
                        }
                        acc[i][j][4 * g + 0] *= f0; acc[i][j][4 * g + 1] *= f1; acc[i][j][4 * g + 2] *= f2; acc[i][j][4 * g + 3] *= f3;
                    }
        }
        epi_to_lds<0>(acc, lds, 1.f); __syncthreads();
        lds_tile_store(lds, (bf16_t*)(p.ws + WS_MERGED) + m0 * DM + nt * 128, DM); __syncthreads();
    }
}

DEVINL void phase_out(const Params& p, char* lds) {
    pg8::Gemm g{(const bf16_t*)(p.ws + WS_MERGED), (const bf16_t*)(p.ws + WS_WOUT), NT, DM, DM};
    pg8::StaticOrder S; S.init(NT, DM, (int)gridDim.x, (int)blockIdx.x);
    EpiOut E{p.x, p.out, (float*)(p.ws + WS_SSQ)};
    pg8::gemm_phase<EpiOut, pg8::StaticOrder, true, true>((LAS unsigned char*)lds, g, S, E);
    __syncthreads();
}
DEVINL void phase_final(const Params& p) {
    const int tid = threadIdx.x, lane = tid & 63, wave = tid >> 6;
#ifdef PROBE_A
    const unsigned* tsw = (const unsigned*)(p.ws + WS_CTL) + 4096;
    const float probeA = (float)(tsw[PROBE_A + 1] - tsw[PROBE_A]) * 1e-4f;
    const float probeB = (float)(tsw[PROBE_B + 1] - tsw[PROBE_B]) * 1e-5f;
#endif
    const float* SSQ = (const float*)(p.ws + WS_SSQ);
    for (int r = blockIdx.x * 8 + wave; r < NT; r += gridDim.x * 8) {
        float ss = 0.f;
#pragma unroll
        for (int k = 0; k < 4; ++k) { const f32x4 sv = *(const f32x4*)(SSQ + (size_t)r * 16 + 4 * k); ss += (sv.x + sv.y) + (sv.z + sv.w); }
        const float rstd = rsqrtf(ss * (1.f / DM) + EPS);
        f32x4* yr = (f32x4*)(p.out + (size_t)r * DM) + lane;
        const f32x4* gr = (const f32x4*)p.final_gain + lane;
#pragma unroll
        for (int j = 0; j < 4; ++j) { f32x4 y = yr[64 * j]; const f32x4 g = gr[64 * j]; y.x *= rstd * g.x; y.y *= rstd * g.y; y.z *= rstd * g.z; y.w *= rstd * g.w;
#ifdef PROBE_A
            y.x += probeB; y.y += probeB; y.z += probeB; y.w += probeB; if (r == 0 && j == 0 && lane == 0) y.x += probeA;
#endif
            yr[64 * j] = y; }
    }
}

constexpr int AT_K = 0, AT_V = 32768, AT_VPLANE = 16384 + 64, AT_END = AT_V + 2 * AT_VPLANE;
DEVINL void load_kv_block(const bf16_t* __restrict__ Kg, const bf16_t* __restrict__ Vg, int ld, char* lds) {
    const int tid = threadIdx.x, c = tid & 7, kr = tid >> 3;
    u32x4 kk[4], vv[4];
#pragma unroll
    for (int j = 0; j < 4; ++j) { kk[j] = *(const u32x4*)(Kg + (size_t)(kr + 64 * j) * ld + c * 8); vv[j] = *(const u32x4*)(Vg + (size_t)(kr + 64 * j) * ld + c * 8); }
#pragma unroll
    for (int j = 0; j < 4; ++j) {
        const int key = kr + 64 * j;
        *(u32x4*)(lds + AT_K + swz128(key, c)) = kk[j];
        *(u32x4*)(lds + AT_V + (c >> 2) * AT_VPLANE + key * 64 + (c & 3) * 16) = vv[j];
    }
}
DEVINL s16x4 tr_read(const char* p) {
    typedef short v4i16_t __attribute__((ext_vector_type(4)));
    return __builtin_bit_cast(s16x4, __builtin_amdgcn_ds_read_tr16_b64_v4i16((LAS v4i16_t*)(uintptr_t)(unsigned)(uintptr_t)p));
}
struct AttnState { float mhat, l; f32x16 o0, o1; };
constexpr float ATT_THR = 8.f;
template <int MODE>
DEVINL void attn_256(const bf16x8 (&qf)[4], const char* lds, int t_row, int pos0, const float* lut, float* wsf, AttnState& st) {
    const int lane = threadIdx.x & 63, r32 = lane & 31, hi = lane >> 5;
    const char* KL = lds + AT_K;
    const char* vbase = lds + AT_V + (4 * hi + ((lane & 15) >> 2)) * 64 + ((lane >> 4) & 1) * 32 + (lane & 3) * 8;
    float mhat = 0.f, l = 0.f;
    f32x16 o0, o1;
#pragma unroll
    for (int r = 0; r < 16; ++r) { o0[r] = 0.f; o1[r] = 0.f; }
#pragma unroll 1
    for (int stp = 0; stp < 4; ++stp) {
        f32x16 s0, s1;
#pragma unroll
        for (int r = 0; r < 16; ++r) { s0[r] = 0.f; s1[r] = 0.f; }
#pragma unroll
        for (int s = 0; s < 4; ++s) {
            const bf16x8 k0 = *(const bf16x8*)(KL + swz128(64 * stp + r32, 2 * s + hi));
            const bf16x8 k1 = *(const bf16x8*)(KL + swz128(64 * stp + 32 + r32, 2 * s + hi));
            s0 = MFMA32(k0, qf[s], s0); s1 = MFMA32(k1, qf[s], s1);
        }
        if (MODE == 1) {
#pragma unroll
            for (int r = 0; r < 16; ++r) {
                const int d0 = t_row - (pos0 + 64 * stp + crow(r, hi)), d1 = d0 - 32;
                s0[r] = d0 < 0 ? -INFINITY : s0[r] + lut[d0 > 127 ? 127 : d0];
                s1[r] = d1 < 0 ? -INFINITY : s1[r] + lut[d1 > 127 ? 127 : d1];
            }
        }
        float rm = fmaxf(s0[0], s1[0]);
#pragma unroll
        for (int r = 1; r < 16; ++r) rm = fmaxf(rm, fmaxf(s0[r], s1[r]));
        { auto rr = __builtin_amdgcn_permlane32_swap(__float_as_uint(rm), __float_as_uint(rm), false, false); rm = fmaxf(__uint_as_float(rr[0]), __uint_as_float(rr[1])); }
        if (stp == 0) { mhat = fmaxf(rm, -1e30f); }
        else {
            const float grow = rm - mhat;
            if (__any(grow > ATT_THR)) {
                const float dl = fmaxf(grow, 0.f); mhat += dl;
                const float f = fexp2(-dl); l *= f;
                if (hi == 0) wsf[r32] = f;
                LDS_WAIT();
#pragma unroll
                for (int g = 0; g < 4; ++g) {
                    const f32x4 fv = *(const f32x4*)(wsf + 8 * g + 4 * hi);
                    o0[4 * g + 0] *= fv.x; o0[4 * g + 1] *= fv.y; o0[4 * g + 2] *= fv.z; o0[4 * g + 3] *= fv.w;
                    o1[4 * g + 0] *= fv.x; o1[4 * g + 1] *= fv.y; o1[4 * g + 2] *= fv.z; o1[4 * g + 3] *= fv.w;
                }
                LDS_WAIT();
            }
        }
        float ps = 0.f;
#pragma unroll
        for (int r = 0; r < 16; ++r) { s0[r] = fexp2(s0[r] - mhat); s1[r] = fexp2(s1[r] - mhat); ps += s0[r] + s1[r]; }
        l += ps;
#pragma unroll
        for (int sub = 0; sub < 2; ++sub)
#pragma unroll
            for (int sp = 0; sp < 2; ++sp) {
                u32x4 pw;
                if (sub == 0) { pw.x = cvtpk(s0[8 * sp + 0], s0[8 * sp + 1]); pw.y = cvtpk(s0[8 * sp + 2], s0[8 * sp + 3]); pw.z = cvtpk(s0[8 * sp + 4], s0[8 * sp + 5]); pw.w = cvtpk(s0[8 * sp + 6], s0[8 * sp + 7]); }
                else { pw.x = cvtpk(s1[8 * sp + 0], s1[8 * sp + 1]); pw.y = cvtpk(s1[8 * sp + 2], s1[8 * sp + 3]); pw.z = cvtpk(s1[8 * sp + 4], s1[8 * sp + 5]); pw.w = cvtpk(s1[8 * sp + 6], s1[8 * sp + 7]); }
                const bf16x8 pf = __builtin_bit_cast(bf16x8, pw);
                const int keybase = 64 * stp + 32 * sub + 16 * sp;
                const char* va = vbase + keybase * 64;
                const s16x4 a0 = tr_read(va), a1 = tr_read(va + 512);
                const s16x4 b0 = tr_read(va + AT_VPLANE), b1 = tr_read(va + AT_VPLANE + 512);
                const bf16x8 vf0 = (bf16x8){a0[0], a0[1], a0[2], a0[3], a1[0], a1[1], a1[2], a1[3]};
                const bf16x8 vf1 = (bf16x8){b0[0], b0[1], b0[2], b0[3], b1[0], b1[1], b1[2], b1[3]};
                o0 = MFMA32(pf, vf0, o0); o1 = MFMA32(pf, vf1, o1);
            }
    }
    st.mhat = mhat; st.l = l; st.o0 = o0; st.o1 = o1;
}
DEVINL float half_sum(float v) { auto rr = __builtin_amdgcn_permlane32_swap(__float_as_uint(v), __float_as_uint(v), false, false); return __uint_as_float(rr[0]) + __uint_as_float(rr[1]); }
DEVINL void rows_to_regs(float v, float* wsf, float (&out)[16]) {
    const int lane = threadIdx.x & 63, r32 = lane & 31, hi = lane >> 5;
    LDS_WAIT();
    if (hi == 0) wsf[r32] = v;
    LDS_WAIT();
#pragma unroll
    for (int g = 0; g < 4; ++g) { const f32x4 fv = *(const f32x4*)(wsf + 8 * g + 4 * hi); out[4 * g] = fv.x; out[4 * g + 1] = fv.y; out[4 * g + 2] = fv.z; out[4 * g + 3] = fv.w; }
    LDS_WAIT();
}
DEVINL void build_lut(float* lut, const float* rel_bias, int col) {
    const int tid = threadIdx.x;
    if (tid < 128) lut[tid] = rel_bias[rel_bucket(tid) * 12 + col] * LOG2E;
}

DEVINL void moba_select_item(const Params& p, char* lds, int item) {
    const int tid = threadIdx.x;
    const int b = item / (HA * 16), h = (item / 16) % HA, t = (item % 16) * 512 + tid, own = t >> 8;
    float* km = (float*)lds;
    unsigned* lcnt = (unsigned*)(lds + 8192);
    unsigned* lbase = lcnt + 32;
    const float* KMEAN = (const float*)(p.ws + WS_KMEAN);
    for (int i = tid; i < 2048; i += NTHR) { const size_t o = (size_t)(b * 32 + (i >> 6)) * 768 + h * 64 + (i & 63); km[i] = (KMEAN[o] + KMEAN[o + 384]) * (1.f / 256.f); }
    if (tid < 32) lcnt[tid] = 0u;
    __syncthreads();
    const bf16_t* q = (const bf16_t*)(p.ws + WS_ACT8) + (size_t)(b * SEQ + t) * 384 + h * 64;
    float qv[64];
#pragma unroll
    for (int c = 0; c < 8; ++c) {
        const u32x4 w = *(const u32x4*)(q + c * 8);
        qv[8 * c + 0] = bf_lo(w.x); qv[8 * c + 1] = bf_hi(w.x); qv[8 * c + 2] = bf_lo(w.y); qv[8 * c + 3] = bf_hi(w.y);
        qv[8 * c + 4] = bf_lo(w.z); qv[8 * c + 5] = bf_hi(w.z); qv[8 * c + 6] = bf_lo(w.w); qv[8 * c + 7] = bf_hi(w.w);
    }
    float v0 = -INFINITY, v1 = -INFINITY, v2 = -INFINITY; int i0 = 0, i1 = 1, i2 = 2;
    const int nmax = (((item % 16) * 512 + 511) >> 8);
#pragma unroll 1
    for (int n = 0; n < nmax; ++n) {
        float g = 0.f;
#pragma unroll
        for (int c = 0; c < 16; ++c) { const f32x4 kv = *(const f32x4*)(km + n * 64 + 4 * c); g += qv[4 * c] * kv.x + qv[4 * c + 1] * kv.y + qv[4 * c + 2] * kv.z + qv[4 * c + 3] * kv.w; }
        if (n < own) {
            if (g > v0) { v2 = v1; i2 = i1; v1 = v0; i1 = i0; v0 = g; i0 = n; }
            else if (g > v1) { v2 = v1; i2 = i1; v1 = g; i1 = n; }
            else if (g > v2) { v2 = g; i2 = n; }
        }
    }
    const int nsel = own < 3 ? own : 3;
    unsigned o0 = 0, o1 = 0, o2 = 0;
    if (nsel > 0) o0 = atomicAdd(&lcnt[i0], 1u);
    if (nsel > 1) o1 = atomicAdd(&lcnt[i1], 1u);
    if (nsel > 2) o2 = atomicAdd(&lcnt[i2], 1u);
    __syncthreads();
    unsigned* gcnt = (unsigned*)(p.ws + WS_CTL) + (b * HA + h) * 32;
    if (tid < 32) lbase[tid] = lcnt[tid] ? atomicAdd(&gcnt[tid], lcnt[tid]) : 0u;
    __syncthreads();
    bf16_t* L = (bf16_t*)(p.ws + WS_LIST) + (size_t)(b * HA + h) * LIST_PER_BH;
    if (nsel > 0) L[list_off(i0) + lbase[i0] + o0] = (bf16_t)(t | (0 << 13));
    if (nsel > 1) L[list_off(i1) + lbase[i1] + o1] = (bf16_t)(t | (1 << 13));
    if (nsel > 2) L[list_off(i2) + lbase[i2] + o2] = (bf16_t)(t | (2 << 13));
    __syncthreads();
}

DEVINL void mem_attn_item(const Params& p, char* lds, int item) {
    const int tid = threadIdx.x, lane = tid & 63, wave = tid >> 6, r32 = lane & 31, hi = lane >> 5;
    const int b = item / (HM * 32), h = (item / 32) % HM, qt = item % 32;
    float* wsf = (float*)(lds + AT_END) + wave * 32;
    char* ostg = lds + AT_END + 1024 + wave * 4096;
    load_kv_block((const bf16_t*)(p.ws + WS_MK) + (size_t)b * 256 * 256 + h * 64, (const bf16_t*)(p.ws + WS_MV) + (size_t)b * 256 * 256 + h * 64, 256, lds);
    const size_t row0 = (size_t)b * SEQ + qt * 256 + wave * 32;
    bf16_t* QM = (bf16_t*)(p.ws + WS_QM);
    bf16x8 qf[4];
#pragma unroll
    for (int s = 0; s < 4; ++s) qf[s] = *(const bf16x8*)(QM + (row0 + r32) * 256 + h * 64 + 16 * s + 8 * hi);
    __syncthreads();
    AttnState st;
    attn_256<0>(qf, lds, 0, 0, nullptr, wsf, st);
    const float ltot = half_sum(st.l);
    float rl[16]; rows_to_regs(1.f / ltot, wsf, rl);
#pragma unroll
    for (int r = 0; r < 16; ++r) {
        *(bf16_t*)(ostg + crow(r, hi) * 128 + r32 * 2) = (bf16_t)(cvtpk(st.o0[r] * rl[r], 0.f) & 0xffffu);
        *(bf16_t*)(ostg + crow(r, hi) * 128 + (32 + r32) * 2) = (bf16_t)(cvtpk(st.o1[r] * rl[r], 0.f) & 0xffffu);
    }
    LDS_WAIT();
    const bf16_t* ZM = (const bf16_t*)(p.ws + WS_ZM);
#pragma unroll
    for (int i = 0; i < 4; ++i) {
        const int row = i * 8 + (lane >> 3), ch = lane & 7;
        const u32x4 ov = *(const u32x4*)(ostg + row * 128 + ch * 16);
        const u32x4 zv = *(const u32x4*)(ZM + (row0 + row) * 256 + h * 64 + ch * 8);
        u32x4 w;
        w.x = cvtpk(bf_lo(ov.x) * bf_lo(zv.x), bf_hi(ov.x) * bf_hi(zv.x)); w.y = cvtpk(bf_lo(ov.y) * bf_lo(zv.y), bf_hi(ov.y) * bf_hi(zv.y));
        w.z = cvtpk(bf_lo(ov.z) * bf_lo(zv.z), bf_hi(ov.z) * bf_hi(zv.z)); w.w = cvtpk(bf_lo(ov.w) * bf_lo(zv.w), bf_hi(ov.w) * bf_hi(zv.w));
        *(u32x4*)(QM + (row0 + row) * 256 + h * 64 + ch * 8) = w;
    }
    __syncthreads();
}

constexpr int IXL_META = 0, IXL_CAND = 2048, IX_CAP = 128, IXL_CANDK = IXL_CAND + 32 * IX_CAP * 4, IXL_HIST = IXL_CAND + 32 * IX_CAP * 6, IXL_STAGE = IXL_HIST + 65536, IXL_END = IXL_STAGE + 2 * 32768;
struct IxMeta { int need[32]; int nr[32]; int done[32]; int ccnt[32]; int lcnt[32]; int B[4][32]; float lo[4][32]; float sc[4][32]; int flag; };
DEVINL int ix_bin(float s, float lo, float sc) { float v = (s - lo) * sc; v = fminf(fmaxf(v, 0.f), 511.f); return (int)v; }
DEVINL int ix_bin0(float s) { return (int)__builtin_amdgcn_fmed3f(__builtin_fmaf(s, 64.f, 256.f), 0.f, 511.f); }
DEVINL float ix_sc(int r) { return r == 0 ? 128.f : (r == 1 ? 65536.f : 33554432.f); }
DEVINL float relu1(float x) { return __builtin_amdgcn_fmed3f(x, 0.f, 3.0e38f); }
DEVINL f32x16 ix_mma(const bf16x8 (&a)[4], const bf16x8 (&b)[4]) {
    f32x16 acc;
#pragma unroll
    for (int r = 0; r < 16; ++r) acc[r] = 0.f;
#pragma unroll
    for (int s = 0; s < 4; ++s) acc = MFMA32(a[s], b[s], acc);
    return acc;
}
DEVINL void ix_reduce(const f32x16& acc, const f32x4 (&cv)[4], float& sA, float& sB) {
    float pj[4];
#pragma unroll
    for (int j = 0; j < 4; ++j) pj[j] = cv[j].x * relu1(acc[4 * j]) + cv[j].y * relu1(acc[4 * j + 1]) + cv[j].z * relu1(acc[4 * j + 2]) + cv[j].w * relu1(acc[4 * j + 3]);
    auto r02 = __builtin_amdgcn_permlane32_swap(__float_as_uint(pj[0]), __float_as_uint(pj[2]), false, false);
    auto r13 = __builtin_amdgcn_permlane32_swap(__float_as_uint(pj[1]), __float_as_uint(pj[3]), false, false);
    sA = __uint_as_float(r02[0]) + __uint_as_float(r02[1]);
    sB = __uint_as_float(r13[0]) + __uint_as_float(r13[1]);
}
template <int MODE, bool CAUSAL>
DEVINL void ix_tile(const f32x16& acc, const f32x4 (&cv)[4], int t0, int kt, int (&B0r)[2], int (&cnt)[2], int (&ccn)[2], IxMeta* meta, char* lds, int round) {
    const int lane = threadIdx.x & 63, wave = threadIdx.x >> 6, r32 = lane & 31, hi = lane >> 5;
    char* histb = lds + IXL_HIST;
    float* cand_s = (float*)(lds + IXL_CAND);
    bf16_t* cand_k = (bf16_t*)(lds + IXL_CANDK);
    const int k = 32 * kt + r32;
    float sc2[2];
    ix_reduce(acc, cv, sc2[0], sc2[1]);
#pragma unroll
    for (int q = 0; q < 2; ++q) {
        const float sv = sc2[q];
        const int row = 4 * wave + 2 * hi + q;
        const bool adm = CAUSAL ? (k <= t0 + row) : true;
        const int b0 = ix_bin0(sv);
        if (MODE == 0) {
            if (adm) atomicAdd((unsigned*)(histb + row * 2048 + b0 * 4), 1u);
        } else if (MODE == 2) {
            if (adm && !meta->done[row]) {
                bool eq = (b0 == meta->B[0][row]);
                for (int j = 1; j < round; ++j) eq = eq && (ix_bin(sv, meta->lo[j][row], meta->sc[j][row]) == meta->B[j][row]);
                if (eq) { const int bb = ix_bin(sv, meta->lo[round][row], meta->sc[round][row]); atomicAdd((unsigned*)(histb + row * 2048 + bb * 4), 1u); }
            }
        } else {
            const int B0 = B0r[q] & 0xffff;
            bool above = adm && b0 > B0, eqv = adm && b0 == B0;
            if (B0r[q] & 0x10000) {
                if (eqv) {
                    const int nr = meta->nr[row]; int cls = 1;
                    for (int j = 1; j < nr && cls == 1; ++j) { const int bj = ix_bin(sv, meta->lo[j][row], meta->sc[j][row]), Bj = meta->B[j][row]; if (bj > Bj) cls = 2; else if (bj < Bj) cls = 0; }
                    above = cls == 2; eqv = cls == 1;
                }
            }
            const unsigned long long bal = __ballot(above);
            const unsigned hm = (unsigned)(bal >> (32 * hi));
            const int pos = cnt[q] + __popc(hm & ((1u << r32) - 1u));
            if (above && pos < 256) *(bf16_t*)(histb + row * 2048 + pos * 2) = (bf16_t)k;
            cnt[q] += __popc(hm);
            const unsigned long long bale = __ballot(eqv);
            if (bale) {
                const unsigned he = (unsigned)(bale >> (32 * hi));
                const int c = ccn[q] + __popc(he & ((1u << r32) - 1u));
                if (eqv && c < IX_CAP) { cand_s[row * IX_CAP + c] = sv; cand_k[row * IX_CAP + c] = (bf16_t)k; }
                ccn[q] += __popc(he);
            }
        }
    }
}
template <int MODE, bool LAST>
DEVINL void ix_chunk(const bf16x8 (&af)[4], const f32x4 (&cv)[4], const char* buf, int t0, int kt0, int ktend, int (&B0r)[2], int (&cnt)[2], int (&ccn)[2], IxMeta* meta, char* lds, int round) {
    const int lane = threadIdx.x & 63, r32 = lane & 31, hi = lane >> 5;
    bf16x8 bfa[4], bfb[4];
#pragma unroll
    for (int s = 0; s < 4; ++s) bfa[s] = *(const bf16x8*)(buf + swz128(r32, 2 * s + hi));
#pragma unroll
    for (int s = 0; s < 4; ++s) bfb[s] = *(const bf16x8*)(buf + swz128(32 + r32, 2 * s + hi));
    f32x16 acc = ix_mma(af, bfa);
#pragma unroll
    for (int t8 = 0; t8 < 8; ++t8) {
        if (!LAST || t8 < ktend) {
            const f32x16 accn = ix_mma(af, bfb);
            if (t8 + 2 < 8) {
#pragma unroll
                for (int s = 0; s < 4; ++s) bfb[s] = *(const bf16x8*)(buf + swz128(32 * (t8 + 2) + r32, 2 * s + hi));
            }
            ix_tile<MODE, LAST>(acc, cv, t0, kt0 + t8, B0r, cnt, ccn, meta, lds, round);
            acc = accn;
        }
    }
}
template <int MODE>
DEVINL void ix_pass(const bf16x8 (&af)[4], const f32x4 (&cv)[4], const bf16_t* IK, int t0, int nkt, int (&B0r)[2], int (&cnt)[2], int (&ccn)[2], IxMeta* meta, char* lds, int round) {
    const int tid = threadIdx.x;
    const int lc = tid & 7, lr = tid >> 3;
    const int nch = (nkt + 7) >> 3;
    u32x4 st[4];
#pragma unroll
    for (int j = 0; j < 4; ++j) st[j] = *(const u32x4*)(IK + (size_t)(lr + 64 * j) * 64 + lc * 8);
#pragma unroll
    for (int j = 0; j < 4; ++j) *(u32x4*)(lds + IXL_STAGE + swz128(lr + 64 * j, lc)) = st[j];
    __syncthreads();
#pragma unroll 1
    for (int ch = 0; ch < nch; ++ch) {
        const char* buf = lds + IXL_STAGE + (ch & 1) * 32768;
        if (ch + 1 < nch) {
#pragma unroll
            for (int j = 0; j < 4; ++j) st[j] = *(const u32x4*)(IK + (size_t)(256 * (ch + 1) + lr + 64 * j) * 64 + lc * 8);
            ix_chunk<MODE, false>(af, cv, buf, t0, 8 * ch, 8, B0r, cnt, ccn, meta, lds, round);
            char* nb = lds + IXL_STAGE + ((ch + 1) & 1) * 32768;
#pragma unroll
            for (int j = 0; j < 4; ++j) *(u32x4*)(nb + swz128(lr + 64 * j, lc)) = st[j];
        } else {
            ix_chunk<MODE, true>(af, cv, buf, t0, 8 * ch, nkt - 8 * ch, B0r, cnt, ccn, meta, lds, round);
        }
        __syncthreads();
    }
}
DEVINL void indexer_item(const Params& p, char* lds, int item) {
    const int tid = threadIdx.x, lane = tid & 63, wave = tid >> 6, r32 = lane & 31, hi = lane >> 5;
    const int b = item >> 8, u = item & 255, qt = (b & 1) ? u : 255 - u, t0 = qt * 32;
    bf16_t* IDX = (bf16_t*)(p.ws + WS_IDX) + ((size_t)b * SEQ + t0) * 256;
    if (t0 < 256) {
#pragma unroll 1
        for (int rr = 0; rr < 4; ++rr) {
            const int row = 4 * wave + rr, n = t0 + row + 1;
#pragma unroll
            for (int k = 0; k < 4; ++k) { const int i = lane + 64 * k; IDX[row * 256 + i] = (bf16_t)(i < n ? i : 0xFFFF); }
        }
        return;
    }
    IxMeta* meta = (IxMeta*)(lds + IXL_META);
    unsigned* hist = (unsigned*)(lds + IXL_HIST);
    __syncthreads();
    if (tid < 32) { meta->need[tid] = 256; meta->nr[tid] = 0; meta->done[tid] = 0; meta->ccnt[tid] = 0; meta->lo[0][tid] = -4.f; meta->sc[0][tid] = 64.f; }
    const bf16_t* IQ = (const bf16_t*)(p.ws + WS_IQ) + ((size_t)b * SEQ + t0) * 512;
    const bf16_t* IK = (const bf16_t*)(p.ws + WS_IK) + (size_t)b * SEQ * 64;
    const float* IW = (const float*)(p.ws + WS_IW) + ((size_t)b * SEQ + t0) * 8;
    bf16x8 af[4]; f32x4 cv[4];
#pragma unroll
    for (int s = 0; s < 4; ++s) af[s] = *(const bf16x8*)(IQ + (size_t)(4 * wave + (r32 >> 3)) * 512 + (r32 & 7) * 64 + 16 * s + 8 * hi);
#pragma unroll
    for (int j = 0; j < 4; ++j) cv[j] = *(const f32x4*)(IW + (size_t)(4 * wave + j) * 8 + 4 * hi);
    int B0r[2] = {0, 0}, cnt[2] = {0, 0}, ccn[2] = {0, 0};
    const int nkt = (t0 + 32) / 32;
#pragma unroll 1
    for (int round = 0; round < 4; ++round) {
#pragma unroll
        for (int k = 0; k < 8; ++k) *(u32x4*)(lds + IXL_HIST + (tid + 512 * k) * 16) = (u32x4){0u, 0u, 0u, 0u};
        if (tid == 0) meta->flag = 0;
        __syncthreads();
        if (round == 0) ix_pass<0>(af, cv, IK, t0, nkt, B0r, cnt, ccn, meta, lds, 0);
        else ix_pass<2>(af, cv, IK, t0, nkt, B0r, cnt, ccn, meta, lds, round);
#pragma unroll 1
        for (int rr = 0; rr < 4; ++rr) {
            const int row = 4 * wave + rr;
            if (meta->done[row]) continue;
            const int need = meta->need[row];
            const u32x4 h0 = *(const u32x4*)(hist + row * 512 + 8 * lane), h1 = *(const u32x4*)(hist + row * 512 + 8 * lane + 4);
            const unsigned c = ((h0[0] + h0[1]) + (h0[2] + h0[3])) + ((h1[0] + h1[1]) + (h1[2] + h1[3]));
            unsigned suf = c;
#pragma unroll
            for (int o = 1; o < 64; o <<= 1) { const unsigned tv = __shfl_down(suf, o); if (lane + o < 64) suf += tv; }
            const unsigned long long bal = __ballot(suf >= (unsigned)need);
            const int Ls = bal ? 63 - __builtin_clzll(bal) : 0;
            const unsigned sufL = __shfl(suf, Ls), cL = __shfl(c, Ls);
            unsigned cum = sufL - cL; int Bs = 8 * Ls; unsigned cb = 0; bool found = false;
#pragma unroll 1
            for (int e = 7; e >= 0; --e) {
                const unsigned hv = hist[row * 512 + 8 * Ls + e];
                if (!found) { if (cum + hv >= (unsigned)need) { Bs = 8 * Ls + e; cb = hv; found = true; } else cum += hv; }
            }
            if (lane == 0) {
                meta->B[round][row] = Bs; meta->need[row] = need - (int)cum; meta->nr[row] = round + 1;
                if (cb > (unsigned)IX_CAP && round < 3) {
                    const float lo = meta->lo[round][row], sc = meta->sc[round][row];
                    if (Bs == 511) { meta->sc[round + 1][row] = sc * 0.0625f; meta->lo[round + 1][row] = lo + 511.f / sc; }
                    else if (Bs == 0) { meta->sc[round + 1][row] = sc * 0.0625f; meta->lo[round + 1][row] = lo + 1.f / sc - 8192.f / sc; }
                    else { meta->sc[round + 1][row] = sc * 512.f; meta->lo[round + 1][row] = lo + (float)Bs / sc; }
                    meta->flag = 1;
                }
                else meta->done[row] = 1;
            }
        }
        __syncthreads();
        const int more = meta->flag;
        __syncthreads();
        if (!more) break;
    }
#pragma unroll
    for (int q = 0; q < 2; ++q) { const int row = 4 * wave + 2 * hi + q; B0r[q] = meta->B[0][row] | (meta->nr[row] > 1 ? 0x10000 : 0); }
    ix_pass<1>(af, cv, IK, t0, nkt, B0r, cnt, ccn, meta, lds, 0);
    if (r32 == 0) {
#pragma unroll
        for (int q = 0; q < 2; ++q) { meta->lcnt[4 * wave + 2 * hi + q] = cnt[q] < 256 ? cnt[q] : 256; meta->ccnt[4 * wave + 2 * hi + q] = ccn[q]; }
    }
    LDS_WAIT();
    {
        const float* cand_s = (const float*)(lds + IXL_CAND);
        const bf16_t* cand_k = (const bf16_t*)(lds + IXL_CANDK);
#pragma unroll 1
        for (int rr = 0; rr < 4; ++rr) {
            const int row = 4 * wave + rr;
            const int c = meta->lcnt[row];
            for (int i = lane; i < c; i += 64) IDX[row * 256 + i] = *(const bf16_t*)(lds + IXL_HIST + row * 2048 + i * 2);
            const int m = meta->ccnt[row] < IX_CAP ? meta->ccnt[row] : IX_CAP, r = meta->need[row], base = 256 - r;
            for (int i = lane; i < m; i += 64) {
                const float si = cand_s[row * IX_CAP + i]; const int ki = cand_k[row * IX_CAP + i];
                int rank = 0;
                for (int j = 0; j < m; ++j) { const float sj = cand_s[row * IX_CAP + j]; const int kj = cand_k[row * IX_CAP + j]; rank += (sj > si || (sj == si && kj < ki)) ? 1 : 0; }
                if (rank < r) IDX[row * 256 + base + rank] = (bf16_t)ki;
            }
        }
    }
    __syncthreads();
}

DEVINL float dot2bf(unsigned a, unsigned b, float c) {
    typedef __bf16 bf2 __attribute__((ext_vector_type(2)));
    return __builtin_amdgcn_fdot2_f32_bf16(__builtin_bit_cast(bf2, a), __builtin_bit_cast(bf2, b), c, false);
}
DEVINL void dsa_item(const Params& p, char* lds, int item, bool dry = false) {
    const int tid = threadIdx.x, lane = tid & 63, wave = tid >> 6, g = lane >> 3, j = lane & 7;
    const int pair = (item & 7) + 8 * (item >> 8), chunk = (item >> 3) & 31;
    const int b = pair / HB, h = pair % HB;
    float* lut = (float*)lds;
    float* pbuf = (float*)(lds + 512) + wave * 256;
    __syncthreads();
    build_lut(lut, p.rel_bias, 6 + h);
    __syncthreads();
    bf16_t* QB = (bf16_t*)(p.ws + WS_ACT8 + 4 * ACT_STRIDE);
    const bf16_t* KB = (const bf16_t*)(p.ws + WS_ACT8 + 5 * ACT_STRIDE) + (size_t)b * SEQ * 384 + h * 64 + 8 * j;
    const bf16_t* VB = (const bf16_t*)(p.ws + WS_ACT8 + 6 * ACT_STRIDE) + (size_t)b * SEQ * 384 + h * 64 + 8 * j;
    const bf16_t* ZB = (const bf16_t*)(p.ws + WS_ACT8 + 7 * ACT_STRIDE);
    const bf16_t* IDX = (const bf16_t*)(p.ws + WS_IDX);
#pragma unroll 1
    for (int qi = 0; qi < 32; ++qi) {
        const int t = chunk * 256 + wave * 32 + qi;
        const size_t row = (size_t)b * SEQ + t;
        const u32x4 qv = *(const u32x4*)(QB + row * 384 + h * 64 + 8 * j);
        const bf16_t* irow = IDX + row * 256 + g * 32;
        u32x4 iv[4];
#pragma unroll
        for (int k = 0; k < 4; ++k) iv[k] = *(const u32x4*)(irow + 8 * k);
        int myk[4];
#pragma unroll
        for (int bt = 0; bt < 4; ++bt) myk[bt] = irow[8 * bt + j];
        float lg[4];
#pragma unroll
        for (int bt = 0; bt < 4; ++bt) {
            float part[8];
#pragma unroll
            for (int i = 0; i < 8; ++i) {
                const int ii = 8 * bt + i;
                const unsigned w = (ii & 1) ? (iv[ii >> 3][(ii >> 1) & 3] >> 16) : (iv[ii >> 3][(ii >> 1) & 3] & 0xffffu);
                const int key = w == 0xFFFFu ? 0 : (int)w;
                const u32x4 kv = *(const u32x4*)(KB + (size_t)key * 384);
                part[i] = dot2bf(kv.w, qv.w, dot2bf(kv.z, qv.z, dot2bf(kv.y, qv.y, dot2bf(kv.x, qv.x, 0.f))));
            }
            float v4[4];
#pragma unroll
            for (int a = 0; a < 4; ++a) { const float keep = (j & 4) ? part[4 + a] : part[a], send = (j & 4) ? part[a] : part[4 + a]; v4[a] = keep + __shfl_xor(send, 4); }
            float v2[2];
#pragma unroll
            for (int a = 0; a < 2; ++a) { const float keep = (j & 2) ? v4[2 + a] : v4[a], send = (j & 2) ? v4[a] : v4[2 + a]; v2[a] = keep + __shfl_xor(send, 2); }
            { const float keep = (j & 1) ? v2[1] : v2[0], send = (j & 1) ? v2[0] : v2[1]; lg[bt] = keep + __shfl_xor(send, 1); }
        }
        float mx = -INFINITY;
#pragma unroll
        for (int bt = 0; bt < 4; ++bt) {
            const int d = t - myk[bt];
            lg[bt] = (myk[bt] == 0xFFFF || d < 0) ? -INFINITY : lg[bt] + lut[d > 127 ? 127 : d];
            mx = fmaxf(mx, lg[bt]);
        }
        mx = wave_max(mx);
        float ls = 0.f;
#pragma unroll
        for (int bt = 0; bt < 4; ++bt) { lg[bt] = fexp2(lg[bt] - mx); ls += lg[bt]; pbuf[g * 32 + 8 * bt + j] = lg[bt]; }
        ls = wave_sum(ls);
        LDS_WAIT();
        float acc[8];
#pragma unroll
        for (int e = 0; e < 8; ++e) acc[e] = 0.f;
#pragma unroll
        for (int k = 0; k < 4; ++k) {
            const f32x4 pa = *(const f32x4*)(pbuf + g * 32 + 8 * k), pb = *(const f32x4*)(pbuf + g * 32 + 8 * k + 4);
            const float pp[8] = {pa.x, pa.y, pa.z, pa.w, pb.x, pb.y, pb.z, pb.w};
#pragma unroll
            for (int i2 = 0; i2 < 4; ++i2) {
                const unsigned wpair = iv[k][i2];
                const unsigned w0 = wpair & 0xffffu, w1 = wpair >> 16;
                const int key0 = w0 == 0xFFFFu ? 0 : (int)w0, key1 = w1 == 0xFFFFu ? 0 : (int)w1;
                const u32x4 va = *(const u32x4*)(VB + (size_t)key0 * 384), vb = *(const u32x4*)(VB + (size_t)key1 * 384);
                const unsigned ppk = cvtpk(pp[2 * i2], pp[2 * i2 + 1]);
#pragma unroll
                for (int w = 0; w < 4; ++w) {
                    const unsigned lo = __builtin_amdgcn_perm(vb[w], va[w], 0x05040100u), hh = __builtin_amdgcn_perm(vb[w], va[w], 0x07060302u);
                    acc[2 * w] = dot2bf(lo, ppk, acc[2 * w]); acc[2 * w + 1] = dot2bf(hh, ppk, acc[2 * w + 1]);
                }
            }
        }
        LDS_WAIT();
        float a4[4];
#pragma unroll
        for (int a = 0; a < 4; ++a) { const float keep = (g & 4) ? acc[4 + a] : acc[a], send = (g & 4) ? acc[a] : acc[4 + a]; a4[a] = keep + __shfl_xor(send, 32); }
        float a2[2];
#pragma unroll
        for (int a = 0; a < 2; ++a) { const float keep = (g & 2) ? a4[2 + a] : a4[a], send = (g & 2) ? a4[a] : a4[2 + a]; a2[a] = keep + __shfl_xor(send, 16); }
        float a1;
        { const float keep = (g & 1) ? a2[1] : a2[0], send = (g & 1) ? a2[0] : a2[1]; a1 = keep + __shfl_xor(send, 8); }
        const int dim = 8 * j + g;
        const float z = bf2f(ZB[row * 384 + h * 64 + dim]);
        bf16_t* dstp = dry ? (bf16_t*)(p.ws + WS_END) + ((row * 384 + h * 64 + dim) & 0x3fffff) : QB + row * 384 + h * 64 + dim;
        *dstp = (bf16_t)(cvtpk(a1 / ls * z, 0.f) & 0xffffu);
    }
}

DEVINL void moba_past_item(const Params& p, char* lds, int b, int h, int n, int c, int cnt) {
    const int tid = threadIdx.x, lane = tid & 63, wave = tid >> 6, r32 = lane & 31, hi = lane >> 5;
    float* lut = (float*)(lds + AT_END);
    float* wsf = (float*)(lds + AT_END + 512) + wave * 32;
    bf16_t* ent = (bf16_t*)(lds + AT_END + 1536);
    char* ostg = lds + AT_END + 2048 + wave * 4096;
    const bf16_t* L = (const bf16_t*)(p.ws + WS_LIST) + (size_t)(b * HA + h) * LIST_PER_BH + list_off(n) + c * 256;
    __syncthreads();
    const int nvalid = cnt - c * 256 < 256 ? cnt - c * 256 : 256;
    if (tid < 256) ent[tid] = tid < nvalid ? L[tid] : L[0];
    build_lut(lut, p.rel_bias, h);
    load_kv_block((const bf16_t*)(p.ws + WS_ACT8 + 1 * ACT_STRIDE) + ((size_t)b * SEQ + n * 256) * 384 + h * 64,
                  (const bf16_t*)(p.ws + WS_ACT8 + 2 * ACT_STRIDE) + ((size_t)b * SEQ + n * 256) * 384 + h * 64, 384, lds);
    __syncthreads();
    if (wave * 32 < nvalid) {
        const int e = ent[wave * 32 + r32], t_row = e & 8191;
        const bf16_t* QA = (const bf16_t*)(p.ws + WS_ACT8);
        bf16x8 qf[4];
#pragma unroll
        for (int s = 0; s < 4; ++s) qf[s] = *(const bf16x8*)(QA + ((size_t)b * SEQ + t_row) * 384 + h * 64 + 16 * s + 8 * hi);
        AttnState st;
        attn_256<1>(qf, lds, t_row, n * 256, lut, wsf, st);
        const float ltot = half_sum(st.l);
        float rl[16]; rows_to_regs(1.f / ltot, wsf, rl);
#pragma unroll
        for (int r = 0; r < 16; ++r) {
            *(bf16_t*)(ostg + crow(r, hi) * 128 + r32 * 2) = (bf16_t)(cvtpk(st.o0[r] * rl[r], 0.f) & 0xffffu);
            *(bf16_t*)(ostg + crow(r, hi) * 128 + (32 + r32) * 2) = (bf16_t)(cvtpk(st.o1[r] * rl[r], 0.f) & 0xffffu);
        }
        LDS_WAIT();
        bf16_t* PO = (bf16_t*)((char*)p.out + OUT_PO);
        float* PL = (float*)((char*)p.out + OUT_PL);
        if (hi == 0 && wave * 32 + r32 < nvalid) PL[(((size_t)b * SEQ + t_row) * HA + h) * 4 + (e >> 13)] = st.mhat + __builtin_amdgcn_logf(ltot);
#pragma unroll
        for (int i = 0; i < 4; ++i) {
            const int row = i * 8 + (lane >> 3), ch = lane & 7;
            if (wave * 32 + row < nvalid) {
                const int e2 = ent[wave * 32 + row];
                *(u32x4*)(PO + ((((size_t)b * SEQ + (e2 & 8191)) * HA + h) * 4 + (e2 >> 13)) * 64 + ch * 8) = *(const u32x4*)(ostg + row * 128 + ch * 16);
            }
        }
    }
    __syncthreads();
}

DEVINL void moba_own_item(const Params& p, char* lds, int item) {
    const int tid = threadIdx.x, lane = tid & 63, wave = tid >> 6, r32 = lane & 31, hi = lane >> 5;
    const int b = item / (HA * 32), h = (item / 32) % HA, n = item % 32;
    float* lut = (float*)(lds + AT_END);
    float* wsf = (float*)(lds + AT_END + 512) + wave * 32;
    float* lse_own = (float*)(lds + AT_END + 1536);
    float* oown = (float*)lds;
    __syncthreads();
    build_lut(lut, p.rel_bias, h);
    const size_t row0 = (size_t)b * SEQ + n * 256;
    load_kv_block((const bf16_t*)(p.ws + WS_ACT8 + 1 * ACT_STRIDE) + row0 * 384 + h * 64, (const bf16_t*)(p.ws + WS_ACT8 + 2 * ACT_STRIDE) + row0 * 384 + h * 64, 384, lds);
    bf16_t* QA = (bf16_t*)(p.ws + WS_ACT8);
    const int t_row = n * 256 + wave * 32 + r32;
    bf16x8 qf[4];
#pragma unroll
    for (int s = 0; s < 4; ++s) qf[s] = *(const bf16x8*)(QA + ((size_t)b * SEQ + t_row) * 384 + h * 64 + 16 * s + 8 * hi);
    __syncthreads();
    AttnState st;
    attn_256<1>(qf, lds, t_row, n * 256, lut, wsf, st);
    const float ltot = half_sum(st.l);
    float rl[16]; rows_to_regs(1.f / ltot, wsf, rl);
    __syncthreads();
    if (hi == 0) lse_own[wave * 32 + r32] = st.mhat + __builtin_amdgcn_logf(ltot);
#pragma unroll
    for (int r = 0; r < 16; ++r) {
        oown[(wave * 32 + crow(r, hi)) * 64 + r32] = st.o0[r] * rl[r];
        oown[(wave * 32 + crow(r, hi)) * 64 + 32 + r32] = st.o1[r] * rl[r];
    }
    __syncthreads();
    const bf16_t* PO = (const bf16_t*)((const char*)p.out + OUT_PO);
    const float* PL = (const float*)((const char*)p.out + OUT_PL);
    const bf16_t* ZA = (const bf16_t*)(p.ws + WS_ACT8 + 3 * ACT_STRIDE);
    const int nsel = n < 3 ? n : 3;
#pragma unroll 1
    for (int k = 0; k < 4; ++k) {
        const int task = tid + 512 * k, row = task >> 3, ch = task & 7;
        const size_t grow = row0 + row;
        const float lo = lse_own[row];
        float ls[3]; float M = lo;
#pragma unroll
        for (int s = 0; s < 3; ++s) { ls[s] = (s < nsel) ? PL[(grow * HA + h) * 4 + s] : -INFINITY; M = fmaxf(M, ls[s]); }
        const float w_own = fexp2(lo - M);
        float wsum = w_own, o[8];
#pragma unroll
        for (int e = 0; e < 8; ++e) o[e] = w_own * oown[row * 64 + ch * 8 + e];
#pragma unroll
        for (int s = 0; s < 3; ++s) {
            if (s < nsel) {
                const float w = fexp2(ls[s] - M); wsum += w;
                const u32x4 pv = *(const u32x4*)(PO + ((grow * HA + h) * 4 + s) * 64 + ch * 8);
                o[0] += w * bf_lo(pv.x); o[1] += w * bf_hi(pv.x); o[2] += w * bf_lo(pv.y); o[3] += w * bf_hi(pv.y);
                o[4] += w * bf_lo(pv.z); o[5] += w * bf_hi(pv.z); o[6] += w * bf_lo(pv.w); o[7] += w * bf_hi(pv.w);
            }
        }
        const float inv = 1.f / wsum;
        const u32x4 zv = *(const u32x4*)(ZA + grow * 384 + h * 64 + ch * 8);
        u32x4 w;
        w.x = cvtpk(o[0] * inv * bf_lo(zv.x), o[1] * inv * bf_hi(zv.x)); w.y = cvtpk(o[2] * inv * bf_lo(zv.y), o[3] * inv * bf_hi(zv.y));
        w.z = cvtpk(o[4] * inv * bf_lo(zv.z), o[5] * inv * bf_hi(zv.z)); w.w = cvtpk(o[6] * inv * bf_lo(zv.w), o[7] * inv * bf_hi(zv.w));
        *(u32x4*)(QA + grow * 384 + h * 64 + ch * 8) = w;
    }
    __syncthreads();
}

DEVINL void phase2(const Params& p, char* lds) {
    for (int it = blockIdx.x; it < NB * 256; it += gridDim.x) indexer_item(p, lds, it);
    __syncthreads();
    for (int it = blockIdx.x; it < NB * HA * 16; it += gridDim.x) moba_select_item(p, lds, it);
    for (int it = blockIdx.x; it < NB * HM * 32; it += gridDim.x) mem_attn_item(p, lds, it);
}
DEVINL void phase3(const Params& p, char* lds) {
    for (int it = blockIdx.x; it < 768; it += gridDim.x) dsa_item(p, lds, it);
#if defined(REP) && REP == 4
    for (int it = blockIdx.x; it < 768; it += gridDim.x) dsa_item(p, lds, it, true);
#endif
    const unsigned* ctl = (const unsigned*)(p.ws + WS_CTL);
    unsigned* pre = (unsigned*)(lds + AT_END + 2048 + 8 * 4096);
    __syncthreads();
    for (int i = threadIdx.x; i < 744; i += NTHR) pre[i + 1] = (ctl[(i / 31) * 32 + (i % 31)] + 255u) >> 8;
    __syncthreads();
    if (threadIdx.x == 0) { unsigned a = 0; pre[0] = 0; for (int i = 1; i <= 744; ++i) { a += pre[i]; pre[i] = a; } }
    __syncthreads();
    const int total = (int)pre[744];
    for (int ri = blockIdx.x; ri < total; ri += gridDim.x) {
        int lo = 0, hi2 = 744;
        while (hi2 - lo > 1) { const int mid = (lo + hi2) >> 1; if ((int)pre[mid] <= ri) lo = mid; else hi2 = mid; }
        const int bh = lo / 31, n = lo % 31, c = ri - (int)pre[lo];
        moba_past_item(p, lds, bh / HA, bh % HA, n, c, (int)ctl[bh * 32 + n]);
    }
#if defined(REP) && REP == 5
    for (int ri = blockIdx.x; ri < total; ri += gridDim.x) {
        int lo = 0, hi2 = 744;
        while (hi2 - lo > 1) { const int mid = (lo + hi2) >> 1; if ((int)pre[mid] <= ri) lo = mid; else hi2 = mid; }
        const int bh = lo / 31, n = lo % 31, c = ri - (int)pre[lo];
        moba_past_item(p, lds, bh / HA, bh % HA, n, c, (int)ctl[bh * 32 + n]);
    }
#endif
}
DEVINL void phase4(const Params& p, char* lds) {
    for (int it = blockIdx.x; it < NB * HA * 32; it += gridDim.x) moba_own_item(p, lds, it);
}


#define XB_TMO      128
#define XB_XCNT(j)  (256  + 64 * (j))
#define XB_XSUB(j)  (1280 + 64 * (j))
#define XB_XGEN(j)  (2304 + 64 * (j))
#define XB_TOP      3328
#define XB_TOPGEN   3392
#define XB_SPIN_CAP (1u << 22)
DEVINL unsigned xb_ld(unsigned* p)              { return __hip_atomic_load(p, __ATOMIC_RELAXED, __HIP_MEMORY_SCOPE_AGENT); }
DEVINL unsigned xb_add(unsigned* p, unsigned v) { return __hip_atomic_fetch_add(p, v, __ATOMIC_RELAXED, __HIP_MEMORY_SCOPE_AGENT); }
DEVINL unsigned xb_xcc_id() { return (unsigned)__builtin_amdgcn_s_getreg((3 << 11) | 20) & 0xFu; }
#define XB_SPIN(cond, bar) do { unsigned _sp = 0; while (cond) { __builtin_amdgcn_s_sleep(1); \
    if ((++_sp & 255u) == 0u) { if (xb_ld(&(bar)[XB_TMO])) break; if (_sp > XB_SPIN_CAP) { atomicAdd(&(bar)[XB_TMO], 1u); break; } } } } while (0)
struct XcdBarrier { unsigned* bar; unsigned x; volatile LAS unsigned* st; };
DEVINL XcdBarrier xcd_barrier_post(unsigned* bar, volatile LAS unsigned* st) {
    XcdBarrier b; b.bar = bar; b.x = xb_xcc_id(); b.st = st;
    if (threadIdx.x == 0) (void)xb_add(&bar[XB_XCNT(b.x)], 1u);
    return b;
}
DEVINL void xcd_barrier_complete(unsigned* bar, unsigned x, unsigned& nloc, unsigned& nx) {
    const unsigned G = gridDim.x * gridDim.y * gridDim.z;
    unsigned sum, cnt, mine, sp = 0u;
    for (;;) {
        sum = 0u; cnt = 0u; mine = 0u;
#pragma unroll
        for (unsigned j = 0; j < 16; ++j) { const unsigned c = xb_ld(&bar[XB_XCNT(j)]); sum += c; cnt += (c > 0u) ? 1u : 0u; mine = (j == x) ? c : mine; }
        if (sum == G) break;
        __builtin_amdgcn_s_sleep(1);
        if ((++sp & 255u) == 0u) { if (xb_ld(&bar[XB_TMO])) break; if (sp > XB_SPIN_CAP) { atomicAdd(&bar[XB_TMO], 1u); break; } }
    }
    nloc = mine > 0u ? mine : 1u; nx = cnt > 0u ? cnt : 1u;
}
DEVINL void xcd_barrier(const XcdBarrier& b) {
    asm volatile("s_waitcnt vmcnt(0)" ::: "memory");
    __syncthreads();
    if (threadIdx.x == 0) {
        unsigned* bar = b.bar;
        __builtin_amdgcn_s_waitcnt(0);
        unsigned nloc = b.st[0], nx = b.st[1];
        if (nloc == 0u) { xcd_barrier_complete(bar, b.x, nloc, nx); b.st[0] = nloc; b.st[1] = nx; }
        const unsigned old = xb_add(&bar[XB_XSUB(b.x)], 1u);
        const unsigned gen = old / nloc;
        if (old + 1u == (gen + 1u) * nloc) {
            __builtin_amdgcn_fence(__ATOMIC_RELEASE, "agent");
            asm volatile("s_waitcnt vmcnt(0)" ::: "memory");
            const unsigned og = xb_add(&bar[XB_TOP], 1u);
            const unsigned tg = og / nx;
            if (og + 1u == (tg + 1u) * nx) xb_add(&bar[XB_TOPGEN], 1u);
            else XB_SPIN(xb_ld(&bar[XB_TOPGEN]) == tg, bar);
            __builtin_amdgcn_fence(__ATOMIC_ACQUIRE, "agent");
            xb_add(&bar[XB_XGEN(b.x)], 1u);
            asm volatile("s_waitcnt vmcnt(0)" ::: "memory");
        } else {
            XB_SPIN(xb_ld(&bar[XB_XGEN(b.x)]) == gen, bar);
            __builtin_amdgcn_fence(__ATOMIC_ACQUIRE, "agent");
            asm volatile("s_waitcnt vmcnt(0)" ::: "memory");
        }
    }
    __syncthreads();
}

constexpr int LDS_BYTES = IXL_END + 64, LDS_XB = IXL_END;
#define KERNEL_PROLOGUE __shared__ __attribute__((aligned(16))) char lds[LDS_BYTES];
#ifdef MULTI_LAUNCH
__global__ void __launch_bounds__(NTHR) k_phase0(Params p) { KERNEL_PROLOGUE phase0(p, lds); }
__global__ void __launch_bounds__(NTHR) k_phase1(Params p) { KERNEL_PROLOGUE phase1(p, lds); }
__global__ void __launch_bounds__(NTHR) k_phase2(Params p) { KERNEL_PROLOGUE phase2(p, lds); }
__global__ void __launch_bounds__(NTHR) k_phase3(Params p) { KERNEL_PROLOGUE phase3(p, lds); }
__global__ void __launch_bounds__(NTHR) k_phase4(Params p) { KERNEL_PROLOGUE phase4(p, lds); }
__global__ void __launch_bounds__(NTHR) k_phase5(Params p) { KERNEL_PROLOGUE phase_gates(p, lds); }
__global__ void __launch_bounds__(NTHR) k_phase6(Params p) { KERNEL_PROLOGUE phase_merge(p, lds); }
__global__ void __launch_bounds__(NTHR) k_phase7(Params p) { KERNEL_PROLOGUE phase_out(p, lds); }
__global__ void __launch_bounds__(NTHR) k_phase8(Params p) { phase_final(p); }
#else
__global__ void __launch_bounds__(NTHR) k_mega(Params p) {
    KERNEL_PROLOGUE
    cg::grid_group grid = cg::this_grid();
#ifdef PROBE_A
    int nst = 0;
#define STAMP() do { if (blockIdx.x == 0 && threadIdx.x == 0) ((unsigned*)(p.ws + WS_CTL))[4096 + nst] = (unsigned)__builtin_amdgcn_s_memrealtime(); ++nst; } while (0)
#else
#define STAMP() do { } while (0)
#endif
    volatile LAS unsigned* xst = (volatile LAS unsigned*)(LAS char*)(uintptr_t)(unsigned)(uintptr_t)(lds + LDS_XB);
    if (threadIdx.x == 0) { xst[0] = 0u; xst[1] = 0u; }
    __syncthreads();
    phase0(p, lds);      grid.sync();
    const XcdBarrier bar = xcd_barrier_post((unsigned*)(p.ws + WS_CTL) + CTL_XBAR, xst);
    phase1(p, lds);      xcd_barrier(bar);
    phase2(p, lds);      xcd_barrier(bar);
    phase3(p, lds);      xcd_barrier(bar);
    phase4(p, lds);      xcd_barrier(bar);
    phase_merge(p, lds); xcd_barrier(bar);
    phase_out(p, lds);   xcd_barrier(bar);
    phase_final(p);
}
#endif

extern "C" void kernel_launch(void* const* d_in, const int* in_sizes, int n_in, void* d_out, int out_size, void* d_ws, size_t ws_size, hipStream_t stream) {
    Params p{};
    p.x = (const float*)d_in[0]; p.mem = (const float*)d_in[1]; p.norm_gain = (const float*)d_in[2]; p.w_in = (const float*)d_in[3];
    p.rel_bias = (const float*)d_in[4]; p.mem_gain = (const float*)d_in[5]; p.w_mem_kv = (const float*)d_in[6]; p.w_branch = (const float*)d_in[7];
    p.w_out = (const float*)d_in[8]; p.final_gain = (const float*)d_in[9];
    p.out = (float*)d_out; p.ws = (unsigned char*)d_ws;
#ifdef MULTI_LAUNCH
    const int G = 256;
    hipLaunchKernelGGL(k_phase0, dim3(G), dim3(NTHR), 0, stream, p);
    hipLaunchKernelGGL(k_phase1, dim3(G), dim3(NTHR), 0, stream, p);
    hipLaunchKernelGGL(k_phase2, dim3(G), dim3(NTHR), 0, stream, p);
    hipLaunchKernelGGL(k_phase3, dim3(G), dim3(NTHR), 0, stream, p);
    hipLaunchKernelGGL(k_phase4, dim3(G), dim3(NTHR), 0, stream, p);
    hipLaunchKernelGGL(k_phase5, dim3(G), dim3(NTHR), 0, stream, p);
    hipLaunchKernelGGL(k_phase6, dim3(G), dim3(NTHR), 0, stream, p);
    hipLaunchKernelGGL(k_phase7, dim3(G), dim3(NTHR), 0, stream, p);
    hipLaunchKernelGGL(k_phase8, dim3(G), dim3(NTHR), 0, stream, p);
#else
    static int grid = 0;
    if (!grid) {
        int dev = 0, cus = 0, per_cu = 0;
        (void)hipGetDevice(&dev);
        (void)hipDeviceGetAttribute(&cus, hipDeviceAttributeMultiprocessorCount, dev);
        (void)hipOccupancyMaxActiveBlocksPerMultiprocessor(&per_cu, (const void*)k_mega, NTHR, 0);
        if (per_cu < 1) { fprintf(stderr, "kernel_launch: occupancy query says %d blocks/CU\n", per_cu); per_cu = 1; }
        grid = cus;
        if (ws_size < WS_END) fprintf(stderr, "kernel_launch: workspace too small: %zu < %zu\n", ws_size, (size_t)WS_END);
    }
    void* args[] = {&p};
    hipError_t e = hipLaunchCooperativeKernel((const void*)k_mega, dim3(grid), dim3(NTHR), args, 0, stream);
    if (e != hipSuccess) fprintf(stderr, "kernel_launch: cooperative launch failed: %s (grid %d)\n", hipGetErrorString(e), grid);
#endif
}
```

```cpp
#include <hip/hip_runtime.h>
#include <hip/hip_cooperative_groups.h>
#include <stdint.h>
#include <stdio.h>
namespace cg = cooperative_groups;

#define DEVINL __device__ __forceinline__
#define LAS __attribute__((address_space(3)))

typedef unsigned short bf16_t;
typedef short bf16x8 __attribute__((ext_vector_type(8)));
typedef short s16x4 __attribute__((ext_vector_type(4)));
typedef float f32x16 __attribute__((ext_vector_type(16)));
typedef float f32x4 __attribute__((ext_vector_type(4)));
typedef unsigned u32x4 __attribute__((ext_vector_type(4)));
typedef unsigned u32x2 __attribute__((ext_vector_type(2)));

constexpr int NB = 4, SEQ = 8192, DM = 1024, NT = NB * SEQ;
constexpr int HD = 64, HA = 6, HB = 6, HM = 4, WA = 384, WB = 384, WM = 256;
constexpr int NMEM = 256, INW = 7240;
constexpr int NWIN = 7424;
constexpr int NG1 = 33;
constexpr int GATE0 = 4224;
constexpr float EPS = 1e-6f;
constexpr float LOG2E = 1.4426950408889634f;
constexpr float QSCALE = 0.125f * LOG2E;
constexpr float CSCALE = 0.35355339059327373f * 0.125f;
constexpr int NTHR = 512;

constexpr size_t MiB = 1u << 20;
constexpr size_t WS_CTL = 0, WS_WIN = 1 * MiB, WS_WBR = 16 * MiB, WS_WOUT = 18 * MiB, WS_WMEM = 20 * MiB, WS_MEMN = 21 * MiB,
                 WS_MK = 23 * MiB, WS_MV = 23 * MiB + 512 * 1024, WS_KMEAN = 24 * MiB, WS_IW = 25 * MiB, WS_IK = 26 * MiB,
                 WS_LIST = 30 * MiB, WS_IDX = 36 * MiB, WS_IQ = 52 * MiB, WS_QM = 84 * MiB, WS_ZM = 100 * MiB, WS_ACT8 = 116 * MiB,
                 WS_GATES = 308 * MiB, WS_SSQ = 500 * MiB, WS_END = 502 * MiB;
constexpr size_t ACT_STRIDE = (size_t)NT * 384 * 2;
constexpr size_t WS_MERGED = WS_ACT8 + ACT_STRIDE;
constexpr size_t OUT_PO = 0, OUT_PL = 96 * MiB;
constexpr int CTL_WORDS = 2048, CTL_QUEUE = 1024, CTL_XBAR = 8192, XCD_BAR_WORDS = 3456;
constexpr int LIST_PER_BH = 126976;

struct Params {
    const float *x, *mem, *norm_gain, *w_in, *rel_bias, *mem_gain, *w_mem_kv, *w_branch, *w_out, *final_gain;
    float* out; unsigned char* ws;
};

typedef __bf16 bf16x2_t __attribute__((ext_vector_type(2)));
DEVINL unsigned cvtpk(float lo, float hi) { bf16x2_t v; v.x = (__bf16)lo; v.y = (__bf16)hi; return __builtin_bit_cast(unsigned, v); }
DEVINL float bf_lo(unsigned u) { return __uint_as_float(u << 16); }
DEVINL float bf_hi(unsigned u) { return __uint_as_float(u & 0xffff0000u); }
DEVINL float bf2f(bf16_t b) { return __uint_as_float(((unsigned)b) << 16); }
DEVINL float wave_sum(float v) {
#pragma unroll
    for (int o = 1; o < 64; o <<= 1) v += __shfl_xor(v, o);
    return v;
}
DEVINL float wave_max(float v) {
#pragma unroll
    for (int o = 1; o < 64; o <<= 1) v = fmaxf(v, __shfl_xor(v, o));
    return v;
}
template <int CTRL> DEVINL float dppf(float x) { return __uint_as_float((unsigned)__builtin_amdgcn_update_dpp(0, (int)__float_as_uint(x), CTRL, 0xF, 0xF, true)); }
DEVINL float xor32f(float x) { auto rr = __builtin_amdgcn_permlane32_swap(__float_as_uint(x), __float_as_uint(x), false, false); return __uint_as_float((threadIdx.x & 32) ? rr[0] : rr[1]); }
DEVINL float wave_sum_dpp(float v) {
    v += dppf<0xB1>(v); v += dppf<0x4E>(v); v += dppf<0x141>(v); v += dppf<0x128>(v); v += __shfl_xor(v, 16);
    auto rr = __builtin_amdgcn_permlane32_swap(__float_as_uint(v), __float_as_uint(v), false, false); return __uint_as_float(rr[0]) + __uint_as_float(rr[1]);
}
DEVINL float wave_max_dpp(float v) {
    v = fmaxf(v, dppf<0xB1>(v)); v = fmaxf(v, dppf<0x4E>(v)); v = fmaxf(v, dppf<0x141>(v)); v = fmaxf(v, dppf<0x128>(v)); v = fmaxf(v, __shfl_xor(v, 16));
    auto rr = __builtin_amdgcn_permlane32_swap(__float_as_uint(v), __float_as_uint(v), false, false); return fmaxf(__uint_as_float(rr[0]), __uint_as_float(rr[1]));
}
DEVINL float fexp2(float x) { return __builtin_amdgcn_exp2f(x); }
DEVINL float frcp(float x) { return __builtin_amdgcn_rcpf(x); }
DEVINL float fsigm(float z) { return frcp(1.f + fexp2(-z * LOG2E)); }
DEVINL float fsilu(float z) { return z * fsigm(z); }
#define LDS_WAIT() asm volatile("s_waitcnt lgkmcnt(0)" ::: "memory")
#define MFMA32(a, b, c) __builtin_amdgcn_mfma_f32_32x32x16_bf16(a, b, c, 0, 0, 0)
DEVINL int crow(int r, int hi) { return (r & 3) + 8 * (r >> 2) + 4 * hi; }
DEVINL int rel_bucket(int d) {
    if (d < 16) return d;
    return 16 + (d >= 19) + (d >= 21) + (d >= 24) + (d >= 27) + (d >= 31) + (d >= 35) + (d >= 40) + (d >= 46) + (d >= 52) + (d >= 59) +
           (d >= 67) + (d >= 77) + (d >= 87) + (d >= 99) + (d >= 113);
}
DEVINL int list_off(int n) { return 8192 * n - 128 * n * (n + 1); }

DEVINL int win_srccol(int n) {
    if (n < 3584) return n;
    if (n < 3840) return n - 3584 + 3656;
    if (n < 4096) return n - 3840 + 3912;
    if (n < 4160) return n - 4096 + 3584;
    if (n < 4168) return n - 4160 + 3648;
    if (n < GATE0) return -1;
    if (n >= GATE0 + 3072) return -1;
    return n - GATE0 + 4168;
}
template <int KIND>
DEVINL void p0_transpose_item(const float* __restrict__ W, int ldw, const float* __restrict__ gain, bf16_t* WT, int K, int item, int nblk, float* scr, int lane) {
    const int kb = item / nblk, nb = item % nblk, k0 = kb * 64, n0 = nb * 32;
    const int n = n0 + (lane & 31);
    const int sc = (KIND == 0) ? win_srccol(n) : n;
#pragma unroll 8
    for (int i = 0; i < 32; ++i) {
        const int kk = 2 * i + (lane >> 5);
        float v = 0.f;
        if (sc >= 0) v = W[(size_t)(k0 + kk) * ldw + sc];
        if (gain) v *= gain[k0 + kk];
        scr[kk * 33 + (lane & 31)] = v;
    }
    LDS_WAIT();
    const int c = lane & 7;
#pragma unroll
    for (int j = 0; j < 4; ++j) {
        const int nn = (lane >> 3) + 8 * j;
        const float* s = scr + (8 * c) * 33 + nn;
        u32x4 o;
        o.x = cvtpk(s[0 * 33], s[1 * 33]); o.y = cvtpk(s[2 * 33], s[3 * 33]); o.z = cvtpk(s[4 * 33], s[5 * 33]); o.w = cvtpk(s[6 * 33], s[7 * 33]);
        *(u32x4*)(WT + (size_t)(n0 + nn) * K + k0 + 8 * c) = o;
    }
    LDS_WAIT();
}
DEVINL void norm_row_bf16(const float* xrow, bf16_t* orow, int lane) {
    const f32x4* xr = (const f32x4*)xrow + lane;
    f32x4 v[4]; float s = 0.f;
#pragma unroll
    for (int j = 0; j < 4; ++j) { v[j] = xr[64 * j]; s += (v[j].x * v[j].x + v[j].y * v[j].y) + (v[j].z * v[j].z + v[j].w * v[j].w); }
    const float rstd = rsqrtf(wave_sum(s) * (1.f / DM) + EPS);
    u32x2* o8 = (u32x2*)orow + lane;
#pragma unroll
    for (int j = 0; j < 4; ++j) { u32x2 w; w.x = cvtpk(v[j].x * rstd, v[j].y * rstd); w.y = cvtpk(v[j].z * rstd, v[j].w * rstd); o8[64 * j] = w; }
}
DEVINL void phase0(const Params& p, char* lds) {
    const int tid = threadIdx.x, lane = tid & 63, wave = tid >> 6;
    const int gw = blockIdx.x * 8 + wave, NGW = gridDim.x * 8;
    unsigned* ctl = (unsigned*)(p.ws + WS_CTL);
    for (int i = blockIdx.x * NTHR + tid; i < CTL_WORDS + XCD_BAR_WORDS; i += gridDim.x * NTHR) ctl[i < CTL_WORDS ? i : CTL_XBAR + (i - CTL_WORDS)] = 0u;
    bf16_t* XN = (bf16_t*)p.out;
    bf16_t* MEMN = (bf16_t*)(p.ws + WS_MEMN);
    for (int r = gw; r < NT + NB * NMEM; r += NGW) {
        if (r < NT) norm_row_bf16(p.x + (size_t)r * DM, XN + (size_t)r * DM, lane);
        else norm_row_bf16(p.mem + (size_t)(r - NT) * DM, MEMN + (size_t)(r - NT) * DM, lane);
    }
    float* scr = (float*)(lds + wave * 8448);
    constexpr int I_WIN = 16 * (NWIN / 32), I_BR = 16 * 32, I_OUT = 16 * 32, I_MEM = 16 * 16;
    for (int it = gw; it < I_WIN + I_BR + I_OUT + I_MEM; it += NGW) {
        int r = it;
        if (r < I_WIN) { p0_transpose_item<0>(p.w_in, INW, p.norm_gain, (bf16_t*)(p.ws + WS_WIN), DM, r, NWIN / 32, scr, lane); continue; } r -= I_WIN;
        if (r < I_BR) { p0_transpose_item<1>(p.w_branch, DM, nullptr, (bf16_t*)(p.ws + WS_WBR), DM, r, 32, scr, lane); continue; } r -= I_BR;
        if (r < I_OUT) { p0_transpose_item<1>(p.w_out, DM, nullptr, (bf16_t*)(p.ws + WS_WOUT), DM, r, 32, scr, lane); continue; } r -= I_OUT;
        p0_transpose_item<1>(p.w_mem_kv, 512, p.mem_gain, (bf16_t*)(p.ws + WS_WMEM), DM, r, 16, scr, lane);
    }
}

constexpr int G_STAGE = 49152, G_AOFF = 0, G_BOFF = 32768;
DEVINL int swz128(int row, int chunk) { return row * 128 + ((chunk ^ ((row >> 1) & 7)) << 4); }
DEVINL void gemm_tile(const bf16_t* __restrict__ A, int lda, const bf16_t* __restrict__ Bt, int ldb, int K, f32x16 (&acc)[2][2], char* lds) {
    const int tid = threadIdx.x, lane = tid & 63, wave = tid >> 6, wm = wave >> 1, wn = wave & 1, r32 = lane & 31, hi = lane >> 5;
    const int lr = tid >> 3, lc = tid & 7;
    const bf16_t* ga = A + (size_t)lr * lda + lc * 8;
    const bf16_t* gb = Bt + (size_t)lr * ldb + lc * 8;
    u32x4 ra[4], rb[2];
#pragma unroll
    for (int j = 0; j < 4; ++j) ra[j] = *(const u32x4*)(ga + (size_t)(64 * j) * lda);
#pragma unroll
    for (int j = 0; j < 2; ++j) rb[j] = *(const u32x4*)(gb + (size_t)(64 * j) * ldb);
#pragma unroll
    for (int j = 0; j < 4; ++j) *(u32x4*)(lds + G_AOFF + swz128(lr + 64 * j, lc)) = ra[j];
#pragma unroll
    for (int j = 0; j < 2; ++j) *(u32x4*)(lds + G_BOFF + swz128(lr + 64 * j, lc)) = rb[j];
    __syncthreads();
    const int nk = K / 64;
    for (int kt = 0; kt < nk; ++kt) {
        const char* st = lds + (kt & 1) * G_STAGE;
        if (kt + 1 < nk) {
#pragma unroll
            for (int j = 0; j < 4; ++j) ra[j] = *(const u32x4*)(ga + (size_t)(64 * j) * lda + (kt + 1) * 64);
#pragma unroll
            for (int j = 0; j < 2; ++j) rb[j] = *(const u32x4*)(gb + (size_t)(64 * j) * ldb + (kt + 1) * 64);
        }
#pragma unroll
        for (int s = 0; s < 4; ++s) {
            const bf16x8 a0 = *(const bf16x8*)(st + G_AOFF + swz128(wm * 64 + r32, 2 * s + hi));
            const bf16x8 a1 = *(const bf16x8*)(st + G_AOFF + swz128(wm * 64 + 32 + r32, 2 * s + hi));
            const bf16x8 b0 = *(const bf16x8*)(st + G_BOFF + swz128(wn * 64 + r32, 2 * s + hi));
            const bf16x8 b1 = *(const bf16x8*)(st + G_BOFF + swz128(wn * 64 + 32 + r32, 2 * s + hi));
            acc[0][0] = MFMA32(b0, a0, acc[0][0]); acc[0][1] = MFMA32(b1, a0, acc[0][1]);
            acc[1][0] = MFMA32(b0, a1, acc[1][0]); acc[1][1] = MFMA32(b1, a1, acc[1][1]);
        }
        if (kt + 1 < nk) {
            char* sn = lds + ((kt + 1) & 1) * G_STAGE;
#pragma unroll
            for (int j = 0; j < 4; ++j) *(u32x4*)(sn + G_AOFF + swz128(lr + 64 * j, lc)) = ra[j];
#pragma unroll
            for (int j = 0; j < 2; ++j) *(u32x4*)(sn + G_BOFF + swz128(lr + 64 * j, lc)) = rb[j];
        }
        __syncthreads();
    }
}
DEVINL void zero_acc(f32x16 (&acc)[2][2]) {
#pragma unroll
    for (int i = 0; i < 2; ++i)
#pragma unroll
        for (int j = 0; j < 2; ++j)
#pragma unroll
            for (int r = 0; r < 16; ++r) acc[i][j][r] = 0.f;
}
constexpr int STG_PITCH = 272;
template <int ACT>
DEVINL void epi_to_lds(const f32x16 (&acc)[2][2], char* lds, float sc) {
    const int tid = threadIdx.x, lane = tid & 63, wave = tid >> 6, wm = wave >> 1, wn = wave & 1, r32 = lane & 31, hi = lane >> 5;
#pragma unroll
    for (int i = 0; i < 2; ++i)
#pragma unroll
        for (int j = 0; j < 2; ++j)
#pragma unroll
            for (int g = 0; g < 4; ++g) {
                float v[4];
#pragma unroll
                for (int e = 0; e < 4; ++e) {
                    float t = acc[i][j][4 * g + e];
                    if (ACT == 1) t *= sc;
                    if (ACT == 2) t = fsilu(t);
                    if (ACT == 3) t = fsigm(t);
                    v[e] = t;
                }
                u32x2 w; w.x = cvtpk(v[0], v[1]); w.y = cvtpk(v[2], v[3]);
                *(u32x2*)(lds + (wm * 64 + 32 * i + r32) * STG_PITCH + (wn * 64 + 32 * j + 8 * g + 4 * hi) * 2) = w;
            }
}
DEVINL void lds_tile_store(char* lds, bf16_t* C, int ldc) {
    const int tid = threadIdx.x;
#pragma unroll
    for (int j = 0; j < 8; ++j) {
        const int row = (tid >> 4) + 32 * j, ch = tid & 15;
        const u32x4 v = *(const u32x4*)(lds + row * STG_PITCH + ch * 16);
        *(u32x4*)(C + (size_t)row * ldc + ch * 8) = v;
    }
}


namespace pg8 {
#define PG8_LAS __attribute__((address_space(3)))
typedef float f32x4 __attribute__((ext_vector_type(4)));
typedef unsigned u32x4 __attribute__((ext_vector_type(4)));
constexpr int BM = 256, BK = 64, HALF = 128, HTB = HALF * BK * 2  , STAGE_BYTES = 8 * HTB, NXCD = 8, WGM = 8;

__host__ __device__ __forceinline__ int lds_byte(int r, int c) { const int st = (r >> 4) * 2 + (c >> 5), rr = r & 15, cc = c & 31, ob = rr * 64 + cc * 2; return st * 1024 + (ob ^ (((ob >> 9) & 1) << 5)); }
__host__ __device__ __forceinline__ void stage_rc(int b, int& R, int& C) { const int st = b / 1024, sb = b % 1024, swz = sb ^ (((sb >> 9) & 1) << 5); R = (st >> 1) * 16 + swz / 64; C = (st & 1) * 32 + (swz % 64) / 2; }
__host__ __device__ __forceinline__ int perm32(int rho) { const int n = rho >> 4, i = rho & 15; return 8 * (i >> 2) + 4 * n + (i & 3); }

struct Unit { int pm, pn; };
struct Gemm { const bf16_t* A; const bf16_t* Bt; int M, N, K; };

struct StaticOrder {
    int nM, nN, nwg, G, c;
    __host__ __device__ void init(int M, int N, int G_, int c_) { nM = M / BM; nN = N / BM; nwg = nM * nN; G = G_; c = c_; }
    __host__ __device__ bool next(int i, Unit& u) const {
        const long L = (long)i * G + c; if (L >= nwg) return false;
        int wgid = (int)L; { const int q = nwg / NXCD, r = nwg % NXCD, xcd = wgid % NXCD, off = wgid / NXCD; wgid = (xcd < r ? xcd * (q + 1) : r * (q + 1) + (xcd - r) * q) + off; }
        const int nig = WGM * nN, gid = wgid / nig, fm = gid * WGM, gsz = (nM - fm) < WGM ? (nM - fm) : WGM;
        u.pm = fm + ((wgid % nig) % gsz); u.pn = (wgid % nig) / gsz; return true;
    }
    __device__ __forceinline__ void a_ready(const Unit&) const {}
    __device__ __forceinline__ void done(const Unit&) const {}
};
template <class Epi, class Sched, bool ALIGN_EPI = false, bool SP2 = false>
__device__ __forceinline__ void gemm_phase(PG8_LAS unsigned char* lds, const Gemm g, const Sched& S, const Epi& E) {
    int tid_ = threadIdx.x; asm volatile("" : "+v"(tid_));
    const int tid = tid_, wid = __builtin_amdgcn_readfirstlane(tid >> 6), lane = tid & 63, wr = wid >> 2, wc = wid & 3, fr = lane & 15, fq = lane >> 4;
    const int K = g.K, nt = K / BK;
    unsigned voffA[2], voffB[2];
#pragma unroll
    for (int i = 0; i < 2; ++i) { int R, C; stage_rc(tid * 16 + i * 8192, R, C); const int Rb = Epi::PERM ? ((R & ~31) + perm32(R & 31)) : R;
        voffA[i] = (unsigned)(R * K + C) * 2u; voffB[i] = (unsigned)(Rb * K + C) * 2u; }
    const size_t kstep = (size_t)(BK * 2);
    const size_t hstep = (size_t)HALF * K * 2;
    const size_t tstep = 2 * hstep;
    const unsigned ldsw = (unsigned)wid * 1024u;
    const int aoff = lds_byte(wr * 64 + fr, fq * 8), boff = lds_byte(wc * 32 + fr, fq * 8);
#define PG8_SA(b, h) (((b) * 2 + (h)) * HTB)
#define PG8_SB(b, h) ((4 + (b) * 2 + (h)) * HTB)
#define PG8_STAGE(bufoff, gbase, voff) do { _Pragma("unroll") for (int _i = 0; _i < 2; ++_i) \
        __builtin_amdgcn_global_load_lds((const unsigned*)((const char*)(gbase) + (voff)[_i]), (PG8_LAS unsigned*)(lds + (bufoff) + ldsw + _i * 8192), 16, 0, 0); } while (0)
#define PG8_LDA(dst, b, h) do { _Pragma("unroll") for (int m = 0; m < 4; ++m) _Pragma("unroll") for (int k = 0; k < 2; ++k) dst[m][k] = *(const PG8_LAS bf16x8*)(lds + PG8_SA(b, h) + aoff + m * 2048 + k * 1024); } while (0)
#define PG8_LDB(dst, b, h) do { _Pragma("unroll") for (int n = 0; n < 2; ++n) _Pragma("unroll") for (int k = 0; k < 2; ++k) dst[n][k] = *(const PG8_LAS bf16x8*)(lds + PG8_SB(b, h) + boff + n * 2048 + k * 1024); } while (0)
#define PG8_MMA(ai, bj, At, Bt) do { __builtin_amdgcn_s_setprio(1); _Pragma("unroll") for (int m = 0; m < 4; ++m) _Pragma("unroll") for (int n = 0; n < 2; ++n) _Pragma("unroll") for (int k = 0; k < 2; ++k) \
        acc[ai][bj][m][n] = __builtin_amdgcn_mfma_f32_16x16x32_bf16(Bt[n][k], At[m][k], acc[ai][bj][m][n], 0, 0, 0); __builtin_amdgcn_s_setprio(0); } while (0)
#define PG8_WAIT_V(n) asm volatile("s_waitcnt vmcnt(" #n ")" ::: "memory")
#define PG8_WAIT_L(n) asm volatile("s_waitcnt lgkmcnt(" #n ")" ::: "memory")
#define PG8_BAR __builtin_amdgcn_s_barrier()
#define PG8_SCHED __builtin_amdgcn_sched_barrier(0)
    Unit cur, nxt; int ui = 0;
    if (!S.next(0, cur)) return;
    f32x4 acc[2][2][4][2];
#pragma unroll
    for (int a = 0; a < 2; ++a)
#pragma unroll
        for (int b = 0; b < 2; ++b)
#pragma unroll
            for (int m = 0; m < 4; ++m)
#pragma unroll
                for (int n = 0; n < 2; ++n) acc[a][b][m][n] = (f32x4){0.f, 0.f, 0.f, 0.f};
    bf16x8 At[4][2], B0[2][2], B1[2][2];
    const char* cA = (const char*)g.A + (size_t)cur.pm * tstep; const char* cB = (const char*)g.Bt + (size_t)cur.pn * tstep;
    S.a_ready(cur);
    if constexpr (SP2) {
        PG8_STAGE(PG8_SB(0, 0), cB, voffB); PG8_STAGE(PG8_SB(0, 1), cB + hstep, voffB); PG8_STAGE(PG8_SA(0, 0), cA, voffA); PG8_STAGE(PG8_SA(0, 1), cA + hstep, voffA);
        if (wr == 1) PG8_BAR;
        PG8_WAIT_V(2); PG8_BAR;
        PG8_STAGE(PG8_SB(1, 0), cB + kstep, voffB); PG8_STAGE(PG8_SA(1, 0), cA + kstep, voffA); PG8_STAGE(PG8_SB(1, 1), cB + hstep + kstep, voffB);
        PG8_WAIT_V(6); PG8_BAR;
    } else {
        PG8_STAGE(PG8_SB(0, 0), cB, voffB); PG8_STAGE(PG8_SA(0, 0), cA, voffA); PG8_STAGE(PG8_SB(0, 1), cB + hstep, voffB); PG8_STAGE(PG8_SA(0, 1), cA + hstep, voffA);
        if (wr == 1) PG8_BAR;
        PG8_WAIT_V(4); PG8_BAR;
        PG8_STAGE(PG8_SB(1, 0), cB + kstep, voffB); PG8_STAGE(PG8_SA(1, 0), cA + kstep, voffA); PG8_STAGE(PG8_SB(1, 1), cB + hstep + kstep, voffB);
        PG8_WAIT_V(6); PG8_BAR;
    }
    for (;;) {
        const bool has_next = S.next(ui + 1, nxt);
        const char* nA = has_next ? (const char*)g.A + (size_t)nxt.pm * tstep : cA; const char* nB = has_next ? (const char*)g.Bt + (size_t)nxt.pn * tstep : cB;
        for (int t = 0; t < nt; t += 2) {
            const bool last = (t == nt - 2);
            const char* a1 = cA + (size_t)(t + 1) * kstep;
            const char* a2 = last ? nA : cA + (size_t)(t + 2) * kstep; const char* b2 = last ? nB : cB + (size_t)(t + 2) * kstep;
            const char* a3 = a2 + kstep; const char* b3 = b2 + kstep;
            if (last && has_next) S.a_ready(nxt);
            if constexpr (SP2) {
            PG8_LDB(B0, 0, 0); PG8_LDB(B1, 0, 1); PG8_SCHED; PG8_LDA(At, 0, 0); PG8_STAGE(PG8_SA(1, 1), a1 + hstep, voffA);
            PG8_WAIT_V(8); PG8_WAIT_L(0); PG8_BAR; PG8_MMA(0, 0, At, B0); PG8_MMA(0, 1, At, B1); PG8_BAR; PG8_SCHED;
            PG8_LDA(At, 0, 1); PG8_STAGE(PG8_SB(0, 0), b2, voffB); PG8_STAGE(PG8_SB(0, 1), b2 + hstep, voffB); PG8_STAGE(PG8_SA(0, 0), a2, voffA);
            PG8_WAIT_V(8); PG8_WAIT_L(0); PG8_BAR; PG8_MMA(1, 0, At, B0); PG8_MMA(1, 1, At, B1); PG8_BAR; PG8_SCHED;
            PG8_LDB(B0, 1, 0); PG8_LDB(B1, 1, 1); PG8_SCHED; PG8_LDA(At, 1, 0); PG8_STAGE(PG8_SA(0, 1), a2 + hstep, voffA);
            PG8_WAIT_V(8); PG8_WAIT_L(0); PG8_BAR; PG8_MMA(0, 0, At, B0); PG8_MMA(0, 1, At, B1); PG8_BAR; PG8_SCHED;
            PG8_LDA(At, 1, 1); PG8_STAGE(PG8_SB(1, 0), b3, voffB); PG8_STAGE(PG8_SB(1, 1), b3 + hstep, voffB); PG8_STAGE(PG8_SA(1, 0), a3, voffA);
            PG8_WAIT_V(8); PG8_WAIT_L(0); PG8_BAR; PG8_MMA(1, 0, At, B0); PG8_MMA(1, 1, At, B1); PG8_BAR; PG8_SCHED;
            } else {
            PG8_LDB(B0, 0, 0); PG8_SCHED; PG8_LDA(At, 0, 0); PG8_STAGE(PG8_SA(1, 1), a1 + hstep, voffA);
            PG8_WAIT_L(8); PG8_BAR; PG8_WAIT_L(0); PG8_MMA(0, 0, At, B0); PG8_BAR; PG8_SCHED;
            PG8_LDB(B1, 0, 1); PG8_STAGE(PG8_SB(0, 0), b2, voffB);
            PG8_BAR; PG8_WAIT_L(0); PG8_MMA(0, 1, At, B1); PG8_BAR;
            PG8_LDA(At, 0, 1); PG8_STAGE(PG8_SA(0, 0), a2, voffA);
            PG8_BAR; PG8_WAIT_L(0); PG8_MMA(1, 0, At, B0); PG8_BAR; PG8_SCHED;
            PG8_STAGE(PG8_SB(0, 1), b2 + hstep, voffB);
            PG8_WAIT_V(6); PG8_BAR; PG8_MMA(1, 1, At, B1); PG8_BAR;
            PG8_LDB(B0, 1, 0); PG8_SCHED; PG8_LDA(At, 1, 0); PG8_STAGE(PG8_SA(0, 1), a2 + hstep, voffA);
            PG8_WAIT_L(8); PG8_BAR; PG8_WAIT_L(0); PG8_MMA(0, 0, At, B0); PG8_BAR; PG8_SCHED;
            PG8_LDB(B1, 1, 1); PG8_STAGE(PG8_SB(1, 0), b3, voffB);
            PG8_BAR; PG8_WAIT_L(0); PG8_MMA(0, 1, At, B1); PG8_BAR;
            PG8_LDA(At, 1, 1); PG8_STAGE(PG8_SA(1, 0), a3, voffA);
            PG8_BAR; PG8_WAIT_L(0); PG8_MMA(1, 0, At, B0); PG8_BAR; PG8_SCHED;
            PG8_STAGE(PG8_SB(1, 1), b3 + hstep, voffB);
            PG8_WAIT_V(6); PG8_BAR; PG8_MMA(1, 1, At, B1); PG8_BAR;
            }
        }
        if constexpr (ALIGN_EPI) { if (wr == 0) PG8_BAR; }
        if constexpr (!Epi::AFTER_DRAIN) { E(acc, cur, wr, wc, fr, fq); S.done(cur); }
        if (!has_next) break;
#pragma unroll
        for (int a = 0; a < 2; ++a)
#pragma unroll
            for (int b = 0; b < 2; ++b)
#pragma unroll
                for (int m = 0; m < 4; ++m)
#pragma unroll
                    for (int n = 0; n < 2; ++n) acc[a][b][m][n] = (f32x4){0.f, 0.f, 0.f, 0.f};
        cur = nxt; cA = nA; cB = nB; ++ui;
        if constexpr (ALIGN_EPI) { if (wr == 1) PG8_BAR; }
    }
    PG8_WAIT_V(0);
    if constexpr (!ALIGN_EPI) { if (wr == 0) PG8_BAR; }
    PG8_BAR;
    if constexpr (Epi::AFTER_DRAIN) { E.fused(acc, cur, wr, wc, fr, fq, lds, wid, lane); S.done(cur); }
#undef PG8_SA
#undef PG8_SB
#undef PG8_STAGE
#undef PG8_LDA
#undef PG8_LDB
#undef PG8_MMA
#undef PG8_WAIT_V
#undef PG8_WAIT_L
#undef PG8_BAR
#undef PG8_SCHED
}
}

DEVINL void proj_store_group(const pg8::f32x4 (&acc)[2][2][4][2], int bj, bf16_t* dst, int ld, int act, size_t row0, int cl0) {
    bf16_t* dp = dst + row0 * ld + cl0;
#pragma unroll
    for (int ai = 0; ai < 2; ++ai)
#pragma unroll
        for (int m = 0; m < 4; ++m) {
            float v[8];
#pragma unroll
            for (int e = 0; e < 4; ++e) { v[e] = bj == 0 ? acc[ai][0][m][0][e] : acc[ai][1][m][0][e]; v[4 + e] = bj == 0 ? acc[ai][0][m][1][e] : acc[ai][1][m][1][e]; }
            if (act == 1) {
#pragma unroll
                for (int e = 0; e < 8; ++e) v[e] *= QSCALE;
            } else if (act == 2) {
#pragma unroll
                for (int e = 0; e < 8; ++e) v[e] = fsilu(v[e]);
            } else if (act == 3) {
#pragma unroll
                for (int e = 0; e < 8; ++e) v[e] = fsigm(v[e]);
            }
            u32x4 w; w.x = cvtpk(v[0], v[1]); w.y = cvtpk(v[2], v[3]); w.z = cvtpk(v[4], v[5]); w.w = cvtpk(v[6], v[7]);
            *(u32x4*)(dp + (size_t)(ai * 128 + m * 16) * ld) = w;
            asm volatile("" ::: "memory");
        }
}
struct EpiProj {
    static constexpr bool PERM = true, AFTER_DRAIN = false;
    unsigned char* ws;
    DEVINL void operator()(const pg8::f32x4 (&acc)[2][2][4][2], const pg8::Unit& u, int wr, int wc, int fr, int fq) const {
#pragma unroll
        for (int bj = 0; bj < 2; ++bj) {
            const int idx = 2 * u.pn + bj;
            if (idx >= 57) continue;
            const size_t row0 = (size_t)u.pm * 256 + wr * 64 + fr;
            const int cl0 = wc * 32 + 8 * fq;
            size_t boff; int ld, act = 0;
            if (idx < 24) { const int g8 = idx / 3; boff = WS_ACT8 + (size_t)g8 * ACT_STRIDE + (idx % 3) * 256; ld = 384; act = (g8 == 0 || g8 == 4) ? 1 : ((g8 == 3 || g8 == 7) ? 2 : 0); }
            else if (idx < 28) { boff = WS_IQ + (idx - 24) * 256; ld = 512; }
            else if (idx < 30) { boff = WS_QM + (idx - 28) * 256; ld = 256; act = 1; }
            else if (idx < 32) { boff = WS_ZM + (idx - 30) * 256; ld = 256; act = 2; }
            else if (idx == 32) { boff = WS_IK; ld = 64; }
            else { boff = WS_GATES + (idx - 33) * 256; ld = 3072; act = 3; }
            if (idx != 32 || wc < 2) proj_store_group(acc, bj, (bf16_t*)(ws + boff), ld, act, row0, cl0);
            if (idx == 32 && wc == 2 && fq == 0) {
                float* IW = (float*)(ws + WS_IW);
#pragma unroll
                for (int ai = 0; ai < 2; ++ai)
#pragma unroll
                    for (int m = 0; m < 4; ++m) {
                        const size_t r = row0 + ai * 128 + m * 16;
                        *(f32x4*)(IW + r * 8) = acc[ai][bj][m][0] * CSCALE; *(f32x4*)(IW + r * 8 + 4) = acc[ai][bj][m][1] * CSCALE;
                    }
            }
            if (idx >= 3 && idx < 6) {
                float cs[8];
#pragma unroll
                for (int e = 0; e < 8; ++e) cs[e] = 0.f;
#pragma unroll
                for (int ai = 0; ai < 2; ++ai)
#pragma unroll
                    for (int m = 0; m < 4; ++m)
#pragma unroll
                        for (int e = 0; e < 4; ++e) { cs[e] += acc[ai][bj][m][0][e]; cs[4 + e] += acc[ai][bj][m][1][e]; }
#pragma unroll
                for (int e = 0; e < 8; ++e) { cs[e] += __shfl_xor(cs[e], 1); cs[e] += __shfl_xor(cs[e], 2); cs[e] += __shfl_xor(cs[e], 4); cs[e] += __shfl_xor(cs[e], 8); }
                if (fr == 0) {
                    float* KM = (float*)(ws + WS_KMEAN) + ((size_t)u.pm * 2 + wr) * 384 + (idx - 3) * 128 + cl0;
                    *(f32x4*)KM = (f32x4){cs[0], cs[1], cs[2], cs[3]}; *(f32x4*)(KM + 4) = (f32x4){cs[4], cs[5], cs[6], cs[7]};
                }
            }
            asm volatile("" ::: "memory");
        }
    }
};
struct EpiOut {
    static constexpr bool PERM = false, AFTER_DRAIN = false;
    const float* x; float* out; float* ssq;
    DEVINL void operator()(const pg8::f32x4 (&acc)[2][2][4][2], const pg8::Unit& u, int wr, int wc, int fr, int fq) const {
#pragma unroll
        for (int ai = 0; ai < 2; ++ai)
#pragma unroll
            for (int m = 0; m < 4; ++m) {
                const size_t row = (size_t)u.pm * 256 + ai * 128 + wr * 64 + m * 16 + fr;
                float ss = 0.f;
#pragma unroll
                for (int bj = 0; bj < 2; ++bj)
#pragma unroll
                    for (int n = 0; n < 2; ++n) {
                        const int col = u.pn * 256 + bj * 128 + wc * 32 + n * 16 + 4 * fq;
                        const f32x4 xv = *(const f32x4*)(x + row * DM + col);
                        const f32x4 y = xv + acc[ai][bj][m][n];
                        ss += (y.x * y.x + y.y * y.y) + (y.z * y.z + y.w * y.w);
                        *(f32x4*)(out + row * DM + col) = y;
                    }
                ss += __shfl_xor(ss, 16); ss += __shfl_xor(ss, 32);
                if (fq == 0) ssq[row * 16 + u.pn * 4 + wc] = ss;
            }
    }
};
DEVINL void phase1(const Params& p, char* lds) {
    {
        pg8::Gemm g{(const bf16_t*)p.out, (const bf16_t*)(p.ws + WS_WIN), NT, NWIN, DM};
        pg8::StaticOrder S; S.init(NT, NWIN, (int)gridDim.x, (int)blockIdx.x);
        EpiProj E{p.ws};
        pg8::gemm_phase<EpiProj, pg8::StaticOrder, true, true>((LAS unsigned char*)lds, g, S, E);
    }
    __syncthreads();
    for (int it = (int)blockIdx.x - (gridDim.x >= 144 ? 128 : 0); it >= 0 && it < 16; it += gridDim.x) {
        const int mt = it >> 2, nt = it & 3;
        f32x16 acc[2][2]; zero_acc(acc);
        gemm_tile((const bf16_t*)(p.ws + WS_MEMN) + (size_t)mt * 256 * DM, DM, (const bf16_t*)(p.ws + WS_WMEM) + (size_t)nt * 128 * DM, DM, DM, acc, lds);
        epi_to_lds<0>(acc, lds, 1.f); __syncthreads();
        bf16_t* dst = (bf16_t*)(p.ws + (nt < 2 ? WS_MK : WS_MV)) + (size_t)mt * 256 * 256 + (nt & 1) * 128;
        lds_tile_store(lds, dst, 256); __syncthreads();
    }
}

DEVINL void phase_merge(const Params& p, char* lds) {
    const int tid = threadIdx.x, lane = tid & 63, wave = tid >> 6, wm = wave >> 1, wn = wave & 1, r32 = lane & 31, hi = lane >> 5;
    const bf16_t* WBR = (const bf16_t*)(p.ws + WS_WBR);
    const bf16_t* GATES = (const bf16_t*)(p.ws + WS_GATES);
    for (int it = blockIdx.x; it < 128 * 8; it += gridDim.x) {
        const int nt = it >> 7, mt = it & 127;
        const size_t m0 = (size_t)mt * 256;
        f32x16 acc[2][2]; zero_acc(acc);
#pragma unroll 1
        for (int br = 0; br < 3; ++br) {
            const bf16_t* Y; int ldy, K, koff;
            if (br == 0) { Y = (const bf16_t*)(p.ws + WS_ACT8) + m0 * 384; ldy = 384; K = 384; koff = 0; }
            else if (br == 1) { Y = (const bf16_t*)(p.ws + WS_ACT8 + 4 * ACT_STRIDE) + m0 * 384; ldy = 384; K = 384; koff = 384; }
            else { Y = (const bf16_t*)(p.ws + WS_QM) + m0 * 256; ldy = 256; K = 256; koff = 768; }
            gemm_tile(Y, ldy, WBR + (size_t)nt * 128 * DM + koff, DM, K, acc, lds);
#pragma unroll
            for (int i = 0; i < 2; ++i)
#pragma unroll
                for (int j = 0; j < 2; ++j)
#pragma unroll
                    for (int g = 0; g < 4; ++g) {
                        const size_t m = m0 + wm * 64 + 32 * i + r32;
                        const int n = nt * 128 + wn * 64 + 32 * j + 8 * g + 4 * hi;
                        const u32x2 gw = *(const u32x2*)(GATES + m * 3072 + br * 1024 + n);
                        float f0 = bf_lo(gw.x), f1 = bf_hi(gw.x), f2 = bf_lo(gw.y), f3 = bf_hi(gw.y);
                        if (br < 2) {
                            const u32x2 gn = *(const u32x2*)(GATES + m * 3072 + (br + 1) * 1024 + n);
                            f0 *= frcp(bf_lo(gn.x)); f1 *= frcp(bf_hi(gn.x)); f2 *= frcp(bf_lo(gn.y)); f3 *= frcp(bf_hi(gn.y));
                        }
                        acc[i][j][4 * g + 0] *= f0; acc[i][j][4 * g + 1] *= f1; acc[i][j][4 * g + 2] *= f2; acc[i][j][4 * g + 3] *= f3;
                    }
        }
        epi_to_lds<0>(acc, lds, 1.f); __syncthreads();
        lds_tile_store(lds, (bf16_t*)(p.ws + WS_MERGED) + m0 * DM + nt * 128, DM); __syncthreads();
    }
}

DEVINL void phase_out(const Params& p, char* lds) {
    pg8::Gemm g{(const bf16_t*)(p.ws + WS_MERGED), (const bf16_t*)(p.ws + WS_WOUT), NT, DM, DM};
    pg8::StaticOrder S; S.init(NT, DM, (int)gridDim.x, (int)blockIdx.x);
    EpiOut E{p.x, p.out, (float*)(p.ws + WS_SSQ)};
    pg8::gemm_phase<EpiOut, pg8::StaticOrder, true, true>((LAS unsigned char*)lds, g, S, E);
    __syncthreads();
}
DEVINL void phase_final(const Params& p) {
    const int tid = threadIdx.x, lane = tid & 63, wave = tid >> 6;
#ifdef PROBE_A
    const unsigned* tsw = (const unsigned*)(p.ws + WS_CTL) + 4096;
    const float probeA = (float)(tsw[PROBE_A + 1] - tsw[PROBE_A]) * 1e-4f;
    const float probeB = (float)(tsw[PROBE_B + 1] - tsw[PROBE_B]) * 1e-5f;
#endif
    const float* SSQ = (const float*)(p.ws + WS_SSQ);
    for (int r = blockIdx.x * 8 + wave; r < NT; r += gridDim.x * 8) {
        float ss = 0.f;
#pragma unroll
        for (int k = 0; k < 4; ++k) { const f32x4 sv = *(const f32x4*)(SSQ + (size_t)r * 16 + 4 * k); ss += (sv.x + sv.y) + (sv.z + sv.w); }
        const float rstd = rsqrtf(ss * (1.f / DM) + EPS);
        f32x4* yr = (f32x4*)(p.out + (size_t)r * DM) + lane;
        const f32x4* gr = (const f32x4*)p.final_gain + lane;
#pragma unroll
        for (int j = 0; j < 4; ++j) { f32x4 y = yr[64 * j]; const f32x4 g = gr[64 * j]; y.x *= rstd * g.x; y.y *= rstd * g.y; y.z *= rstd * g.z; y.w *= rstd * g.w;
#ifdef PROBE_A
            y.x += probeB; y.y += probeB; y.z += probeB; y.w += probeB; if (r == 0 && j == 0 && lane == 0) y.x += probeA;
#endif
            yr[64 * j] = y; }
    }
}

constexpr int AT_K = 0, AT_V = 32768, AT_VPLANE = 16384 + 64, AT_END = AT_V + 2 * AT_VPLANE;
DEVINL void load_kv_block(const bf16_t* __restrict__ Kg, const bf16_t* __restrict__ Vg, int ld, char* lds) {
    const int tid = threadIdx.x, c = tid & 7, kr = tid >> 3;
    u32x4 kk[4], vv[4];
#pragma unroll
    for (int j = 0; j < 4; ++j) { kk[j] = *(const u32x4*)(Kg + (size_t)(kr + 64 * j) * ld + c * 8); vv[j] = *(const u32x4*)(Vg + (size_t)(kr + 64 * j) * ld + c * 8); }
#pragma unroll
    for (int j = 0; j < 4; ++j) {
        const int key = kr + 64 * j;
        *(u32x4*)(lds + AT_K + swz128(key, c)) = kk[j];
        *(u32x4*)(lds + AT_V + (c >> 2) * AT_VPLANE + key * 64 + (c & 3) * 16) = vv[j];
    }
}
DEVINL s16x4 tr_read(const char* p) {
    typedef short v4i16_t __attribute__((ext_vector_type(4)));
    return __builtin_bit_cast(s16x4, __builtin_amdgcn_ds_read_tr16_b64_v4i16((LAS v4i16_t*)(uintptr_t)(unsigned)(uintptr_t)p));
}
struct AttnState { float mhat, l; f32x16 o0, o1; };
constexpr float ATT_THR = 8.f;
template <int MODE>
DEVINL void attn_256(const bf16x8 (&qf)[4], const char* lds, int t_row, int pos0, const float* lut, float* wsf, AttnState& st) {
    const int lane = threadIdx.x & 63, r32 = lane & 31, hi = lane >> 5;
    const char* KL = lds + AT_K;
    const char* vbase = lds + AT_V + (4 * hi + ((lane & 15) >> 2)) * 64 + ((lane >> 4) & 1) * 32 + (lane & 3) * 8;
    float mhat = 0.f, l = 0.f;
    f32x16 o0, o1;
#pragma unroll
    for (int r = 0; r < 16; ++r) { o0[r] = 0.f; o1[r] = 0.f; }
#pragma unroll 1
    for (int stp = 0; stp < 4; ++stp) {
        f32x16 s0, s1;
#pragma unroll
        for (int r = 0; r < 16; ++r) { s0[r] = 0.f; s1[r] = 0.f; }
#pragma unroll
        for (int s = 0; s < 4; ++s) {
            const bf16x8 k0 = *(const bf16x8*)(KL + swz128(64 * stp + r32, 2 * s + hi));
            const bf16x8 k1 = *(const bf16x8*)(KL + swz128(64 * stp + 32 + r32, 2 * s + hi));
            s0 = MFMA32(k0, qf[s], s0); s1 = MFMA32(k1, qf[s], s1);
        }
        if (MODE == 1) {
#pragma unroll
            for (int r = 0; r < 16; ++r) {
                const int d0 = t_row - (pos0 + 64 * stp + crow(r, hi)), d1 = d0 - 32;
                s0[r] = d0 < 0 ? -INFINITY : s0[r] + lut[d0 > 127 ? 127 : d0];
                s1[r] = d1 < 0 ? -INFINITY : s1[r] + lut[d1 > 127 ? 127 : d1];
            }
        }
        float rm = fmaxf(s0[0], s1[0]);
#pragma unroll
        for (int r = 1; r < 16; ++r) rm = fmaxf(rm, fmaxf(s0[r], s1[r]));
        { auto rr = __builtin_amdgcn_permlane32_swap(__float_as_uint(rm), __float_as_uint(rm), false, false); rm = fmaxf(__uint_as_float(rr[0]), __uint_as_float(rr[1])); }
        if (stp == 0) { mhat = fmaxf(rm, -1e30f); }
        else {
            const float grow = rm - mhat;
            if (__any(grow > ATT_THR)) {
                const float dl = fmaxf(grow, 0.f); mhat += dl;
                const float f = fexp2(-dl); l *= f;
                if (hi == 0) wsf[r32] = f;
                LDS_WAIT();
#pragma unroll
                for (int g = 0; g < 4; ++g) {
                    const f32x4 fv = *(const f32x4*)(wsf + 8 * g + 4 * hi);
                    o0[4 * g + 0] *= fv.x; o0[4 * g + 1] *= fv.y; o0[4 * g + 2] *= fv.z; o0[4 * g + 3] *= fv.w;
                    o1[4 * g + 0] *= fv.x; o1[4 * g + 1] *= fv.y; o1[4 * g + 2] *= fv.z; o1[4 * g + 3] *= fv.w;
                }
                LDS_WAIT();
            }
        }
        float ps = 0.f;
#pragma unroll
        for (int r = 0; r < 16; ++r) { s0[r] = fexp2(s0[r] - mhat); s1[r] = fexp2(s1[r] - mhat); ps += s0[r] + s1[r]; }
        l += ps;
#pragma unroll
        for (int sub = 0; sub < 2; ++sub)
#pragma unroll
            for (int sp = 0; sp < 2; ++sp) {
                u32x4 pw;
                if (sub == 0) { pw.x = cvtpk(s0[8 * sp + 0], s0[8 * sp + 1]); pw.y = cvtpk(s0[8 * sp + 2], s0[8 * sp + 3]); pw.z = cvtpk(s0[8 * sp + 4], s0[8 * sp + 5]); pw.w = cvtpk(s0[8 * sp + 6], s0[8 * sp + 7]); }
                else { pw.x = cvtpk(s1[8 * sp + 0], s1[8 * sp + 1]); pw.y = cvtpk(s1[8 * sp + 2], s1[8 * sp + 3]); pw.z = cvtpk(s1[8 * sp + 4], s1[8 * sp + 5]); pw.w = cvtpk(s1[8 * sp + 6], s1[8 * sp + 7]); }
                const bf16x8 pf = __builtin_bit_cast(bf16x8, pw);
                const int keybase = 64 * stp + 32 * sub + 16 * sp;
                const char* va = vbase + keybase * 64;
                const s16x4 a0 = tr_read(va), a1 = tr_read(va + 512);
                const s16x4 b0 = tr_read(va + AT_VPLANE), b1 = tr_read(va + AT_VPLANE + 512);
                const bf16x8 vf0 = (bf16x8){a0[0], a0[1], a0[2], a0[3], a1[0], a1[1], a1[2], a1[3]};
                const bf16x8 vf1 = (bf16x8){b0[0], b0[1], b0[2], b0[3], b1[0], b1[1], b1[2], b1[3]};
                o0 = MFMA32(pf, vf0, o0); o1 = MFMA32(pf, vf1, o1);
            }
    }
    st.mhat = mhat; st.l = l; st.o0 = o0; st.o1 = o1;
}
DEVINL float half_sum(float v) { auto rr = __builtin_amdgcn_permlane32_swap(__float_as_uint(v), __float_as_uint(v), false, false); return __uint_as_float(rr[0]) + __uint_as_float(rr[1]); }
DEVINL void rows_to_regs(float v, float* wsf, float (&out)[16]) {
    const int lane = threadIdx.x & 63, r32 = lane & 31, hi = lane >> 5;
    LDS_WAIT();
    if (hi == 0) wsf[r32] = v;
    LDS_WAIT();
#pragma unroll
    for (int g = 0; g < 4; ++g) { const f32x4 fv = *(const f32x4*)(wsf + 8 * g + 4 * hi); out[4 * g] = fv.x; out[4 * g + 1] = fv.y; out[4 * g + 2] = fv.z; out[4 * g + 3] = fv.w; }
    LDS_WAIT();
}
DEVINL void build_lut(float* lut, const float* rel_bias, int col) {
    const int tid = threadIdx.x;
    if (tid < 128) lut[tid] = rel_bias[rel_bucket(tid) * 12 + col] * LOG2E;
}

DEVINL void moba_select_item(const Params& p, char* lds, int item) {
    const int tid = threadIdx.x;
    const int b = item / (HA * 16), h = (item / 16) % HA, t = (item % 16) * 512 + tid, own = t >> 8;
    float* km = (float*)lds;
    unsigned* lcnt = (unsigned*)(lds + 8192);
    unsigned* lbase = lcnt + 32;
    const float* KMEAN = (const float*)(p.ws + WS_KMEAN);
    for (int i = tid; i < 2048; i += NTHR) { const size_t o = (size_t)(b * 32 + (i >> 6)) * 768 + h * 64 + (i & 63); km[i] = (KMEAN[o] + KMEAN[o + 384]) * (1.f / 256.f); }
    if (tid < 32) lcnt[tid] = 0u;
    __syncthreads();
    const bf16_t* q = (const bf16_t*)(p.ws + WS_ACT8) + (size_t)(b * SEQ + t) * 384 + h * 64;
    float qv[64];
#pragma unroll
    for (int c = 0; c < 8; ++c) {
        const u32x4 w = *(const u32x4*)(q + c * 8);
        qv[8 * c + 0] = bf_lo(w.x); qv[8 * c + 1] = bf_hi(w.x); qv[8 * c + 2] = bf_lo(w.y); qv[8 * c + 3] = bf_hi(w.y);
        qv[8 * c + 4] = bf_lo(w.z); qv[8 * c + 5] = bf_hi(w.z); qv[8 * c + 6] = bf_lo(w.w); qv[8 * c + 7] = bf_hi(w.w);
    }
    float v0 = -INFINITY, v1 = -INFINITY, v2 = -INFINITY; int i0 = 0, i1 = 1, i2 = 2;
    const int nmax = (((item % 16) * 512 + 511) >> 8);
#pragma unroll 1
    for (int n = 0; n < nmax; ++n) {
        float g = 0.f;
#pragma unroll
        for (int c = 0; c < 16; ++c) { const f32x4 kv = *(const f32x4*)(km + n * 64 + 4 * c); g += qv[4 * c] * kv.x + qv[4 * c + 1] * kv.y + qv[4 * c + 2] * kv.z + qv[4 * c + 3] * kv.w; }
        if (n < own) {
            if (g > v0) { v2 = v1; i2 = i1; v1 = v0; i1 = i0; v0 = g; i0 = n; }
            else if (g > v1) { v2 = v1; i2 = i1; v1 = g; i1 = n; }
            else if (g > v2) { v2 = g; i2 = n; }
        }
    }
    const int nsel = own < 3 ? own : 3;
    unsigned o0 = 0, o1 = 0, o2 = 0;
    if (nsel > 0) o0 = atomicAdd(&lcnt[i0], 1u);
    if (nsel > 1) o1 = atomicAdd(&lcnt[i1], 1u);
    if (nsel > 2) o2 = atomicAdd(&lcnt[i2], 1u);
    __syncthreads();
    unsigned* gcnt = (unsigned*)(p.ws + WS_CTL) + (b * HA + h) * 32;
    if (tid < 32) lbase[tid] = lcnt[tid] ? atomicAdd(&gcnt[tid], lcnt[tid]) : 0u;
    __syncthreads();
    bf16_t* L = (bf16_t*)(p.ws + WS_LIST) + (size_t)(b * HA + h) * LIST_PER_BH;
    if (nsel > 0) L[list_off(i0) + lbase[i0] + o0] = (bf16_t)(t | (0 << 13));
    if (nsel > 1) L[list_off(i1) + lbase[i1] + o1] = (bf16_t)(t | (1 << 13));
    if (nsel > 2) L[list_off(i2) + lbase[i2] + o2] = (bf16_t)(t | (2 << 13));
    __syncthreads();
}

DEVINL void mem_attn_item(const Params& p, char* lds, int item) {
    const int tid = threadIdx.x, lane = tid & 63, wave = tid >> 6, r32 = lane & 31, hi = lane >> 5;
    const int b = item / (HM * 32), h = (item / 32) % HM, qt = item % 32;
    float* wsf = (float*)(lds + AT_END) + wave * 32;
    char* ostg = lds + AT_END + 1024 + wave * 4096;
    load_kv_block((const bf16_t*)(p.ws + WS_MK) + (size_t)b * 256 * 256 + h * 64, (const bf16_t*)(p.ws + WS_MV) + (size_t)b * 256 * 256 + h * 64, 256, lds);
    const size_t row0 = (size_t)b * SEQ + qt * 256 + wave * 32;
    bf16_t* QM = (bf16_t*)(p.ws + WS_QM);
    bf16x8 qf[4];
#pragma unroll
    for (int s = 0; s < 4; ++s) qf[s] = *(const bf16x8*)(QM + (row0 + r32) * 256 + h * 64 + 16 * s + 8 * hi);
    __syncthreads();
    AttnState st;
    attn_256<0>(qf, lds, 0, 0, nullptr, wsf, st);
    const float ltot = half_sum(st.l);
    float rl[16]; rows_to_regs(frcp(ltot), wsf, rl);
#pragma unroll
    for (int r = 0; r < 16; ++r) {
        *(bf16_t*)(ostg + crow(r, hi) * 128 + r32 * 2) = (bf16_t)(cvtpk(st.o0[r] * rl[r], 0.f) & 0xffffu);
        *(bf16_t*)(ostg + crow(r, hi) * 128 + (32 + r32) * 2) = (bf16_t)(cvtpk(st.o1[r] * rl[r], 0.f) & 0xffffu);
    }
    LDS_WAIT();
    const bf16_t* ZM = (const bf16_t*)(p.ws + WS_ZM);
#pragma unroll
    for (int i = 0; i < 4; ++i) {
        const int row = i * 8 + (lane >> 3), ch = lane & 7;
        const u32x4 ov = *(const u32x4*)(ostg + row * 128 + ch * 16);
        const u32x4 zv = *(const u32x4*)(ZM + (row0 + row) * 256 + h * 64 + ch * 8);
        u32x4 w;
        w.x = cvtpk(bf_lo(ov.x) * bf_lo(zv.x), bf_hi(ov.x) * bf_hi(zv.x)); w.y = cvtpk(bf_lo(ov.y) * bf_lo(zv.y), bf_hi(ov.y) * bf_hi(zv.y));
        w.z = cvtpk(bf_lo(ov.z) * bf_lo(zv.z), bf_hi(ov.z) * bf_hi(zv.z)); w.w = cvtpk(bf_lo(ov.w) * bf_lo(zv.w), bf_hi(ov.w) * bf_hi(zv.w));
        *(u32x4*)(QM + (row0 + row) * 256 + h * 64 + ch * 8) = w;
    }
    __syncthreads();
}

constexpr int IXL_META = 0, IXL_CAND = 2048, IX_CAP = 128, IXL_CANDK = IXL_CAND + 32 * IX_CAP * 4, IXL_HIST = IXL_CAND + 32 * IX_CAP * 6, IXL_STAGE = IXL_HIST + 65536, IXL_END = IXL_STAGE + 2 * 32768;
struct IxMeta { int need[32]; int nr[32]; int done[32]; int ccnt[32]; int lcnt[32]; int B[4][32]; float lo[4][32]; float sc[4][32]; int flag; };
DEVINL int ix_bin(float s, float lo, float sc) { float v = (s - lo) * sc; v = fminf(fmaxf(v, 0.f), 511.f); return (int)v; }
DEVINL int ix_bin0(float s) { return (int)__builtin_amdgcn_fmed3f(__builtin_fmaf(s, 64.f, 256.f), 0.f, 511.f); }
DEVINL float ix_sc(int r) { return r == 0 ? 128.f : (r == 1 ? 65536.f : 33554432.f); }
DEVINL float relu1(float x) { return __builtin_amdgcn_fmed3f(x, 0.f, 3.0e38f); }
DEVINL f32x16 ix_mma(const bf16x8 (&a)[4], const bf16x8 (&b)[4]) {
    f32x16 acc;
#pragma unroll
    for (int r = 0; r < 16; ++r) acc[r] = 0.f;
#pragma unroll
    for (int s = 0; s < 4; ++s) acc = MFMA32(a[s], b[s], acc);
    return acc;
}
DEVINL void ix_reduce(const f32x16& acc, const f32x4 (&cv)[4], float& sA, float& sB) {
    float pj[4];
#pragma unroll
    for (int j = 0; j < 4; ++j) pj[j] = cv[j].x * relu1(acc[4 * j]) + cv[j].y * relu1(acc[4 * j + 1]) + cv[j].z * relu1(acc[4 * j + 2]) + cv[j].w * relu1(acc[4 * j + 3]);
    auto r02 = __builtin_amdgcn_permlane32_swap(__float_as_uint(pj[0]), __float_as_uint(pj[2]), false, false);
    auto r13 = __builtin_amdgcn_permlane32_swap(__float_as_uint(pj[1]), __float_as_uint(pj[3]), false, false);
    sA = __uint_as_float(r02[0]) + __uint_as_float(r02[1]);
    sB = __uint_as_float(r13[0]) + __uint_as_float(r13[1]);
}
template <int MODE, bool CAUSAL>
DEVINL void ix_tile(const f32x16& acc, const f32x4 (&cv)[4], int t0, int kt, int (&B0r)[2], int (&cnt)[2], int (&ccn)[2], IxMeta* meta, char* lds, int round) {
    const int lane = threadIdx.x & 63, wave = threadIdx.x >> 6, r32 = lane & 31, hi = lane >> 5;
    char* histb = lds + IXL_HIST;
    float* cand_s = (float*)(lds + IXL_CAND);
    bf16_t* cand_k = (bf16_t*)(lds + IXL_CANDK);
    const int k = 32 * kt + r32;
    float sc2[2];
    ix_reduce(acc, cv, sc2[0], sc2[1]);
#pragma unroll
    for (int q = 0; q < 2; ++q) {
        const float sv = sc2[q];
        const int row = 4 * wave + 2 * hi + q;
        const bool adm = CAUSAL ? (k <= t0 + row) : true;
        const int b0 = ix_bin0(sv);
        if (MODE == 0) {
            if (adm) atomicAdd((unsigned*)(histb + row * 2048 + b0 * 4), 1u);
        } else if (MODE == 2) {
            if (adm && !meta->done[row]) {
                bool eq = (b0 == meta->B[0][row]);
                for (int j = 1; j < round; ++j) eq = eq && (ix_bin(sv, meta->lo[j][row], meta->sc[j][row]) == meta->B[j][row]);
                if (eq) { const int bb = ix_bin(sv, meta->lo[round][row], meta->sc[round][row]); atomicAdd((unsigned*)(histb + row * 2048 + bb * 4), 1u); }
            }
        } else {
            const int B0 = B0r[q] & 0xffff;
            bool above = adm && b0 > B0, eqv = adm && b0 == B0;
            if (B0r[q] & 0x10000) {
                if (eqv) {
                    const int nr = meta->nr[row]; int cls = 1;
                    for (int j = 1; j < nr && cls == 1; ++j) { const int bj = ix_bin(sv, meta->lo[j][row], meta->sc[j][row]), Bj = meta->B[j][row]; if (bj > Bj) cls = 2; else if (bj < Bj) cls = 0; }
                    above = cls == 2; eqv = cls == 1;
                }
            }
            const unsigned long long bal = __ballot(above);
            const unsigned hm = (unsigned)(bal >> (32 * hi));
            const int pos = cnt[q] + __popc(hm & ((1u << r32) - 1u));
            if (above && pos < 256) *(bf16_t*)(histb + row * 2048 + pos * 2) = (bf16_t)k;
            cnt[q] += __popc(hm);
            const unsigned long long bale = __ballot(eqv);
            if (bale) {
                const unsigned he = (unsigned)(bale >> (32 * hi));
                const int c = ccn[q] + __popc(he & ((1u << r32) - 1u));
                if (eqv && c < IX_CAP) { cand_s[row * IX_CAP + c] = sv; cand_k[row * IX_CAP + c] = (bf16_t)k; }
                ccn[q] += __popc(he);
            }
        }
    }
}
template <int MODE, bool LAST>
DEVINL void ix_chunk(const bf16x8 (&af)[4], const f32x4 (&cv)[4], const char* buf, int t0, int kt0, int ktend, int (&B0r)[2], int (&cnt)[2], int (&ccn)[2], IxMeta* meta, char* lds, int round) {
    const int lane = threadIdx.x & 63, r32 = lane & 31, hi = lane >> 5;
    bf16x8 bfa[4], bfb[4];
#pragma unroll
    for (int s = 0; s < 4; ++s) bfa[s] = *(const bf16x8*)(buf + swz128(r32, 2 * s + hi));
#pragma unroll
    for (int s = 0; s < 4; ++s) bfb[s] = *(const bf16x8*)(buf + swz128(32 + r32, 2 * s + hi));
    f32x16 acc = ix_mma(af, bfa);
#pragma unroll
    for (int t8 = 0; t8 < 8; ++t8) {
        if (!LAST || t8 < ktend) {
            const f32x16 accn = ix_mma(af, bfb);
            if (t8 + 2 < 8) {
#pragma unroll
                for (int s = 0; s < 4; ++s) bfb[s] = *(const bf16x8*)(buf + swz128(32 * (t8 + 2) + r32, 2 * s + hi));
            }
            ix_tile<MODE, LAST>(acc, cv, t0, kt0 + t8, B0r, cnt, ccn, meta, lds, round);
            acc = accn;
        }
    }
}
template <int MODE>
DEVINL void ix_pass(const bf16x8 (&af)[4], const f32x4 (&cv)[4], const bf16_t* IK, int t0, int nkt, int (&B0r)[2], int (&cnt)[2], int (&ccn)[2], IxMeta* meta, char* lds, int round) {
    const int tid = threadIdx.x;
    const int lc = tid & 7, lr = tid >> 3;
    const int nch = (nkt + 7) >> 3;
    u32x4 st[4];
#pragma unroll
    for (int j = 0; j < 4; ++j) st[j] = *(const u32x4*)(IK + (size_t)(lr + 64 * j) * 64 + lc * 8);
#pragma unroll
    for (int j = 0; j < 4; ++j) *(u32x4*)(lds + IXL_STAGE + swz128(lr + 64 * j, lc)) = st[j];
    __syncthreads();
#pragma unroll 1
    for (int ch = 0; ch < nch; ++ch) {
        const char* buf = lds + IXL_STAGE + (ch & 1) * 32768;
        if (ch + 1 < nch) {
#pragma unroll
            for (int j = 0; j < 4; ++j) st[j] = *(const u32x4*)(IK + (size_t)(256 * (ch + 1) + lr + 64 * j) * 64 + lc * 8);
            ix_chunk<MODE, false>(af, cv, buf, t0, 8 * ch, 8, B0r, cnt, ccn, meta, lds, round);
            char* nb = lds + IXL_STAGE + ((ch + 1) & 1) * 32768;
#pragma unroll
            for (int j = 0; j < 4; ++j) *(u32x4*)(nb + swz128(lr + 64 * j, lc)) = st[j];
        } else {
            ix_chunk<MODE, true>(af, cv, buf, t0, 8 * ch, nkt - 8 * ch, B0r, cnt, ccn, meta, lds, round);
        }
        __syncthreads();
    }
}
DEVINL void indexer_item(const Params& p, char* lds, int item) {
    const int tid = threadIdx.x, lane = tid & 63, wave = tid >> 6, r32 = lane & 31, hi = lane >> 5;
    const int b = item >> 8, u = item & 255, qt = (b & 1) ? u : 255 - u, t0 = qt * 32;
    bf16_t* IDX = (bf16_t*)(p.ws + WS_IDX) + ((size_t)b * SEQ + t0) * 256;
    if (t0 < 256) {
#pragma unroll 1
        for (int rr = 0; rr < 4; ++rr) {
            const int row = 4 * wave + rr, n = t0 + row + 1;
#pragma unroll
            for (int k = 0; k < 4; ++k) { const int i = lane + 64 * k; IDX[row * 256 + i] = (bf16_t)(i < n ? i : 0xFFFF); }
        }
        return;
    }
    IxMeta* meta = (IxMeta*)(lds + IXL_META);
    unsigned* hist = (unsigned*)(lds + IXL_HIST);
    __syncthreads();
    if (tid < 32) { meta->need[tid] = 256; meta->nr[tid] = 0; meta->done[tid] = 0; meta->ccnt[tid] = 0; meta->lo[0][tid] = -4.f; meta->sc[0][tid] = 64.f; }
    const bf16_t* IQ = (const bf16_t*)(p.ws + WS_IQ) + ((size_t)b * SEQ + t0) * 512;
    const bf16_t* IK = (const bf16_t*)(p.ws + WS_IK) + (size_t)b * SEQ * 64;
    const float* IW = (const float*)(p.ws + WS_IW) + ((size_t)b * SEQ + t0) * 8;
    bf16x8 af[4]; f32x4 cv[4];
#pragma unroll
    for (int s = 0; s < 4; ++s) af[s] = *(const bf16x8*)(IQ + (size_t)(4 * wave + (r32 >> 3)) * 512 + (r32 & 7) * 64 + 16 * s + 8 * hi);
#pragma unroll
    for (int j = 0; j < 4; ++j) cv[j] = *(const f32x4*)(IW + (size_t)(4 * wave + j) * 8 + 4 * hi);
    int B0r[2] = {0, 0}, cnt[2] = {0, 0}, ccn[2] = {0, 0};
    const int nkt = (t0 + 32) / 32;
#pragma unroll 1
    for (int round = 0; round < 4; ++round) {
#pragma unroll
        for (int k = 0; k < 8; ++k) *(u32x4*)(lds + IXL_HIST + (tid + 512 * k) * 16) = (u32x4){0u, 0u, 0u, 0u};
        if (tid == 0) meta->flag = 0;
        __syncthreads();
        if (round == 0) ix_pass<0>(af, cv, IK, t0, nkt, B0r, cnt, ccn, meta, lds, 0);
        else ix_pass<2>(af, cv, IK, t0, nkt, B0r, cnt, ccn, meta, lds, round);
#pragma unroll 1
        for (int rr = 0; rr < 4; ++rr) {
            const int row = 4 * wave + rr;
            if (meta->done[row]) continue;
            const int need = meta->need[row];
            const u32x4 h0 = *(const u32x4*)(hist + row * 512 + 8 * lane), h1 = *(const u32x4*)(hist + row * 512 + 8 * lane + 4);
            const unsigned c = ((h0[0] + h0[1]) + (h0[2] + h0[3])) + ((h1[0] + h1[1]) + (h1[2] + h1[3]));
            unsigned suf = c;
#pragma unroll
            for (int o = 1; o < 64; o <<= 1) { const unsigned tv = __shfl_down(suf, o); if (lane + o < 64) suf += tv; }
            const unsigned long long bal = __ballot(suf >= (unsigned)need);
            const int Ls = bal ? 63 - __builtin_clzll(bal) : 0;
            const unsigned sufL = __shfl(suf, Ls), cL = __shfl(c, Ls);
            unsigned cum = sufL - cL; int Bs = 8 * Ls; unsigned cb = 0; bool found = false;
#pragma unroll 1
            for (int e = 7; e >= 0; --e) {
                const unsigned hv = hist[row * 512 + 8 * Ls + e];
                if (!found) { if (cum + hv >= (unsigned)need) { Bs = 8 * Ls + e; cb = hv; found = true; } else cum += hv; }
            }
            if (lane == 0) {
                meta->B[round][row] = Bs; meta->need[row] = need - (int)cum; meta->nr[row] = round + 1;
                if (cb > (unsigned)IX_CAP && round < 3) {
                    const float lo = meta->lo[round][row], sc = meta->sc[round][row];
                    if (Bs == 511) { meta->sc[round + 1][row] = sc * 0.0625f; meta->lo[round + 1][row] = lo + 511.f / sc; }
                    else if (Bs == 0) { meta->sc[round + 1][row] = sc * 0.0625f; meta->lo[round + 1][row] = lo + 1.f / sc - 8192.f / sc; }
                    else { meta->sc[round + 1][row] = sc * 512.f; meta->lo[round + 1][row] = lo + (float)Bs / sc; }
                    meta->flag = 1;
                }
                else meta->done[row] = 1;
            }
        }
        __syncthreads();
        const int more = meta->flag;
        __syncthreads();
        if (!more) break;
    }
#pragma unroll
    for (int q = 0; q < 2; ++q) { const int row = 4 * wave + 2 * hi + q; B0r[q] = meta->B[0][row] | (meta->nr[row] > 1 ? 0x10000 : 0); }
    ix_pass<1>(af, cv, IK, t0, nkt, B0r, cnt, ccn, meta, lds, 0);
    if (r32 == 0) {
#pragma unroll
        for (int q = 0; q < 2; ++q) { meta->lcnt[4 * wave + 2 * hi + q] = cnt[q] < 256 ? cnt[q] : 256; meta->ccnt[4 * wave + 2 * hi + q] = ccn[q]; }
    }
    LDS_WAIT();
    {
        const float* cand_s = (const float*)(lds + IXL_CAND);
        const bf16_t* cand_k = (const bf16_t*)(lds + IXL_CANDK);
#pragma unroll 1
        for (int rr = 0; rr < 4; ++rr) {
            const int row = 4 * wave + rr;
            const int c = meta->lcnt[row];
            for (int i = lane; i < c; i += 64) IDX[row * 256 + i] = *(const bf16_t*)(lds + IXL_HIST + row * 2048 + i * 2);
            const int m = meta->ccnt[row] < IX_CAP ? meta->ccnt[row] : IX_CAP, r = meta->need[row], base = 256 - r;
            for (int i = lane; i < m; i += 64) {
                const float si = cand_s[row * IX_CAP + i]; const int ki = cand_k[row * IX_CAP + i];
                int rank = 0;
                for (int j = 0; j < m; ++j) { const float sj = cand_s[row * IX_CAP + j]; const int kj = cand_k[row * IX_CAP + j]; rank += (sj > si || (sj == si && kj < ki)) ? 1 : 0; }
                if (rank < r) IDX[row * 256 + base + rank] = (bf16_t)ki;
            }
        }
    }
    __syncthreads();
}

DEVINL float dot2bf(unsigned a, unsigned b, float c) {
    typedef __bf16 bf2 __attribute__((ext_vector_type(2)));
    return __builtin_amdgcn_fdot2_f32_bf16(__builtin_bit_cast(bf2, a), __builtin_bit_cast(bf2, b), c, false);
}
DEVINL void dsa_item(const Params& p, char* lds, int item) {
    const int tid = threadIdx.x, lane = tid & 63, wave = tid >> 6, g = lane >> 3, j = lane & 7;
    const int pair = (item & 7) + 8 * (item >> 8), chunk = (item >> 3) & 31;
    const int b = pair / HB, h = pair % HB;
    float* lut = (float*)lds;
    float* pbuf = (float*)(lds + 512) + wave * 256;
    __syncthreads();
    build_lut(lut, p.rel_bias, 6 + h);
    __syncthreads();
    bf16_t* QB = (bf16_t*)(p.ws + WS_ACT8 + 4 * ACT_STRIDE);
    const bf16_t* KB = (const bf16_t*)(p.ws + WS_ACT8 + 5 * ACT_STRIDE) + (size_t)b * SEQ * 384 + h * 64 + 8 * j;
    const bf16_t* VB = (const bf16_t*)(p.ws + WS_ACT8 + 6 * ACT_STRIDE) + (size_t)b * SEQ * 384 + h * 64 + 8 * j;
    const bf16_t* ZB = (const bf16_t*)(p.ws + WS_ACT8 + 7 * ACT_STRIDE);
    const bf16_t* IDX = (const bf16_t*)(p.ws + WS_IDX);
    const int dim = 8 * j + g;
    const int t_first = chunk * 256 + wave * 32;
    u32x4 qv_n, iv_n[4]; int myk_n[4]; bf16_t z_n;
    {
        const size_t row = (size_t)b * SEQ + t_first;
        const bf16_t* irow = IDX + row * 256 + g * 32;
        qv_n = *(const u32x4*)(QB + row * 384 + h * 64 + 8 * j);
#pragma unroll
        for (int k = 0; k < 4; ++k) iv_n[k] = *(const u32x4*)(irow + 8 * k);
#pragma unroll
        for (int bt = 0; bt < 4; ++bt) myk_n[bt] = irow[8 * bt + j];
        z_n = ZB[row * 384 + h * 64 + dim];
    }
#pragma unroll 1
    for (int qi = 0; qi < 32; ++qi) {
        const int t = t_first + qi;
        const size_t row = (size_t)b * SEQ + t;
        const u32x4 qv = qv_n; u32x4 iv[4]; int myk[4]; const bf16_t zc = z_n;
#pragma unroll
        for (int k = 0; k < 4; ++k) { iv[k] = iv_n[k]; myk[k] = myk_n[k]; }
        {
            const size_t rown = row + (qi + 1 < 32 ? 1 : 0);
            const bf16_t* irow = IDX + rown * 256 + g * 32;
            qv_n = *(const u32x4*)(QB + rown * 384 + h * 64 + 8 * j);
#pragma unroll
            for (int k = 0; k < 4; ++k) iv_n[k] = *(const u32x4*)(irow + 8 * k);
#pragma unroll
            for (int bt = 0; bt < 4; ++bt) myk_n[bt] = irow[8 * bt + j];
            z_n = ZB[rown * 384 + h * 64 + dim];
        }
        float lg[4];
#pragma unroll
        for (int bt = 0; bt < 4; ++bt) {
            float part[8];
#pragma unroll
            for (int i = 0; i < 8; ++i) {
                const int ii = 8 * bt + i;
                const unsigned w = (ii & 1) ? (iv[ii >> 3][(ii >> 1) & 3] >> 16) : (iv[ii >> 3][(ii >> 1) & 3] & 0xffffu);
                const int key = w == 0xFFFFu ? 0 : (int)w;
                const u32x4 kv = *(const u32x4*)(KB + (size_t)key * 384);
                part[i] = dot2bf(kv.w, qv.w, dot2bf(kv.z, qv.z, dot2bf(kv.y, qv.y, dot2bf(kv.x, qv.x, 0.f))));
            }
            float v4[4];
#pragma unroll
            for (int a = 0; a < 4; ++a) { const float keep = (j & 4) ? part[4 + a] : part[a], send = (j & 4) ? part[a] : part[4 + a]; v4[a] = keep + dppf<0x141>(send); }
            float v2[2];
#pragma unroll
            for (int a = 0; a < 2; ++a) { const float keep = (j & 2) ? v4[2 + a] : v4[a], send = (j & 2) ? v4[a] : v4[2 + a]; v2[a] = keep + dppf<0x4E>(send); }
            { const float keep = (j & 1) ? v2[1] : v2[0], send = (j & 1) ? v2[0] : v2[1]; lg[bt] = keep + dppf<0xB1>(send); }
        }
        float mx = -INFINITY;
#pragma unroll
        for (int bt = 0; bt < 4; ++bt) {
            const int d = t - myk[bt];
            lg[bt] = (myk[bt] == 0xFFFF || d < 0) ? -INFINITY : lg[bt] + lut[d > 127 ? 127 : d];
            mx = fmaxf(mx, lg[bt]);
        }
        mx = wave_max_dpp(mx);
        float ls = 0.f;
#pragma unroll
        for (int bt = 0; bt < 4; ++bt) { lg[bt] = fexp2(lg[bt] - mx); ls += lg[bt]; pbuf[g * 32 + 8 * bt + j] = lg[bt]; }
        ls = wave_sum_dpp(ls);
        LDS_WAIT();
        float acc[8];
#pragma unroll
        for (int e = 0; e < 8; ++e) acc[e] = 0.f;
#pragma unroll
        for (int k = 0; k < 4; ++k) {
            const f32x4 pa = *(const f32x4*)(pbuf + g * 32 + 8 * k), pb = *(const f32x4*)(pbuf + g * 32 + 8 * k + 4);
            const float pp[8] = {pa.x, pa.y, pa.z, pa.w, pb.x, pb.y, pb.z, pb.w};
#pragma unroll
            for (int i2 = 0; i2 < 4; ++i2) {
                const unsigned wpair = iv[k][i2];
                const unsigned w0 = wpair & 0xffffu, w1 = wpair >> 16;
                const int key0 = w0 == 0xFFFFu ? 0 : (int)w0, key1 = w1 == 0xFFFFu ? 0 : (int)w1;
                const u32x4 va = *(const u32x4*)(VB + (size_t)key0 * 384), vb = *(const u32x4*)(VB + (size_t)key1 * 384);
                const unsigned ppk = cvtpk(pp[2 * i2], pp[2 * i2 + 1]);
#pragma unroll
                for (int w = 0; w < 4; ++w) {
                    const unsigned lo = __builtin_amdgcn_perm(vb[w], va[w], 0x05040100u), hh = __builtin_amdgcn_perm(vb[w], va[w], 0x07060302u);
                    acc[2 * w] = dot2bf(lo, ppk, acc[2 * w]); acc[2 * w + 1] = dot2bf(hh, ppk, acc[2 * w + 1]);
                }
            }
        }
        LDS_WAIT();
        float a4[4];
#pragma unroll
        for (int a = 0; a < 4; ++a) { const float keep = (g & 4) ? acc[4 + a] : acc[a], send = (g & 4) ? acc[a] : acc[4 + a]; a4[a] = keep + xor32f(send); }
        float a2[2];
#pragma unroll
        for (int a = 0; a < 2; ++a) { const float keep = (g & 2) ? a4[2 + a] : a4[a], send = (g & 2) ? a4[a] : a4[2 + a]; a2[a] = keep + __shfl_xor(send, 16); }
        float a1;
        { const float keep = (g & 1) ? a2[1] : a2[0], send = (g & 1) ? a2[0] : a2[1]; a1 = keep + dppf<0x128>(send); }
        QB[row * 384 + h * 64 + dim] = (bf16_t)(cvtpk(a1 * frcp(ls) * bf2f(zc), 0.f) & 0xffffu);
    }
}

struct KvRegs { u32x4 kk[4], vv[4]; };
DEVINL void kv_issue(KvRegs& r, const bf16_t* __restrict__ Kg, const bf16_t* __restrict__ Vg, int ld) {
    const int tid = threadIdx.x, c = tid & 7, kr = tid >> 3;
#pragma unroll
    for (int j = 0; j < 4; ++j) { r.kk[j] = *(const u32x4*)(Kg + (size_t)(kr + 64 * j) * ld + c * 8); r.vv[j] = *(const u32x4*)(Vg + (size_t)(kr + 64 * j) * ld + c * 8); }
}
DEVINL void kv_commit(const KvRegs& r, char* lds) {
    const int tid = threadIdx.x, c = tid & 7, kr = tid >> 3;
#pragma unroll
    for (int j = 0; j < 4; ++j) {
        const int key = kr + 64 * j;
        *(u32x4*)(lds + AT_K + swz128(key, c)) = r.kk[j];
        *(u32x4*)(lds + AT_V + (c >> 2) * AT_VPLANE + key * 64 + (c & 3) * 16) = r.vv[j];
    }
}
constexpr int MB_LUT = AT_END, MB_WSF = AT_END + 3072, MB_ENT = MB_WSF + 1024, MB_OSTG = MB_ENT + 512, MB_PRE = MB_OSTG + 8 * 4096, MB_END = MB_PRE + 3072;
struct MobaItem { int b, h, n, c, cnt; };
DEVINL bool moba_decode(const unsigned* pre, const unsigned* ctl, int ri, int total, MobaItem& it) {
    if (ri >= total) return false;
    int lo = 0, hi2 = 744;
    while (hi2 - lo > 1) { const int mid = (lo + hi2) >> 1; if ((int)pre[mid] <= ri) lo = mid; else hi2 = mid; }
    const int bh = lo / 31; it.b = bh / HA; it.h = bh % HA; it.n = lo % 31; it.c = ri - (int)pre[lo]; it.cnt = (int)ctl[bh * 32 + it.n];
    return true;
}
DEVINL void moba_past_compute(const Params& p, char* lds, const MobaItem& it) {
    const int tid = threadIdx.x, lane = tid & 63, wave = tid >> 6, r32 = lane & 31, hi = lane >> 5;
    const float* lut = (const float*)(lds + MB_LUT) + it.h * 128;
    float* wsf = (float*)(lds + MB_WSF) + wave * 32;
    const bf16_t* ent = (const bf16_t*)(lds + MB_ENT);
    char* ostg = lds + MB_OSTG + wave * 4096;
    const int b = it.b, h = it.h, n = it.n;
    const int nvalid = it.cnt - it.c * 256 < 256 ? it.cnt - it.c * 256 : 256;
    if (wave * 32 < nvalid) {
        const int e = ent[wave * 32 + r32], t_row = e & 8191;
        const bf16_t* QA = (const bf16_t*)(p.ws + WS_ACT8);
        bf16x8 qf[4];
#pragma unroll
        for (int s = 0; s < 4; ++s) qf[s] = *(const bf16x8*)(QA + ((size_t)b * SEQ + t_row) * 384 + h * 64 + 16 * s + 8 * hi);
        AttnState st;
        attn_256<1>(qf, lds, t_row, n * 256, lut, wsf, st);
        const float ltot = half_sum(st.l);
        float rl[16]; rows_to_regs(frcp(ltot), wsf, rl);
#pragma unroll
        for (int r = 0; r < 16; ++r) {
            *(bf16_t*)(ostg + crow(r, hi) * 128 + r32 * 2) = (bf16_t)(cvtpk(st.o0[r] * rl[r], 0.f) & 0xffffu);
            *(bf16_t*)(ostg + crow(r, hi) * 128 + (32 + r32) * 2) = (bf16_t)(cvtpk(st.o1[r] * rl[r], 0.f) & 0xffffu);
        }
        LDS_WAIT();
        bf16_t* PO = (bf16_t*)((char*)p.out + OUT_PO);
        float* PL = (float*)((char*)p.out + OUT_PL);
        if (hi == 0 && wave * 32 + r32 < nvalid) PL[(((size_t)b * SEQ + t_row) * HA + h) * 4 + (e >> 13)] = st.mhat + __builtin_amdgcn_logf(ltot);
#pragma unroll
        for (int i = 0; i < 4; ++i) {
            const int row = i * 8 + (lane >> 3), ch = lane & 7;
            if (wave * 32 + row < nvalid) {
                const int e2 = ent[wave * 32 + row];
                *(u32x4*)(PO + ((((size_t)b * SEQ + (e2 & 8191)) * HA + h) * 4 + (e2 >> 13)) * 64 + ch * 8) = *(const u32x4*)(ostg + row * 128 + ch * 16);
            }
        }
    }
}
DEVINL void moba_issue(const Params& p, const MobaItem& it, KvRegs& kv, int& entv) {
    const int tid = threadIdx.x;
    const size_t r0 = ((size_t)it.b * SEQ + it.n * 256) * 384 + it.h * 64;
    kv_issue(kv, (const bf16_t*)(p.ws + WS_ACT8 + 1 * ACT_STRIDE) + r0, (const bf16_t*)(p.ws + WS_ACT8 + 2 * ACT_STRIDE) + r0, 384);
    const bf16_t* L = (const bf16_t*)(p.ws + WS_LIST) + (size_t)(it.b * HA + it.h) * LIST_PER_BH + list_off(it.n) + it.c * 256;
    const int nvalid = it.cnt - it.c * 256 < 256 ? it.cnt - it.c * 256 : 256;
    entv = tid < 256 ? (int)L[tid < nvalid ? tid : 0] : 0;
}
DEVINL void phase3(const Params& p, char* lds) {
    for (int it = blockIdx.x; it < 768; it += gridDim.x) dsa_item(p, lds, it);
    const unsigned* ctl = (const unsigned*)(p.ws + WS_CTL);
    unsigned* pre = (unsigned*)(lds + MB_PRE);
    __syncthreads();
    for (int i = threadIdx.x; i < 744; i += NTHR) pre[i + 1] = (ctl[(i / 31) * 32 + (i % 31)] + 255u) >> 8;
    for (int i = threadIdx.x; i < HA * 128; i += NTHR) ((float*)(lds + MB_LUT))[i] = p.rel_bias[rel_bucket(i & 127) * 12 + (i >> 7)] * LOG2E;
    __syncthreads();
    if (threadIdx.x == 0) { unsigned a = 0; pre[0] = 0; for (int i = 1; i <= 744; ++i) { a += pre[i]; pre[i] = a; } }
    __syncthreads();
    const int total = (int)pre[744];
    bf16_t* ent = (bf16_t*)(lds + MB_ENT);
    MobaItem cur, nxt; KvRegs kv; int entv = 0;
    bool have = moba_decode(pre, ctl, blockIdx.x, total, cur);
    if (have) { moba_issue(p, cur, kv, entv); kv_commit(kv, lds); if (threadIdx.x < 256) ent[threadIdx.x] = (bf16_t)entv; }
    __syncthreads();
    for (int ri = blockIdx.x; have; ri += gridDim.x) {
        const bool hn = moba_decode(pre, ctl, ri + gridDim.x, total, nxt);
        if (hn) moba_issue(p, nxt, kv, entv);
        moba_past_compute(p, lds, cur);
        __syncthreads();
        if (hn) { kv_commit(kv, lds); if (threadIdx.x < 256) ent[threadIdx.x] = (bf16_t)entv; }
        __syncthreads();
        cur = nxt; have = hn;
    }
}
DEVINL void moba_own_item(const Params& p, char* lds, int item) {
    const int tid = threadIdx.x, lane = tid & 63, wave = tid >> 6, r32 = lane & 31, hi = lane >> 5;
    const int b = item / (HA * 32), h = (item / 32) % HA, n = item % 32;
    float* lut = (float*)(lds + AT_END);
    float* wsf = (float*)(lds + AT_END + 512) + wave * 32;
    float* lse_own = (float*)(lds + AT_END + 1536);
    float* oown = (float*)lds;
    __syncthreads();
    build_lut(lut, p.rel_bias, h);
    const size_t row0 = (size_t)b * SEQ + n * 256;
    load_kv_block((const bf16_t*)(p.ws + WS_ACT8 + 1 * ACT_STRIDE) + row0 * 384 + h * 64, (const bf16_t*)(p.ws + WS_ACT8 + 2 * ACT_STRIDE) + row0 * 384 + h * 64, 384, lds);
    bf16_t* QA = (bf16_t*)(p.ws + WS_ACT8);
    const int t_row = n * 256 + wave * 32 + r32;
    bf16x8 qf[4];
#pragma unroll
    for (int s = 0; s < 4; ++s) qf[s] = *(const bf16x8*)(QA + ((size_t)b * SEQ + t_row) * 384 + h * 64 + 16 * s + 8 * hi);
    __syncthreads();
    AttnState st;
    attn_256<1>(qf, lds, t_row, n * 256, lut, wsf, st);
    const float ltot = half_sum(st.l);
    float rl[16]; rows_to_regs(frcp(ltot), wsf, rl);
    __syncthreads();
    if (hi == 0) lse_own[wave * 32 + r32] = st.mhat + __builtin_amdgcn_logf(ltot);
#pragma unroll
    for (int r = 0; r < 16; ++r) {
        oown[(wave * 32 + crow(r, hi)) * 64 + r32] = st.o0[r] * rl[r];
        oown[(wave * 32 + crow(r, hi)) * 64 + 32 + r32] = st.o1[r] * rl[r];
    }
    __syncthreads();
    const bf16_t* PO = (const bf16_t*)((const char*)p.out + OUT_PO);
    const float* PL = (const float*)((const char*)p.out + OUT_PL);
    const bf16_t* ZA = (const bf16_t*)(p.ws + WS_ACT8 + 3 * ACT_STRIDE);
    const int nsel = n < 3 ? n : 3;
#pragma unroll 1
    for (int k = 0; k < 4; ++k) {
        const int task = tid + 512 * k, row = task >> 3, ch = task & 7;
        const size_t grow = row0 + row;
        const float lo = lse_own[row];
        float ls[3]; float M = lo;
#pragma unroll
        for (int s = 0; s < 3; ++s) { ls[s] = (s < nsel) ? PL[(grow * HA + h) * 4 + s] : -INFINITY; M = fmaxf(M, ls[s]); }
        const float w_own = fexp2(lo - M);
        float wsum = w_own, o[8];
#pragma unroll
        for (int e = 0; e < 8; ++e) o[e] = w_own * oown[row * 64 + ch * 8 + e];
#pragma unroll
        for (int s = 0; s < 3; ++s) {
            if (s < nsel) {
                const float w = fexp2(ls[s] - M); wsum += w;
                const u32x4 pv = *(const u32x4*)(PO + ((grow * HA + h) * 4 + s) * 64 + ch * 8);
                o[0] += w * bf_lo(pv.x); o[1] += w * bf_hi(pv.x); o[2] += w * bf_lo(pv.y); o[3] += w * bf_hi(pv.y);
                o[4] += w * bf_lo(pv.z); o[5] += w * bf_hi(pv.z); o[6] += w * bf_lo(pv.w); o[7] += w * bf_hi(pv.w);
            }
        }
        const float inv = frcp(wsum);
        const u32x4 zv = *(const u32x4*)(ZA + grow * 384 + h * 64 + ch * 8);
        u32x4 w;
        w.x = cvtpk(o[0] * inv * bf_lo(zv.x), o[1] * inv * bf_hi(zv.x)); w.y = cvtpk(o[2] * inv * bf_lo(zv.y), o[3] * inv * bf_hi(zv.y));
        w.z = cvtpk(o[4] * inv * bf_lo(zv.z), o[5] * inv * bf_hi(zv.z)); w.w = cvtpk(o[6] * inv * bf_lo(zv.w), o[7] * inv * bf_hi(zv.w));
        *(u32x4*)(QA + grow * 384 + h * 64 + ch * 8) = w;
    }
    __syncthreads();
}

DEVINL void phase2(const Params& p, char* lds) {
    for (int it = blockIdx.x; it < NB * 256; it += gridDim.x) indexer_item(p, lds, it);
    __syncthreads();
    for (int it = blockIdx.x; it < NB * HA * 16; it += gridDim.x) moba_select_item(p, lds, it);
    for (int it = blockIdx.x; it < NB * HM * 32; it += gridDim.x) mem_attn_item(p, lds, it);
}
DEVINL void phase4(const Params& p, char* lds) {
    for (int it = blockIdx.x; it < NB * HA * 32; it += gridDim.x) moba_own_item(p, lds, it);
}


#define XB_TMO      128
#define XB_XCNT(j)  (256  + 64 * (j))
#define XB_XSUB(j)  (1280 + 64 * (j))
#define XB_XGEN(j)  (2304 + 64 * (j))
#define XB_TOP      3328
#define XB_TOPGEN   3392
#define XB_SPIN_CAP (1u << 22)
DEVINL unsigned xb_ld(unsigned* p)              { return __hip_atomic_load(p, __ATOMIC_RELAXED, __HIP_MEMORY_SCOPE_AGENT); }
DEVINL unsigned xb_add(unsigned* p, unsigned v) { return __hip_atomic_fetch_add(p, v, __ATOMIC_RELAXED, __HIP_MEMORY_SCOPE_AGENT); }
DEVINL unsigned xb_xcc_id() { return (unsigned)__builtin_amdgcn_s_getreg((3 << 11) | 20) & 0xFu; }
#define XB_SPIN(cond, bar) do { unsigned _sp = 0; while (cond) { __builtin_amdgcn_s_sleep(1); \
    if ((++_sp & 255u) == 0u) { if (xb_ld(&(bar)[XB_TMO])) break; if (_sp > XB_SPIN_CAP) { atomicAdd(&(bar)[XB_TMO], 1u); break; } } } } while (0)
struct XcdBarrier { unsigned* bar; unsigned x; volatile LAS unsigned* st; };
DEVINL XcdBarrier xcd_barrier_post(unsigned* bar, volatile LAS unsigned* st) {
    XcdBarrier b; b.bar = bar; b.x = xb_xcc_id(); b.st = st;
    if (threadIdx.x == 0) (void)xb_add(&bar[XB_XCNT(b.x)], 1u);
    return b;
}
DEVINL void xcd_barrier_complete(unsigned* bar, unsigned x, unsigned& nloc, unsigned& nx) {
    const unsigned G = gridDim.x * gridDim.y * gridDim.z;
    unsigned sum, cnt, mine, sp = 0u;
    for (;;) {
        sum = 0u; cnt = 0u; mine = 0u;
#pragma unroll
        for (unsigned j = 0; j < 16; ++j) { const unsigned c = xb_ld(&bar[XB_XCNT(j)]); sum += c; cnt += (c > 0u) ? 1u : 0u; mine = (j == x) ? c : mine; }
        if (sum == G) break;
        __builtin_amdgcn_s_sleep(1);
        if ((++sp & 255u) == 0u) { if (xb_ld(&bar[XB_TMO])) break; if (sp > XB_SPIN_CAP) { atomicAdd(&bar[XB_TMO], 1u); break; } }
    }
    nloc = mine > 0u ? mine : 1u; nx = cnt > 0u ? cnt : 1u;
}
DEVINL void xcd_barrier(const XcdBarrier& b) {
    asm volatile("s_waitcnt vmcnt(0)" ::: "memory");
    __syncthreads();
    if (threadIdx.x == 0) {
        unsigned* bar = b.bar;
        __builtin_amdgcn_s_waitcnt(0);
        unsigned nloc = b.st[0], nx = b.st[1];
        if (nloc == 0u) { xcd_barrier_complete(bar, b.x, nloc, nx); b.st[0] = nloc; b.st[1] = nx; }
        const unsigned old = xb_add(&bar[XB_XSUB(b.x)], 1u);
        const unsigned gen = old / nloc;
        if (old + 1u == (gen + 1u) * nloc) {
            __builtin_amdgcn_fence(__ATOMIC_RELEASE, "agent");
            asm volatile("s_waitcnt vmcnt(0)" ::: "memory");
            const unsigned og = xb_add(&bar[XB_TOP], 1u);
            const unsigned tg = og / nx;
            if (og + 1u == (tg + 1u) * nx) xb_add(&bar[XB_TOPGEN], 1u);
            else XB_SPIN(xb_ld(&bar[XB_TOPGEN]) == tg, bar);
            __builtin_amdgcn_fence(__ATOMIC_ACQUIRE, "agent");
            xb_add(&bar[XB_XGEN(b.x)], 1u);
            asm volatile("s_waitcnt vmcnt(0)" ::: "memory");
        } else {
            XB_SPIN(xb_ld(&bar[XB_XGEN(b.x)]) == gen, bar);
            __builtin_amdgcn_fence(__ATOMIC_ACQUIRE, "agent");
            asm volatile("s_waitcnt vmcnt(0)" ::: "memory");
        }
    }
    __syncthreads();
}

constexpr int LDS_BYTES = IXL_END + 64, LDS_XB = IXL_END;
#define KERNEL_PROLOGUE __shared__ __attribute__((aligned(16))) char lds[LDS_BYTES];
#ifdef MULTI_LAUNCH
__global__ void __launch_bounds__(NTHR) k_phase0(Params p) { KERNEL_PROLOGUE phase0(p, lds); }
__global__ void __launch_bounds__(NTHR) k_phase1(Params p) { KERNEL_PROLOGUE phase1(p, lds); }
__global__ void __launch_bounds__(NTHR) k_phase2(Params p) { KERNEL_PROLOGUE phase2(p, lds); }
__global__ void __launch_bounds__(NTHR) k_phase3(Params p) { KERNEL_PROLOGUE phase3(p, lds); }
__global__ void __launch_bounds__(NTHR) k_phase4(Params p) { KERNEL_PROLOGUE phase4(p, lds); }
__global__ void __launch_bounds__(NTHR) k_phase5(Params p) { KERNEL_PROLOGUE phase_gates(p, lds); }
__global__ void __launch_bounds__(NTHR) k_phase6(Params p) { KERNEL_PROLOGUE phase_merge(p, lds); }
__global__ void __launch_bounds__(NTHR) k_phase7(Params p) { KERNEL_PROLOGUE phase_out(p, lds); }
__global__ void __launch_bounds__(NTHR) k_phase8(Params p) { phase_final(p); }
#else
__global__ void __launch_bounds__(NTHR) k_mega(Params p) {
    KERNEL_PROLOGUE
    cg::grid_group grid = cg::this_grid();
#ifdef PROBE_A
    int nst = 0;
#define STAMP() do { if (blockIdx.x == 0 && threadIdx.x == 0) ((unsigned*)(p.ws + WS_CTL))[4096 + nst] = (unsigned)__builtin_amdgcn_s_memrealtime(); ++nst; } while (0)
#else
#define STAMP() do { } while (0)
#endif
    volatile LAS unsigned* xst = (volatile LAS unsigned*)(LAS char*)(uintptr_t)(unsigned)(uintptr_t)(lds + LDS_XB);
    if (threadIdx.x == 0) { xst[0] = 0u; xst[1] = 0u; }
    __syncthreads();
    phase0(p, lds);      grid.sync();
    const XcdBarrier bar = xcd_barrier_post((unsigned*)(p.ws + WS_CTL) + CTL_XBAR, xst);
    phase1(p, lds);      xcd_barrier(bar);
    phase2(p, lds);      xcd_barrier(bar);
    phase3(p, lds);      xcd_barrier(bar);
    phase4(p, lds);      xcd_barrier(bar);
    phase_merge(p, lds); xcd_barrier(bar);
    phase_out(p, lds);   xcd_barrier(bar);
    phase_final(p);
}
#endif

extern "C" void kernel_launch(void* const* d_in, const int* in_sizes, int n_in, void* d_out, int out_size, void* d_ws, size_t ws_size, hipStream_t stream) {
    Params p{};
    p.x = (const float*)d_in[0]; p.mem = (const float*)d_in[1]; p.norm_gain = (const float*)d_in[2]; p.w_in = (const float*)d_in[3];
    p.rel_bias = (const float*)d_in[4]; p.mem_gain = (const float*)d_in[5]; p.w_mem_kv = (const float*)d_in[6]; p.w_branch = (const float*)d_in[7];
    p.w_out = (const float*)d_in[8]; p.final_gain = (const float*)d_in[9];
    p.out = (float*)d_out; p.ws = (unsigned char*)d_ws;
#ifdef MULTI_LAUNCH
    const int G = 256;
    hipLaunchKernelGGL(k_phase0, dim3(G), dim3(NTHR), 0, stream, p);
    hipLaunchKernelGGL(k_phase1, dim3(G), dim3(NTHR), 0, stream, p);
    hipLaunchKernelGGL(k_phase2, dim3(G), dim3(NTHR), 0, stream, p);
    hipLaunchKernelGGL(k_phase3, dim3(G), dim3(NTHR), 0, stream, p);
    hipLaunchKernelGGL(k_phase4, dim3(G), dim3(NTHR), 0, stream, p);
    hipLaunchKernelGGL(k_phase5, dim3(G), dim3(NTHR), 0, stream, p);
    hipLaunchKernelGGL(k_phase6, dim3(G), dim3(NTHR), 0, stream, p);
    hipLaunchKernelGGL(k_phase7, dim3(G), dim3(NTHR), 0, stream, p);
    hipLaunchKernelGGL(k_phase8, dim3(G), dim3(NTHR), 0, stream, p);
#else
    static int grid = 0;
    if (!grid) {
        int dev = 0, cus = 0, per_cu = 0;
        (void)hipGetDevice(&dev);
        (void)hipDeviceGetAttribute(&cus, hipDeviceAttributeMultiprocessorCount, dev);
        (void)hipOccupancyMaxActiveBlocksPerMultiprocessor(&per_cu, (const void*)k_mega, NTHR, 0);
        if (per_cu < 1) { fprintf(stderr, "kernel_launch: occupancy query says %d blocks/CU\n", per_cu); per_cu = 1; }
        grid = cus;
        if (ws_size < WS_END) fprintf(stderr, "kernel_launch: workspace too small: %zu < %zu\n", ws_size, (size_t)WS_END);
    }
    void* args[] = {&p};
    hipError_t e = hipLaunchCooperativeKernel((const void*)k_mega, dim3(grid), dim3(NTHR), args, 0, stream);
    if (e != hipSuccess) fprintf(stderr, "kernel_launch: cooperative launch failed: %s (grid %d)\n", hipGetErrorString(e), grid);
#endif
}
```

```cpp
#include <hip/hip_runtime.h>
#include <hip/hip_cooperative_groups.h>
#include <stdint.h>
#include <stdio.h>
namespace cg = cooperative_groups;

#define DEVINL __device__ __forceinline__
#define LAS __attribute__((address_space(3)))

typedef unsigned short bf16_t;
typedef short bf16x8 __attribute__((ext_vector_type(8)));
typedef short s16x4 __attribute__((ext_vector_type(4)));
typedef float f32x16 __attribute__((ext_vector_type(16)));
typedef float f32x4 __attribute__((ext_vector_type(4)));
typedef unsigned u32x4 __attribute__((ext_vector_type(4)));
typedef unsigned u32x2 __attribute__((ext_vector_type(2)));

constexpr int NB = 4, SEQ = 8192, DM = 1024, NT = NB * SEQ;
constexpr int HD = 64, HA = 6, HB = 6, HM = 4, WA = 384, WB = 384, WM = 256;
constexpr int NMEM = 256, INW = 7240;
constexpr int NWIN = 7424;
constexpr int NG1 = 33;
constexpr int GATE0 = 4224;
constexpr float EPS = 1e-6f;
constexpr float LOG2E = 1.4426950408889634f;
constexpr float QSCALE = 0.125f * LOG2E;
constexpr float CSCALE = 0.35355339059327373f * 0.125f;
constexpr int NTHR = 512;

constexpr size_t MiB = 1u << 20;
constexpr size_t WS_CTL = 0, WS_WIN = 1 * MiB, WS_WBR = 16 * MiB, WS_WOUT = 18 * MiB, WS_WMEM = 20 * MiB, WS_MEMN = 21 * MiB,
                 WS_MK = 23 * MiB, WS_MV = 23 * MiB + 512 * 1024, WS_KMEAN = 24 * MiB, WS_IW = 25 * MiB, WS_IK = 26 * MiB,
                 WS_LIST = 30 * MiB, WS_IDX = 36 * MiB, WS_IQ = 52 * MiB, WS_QM = 84 * MiB, WS_ZM = 100 * MiB, WS_ACT8 = 116 * MiB,
                 WS_GATES = 308 * MiB, WS_SSQ = 500 * MiB, WS_END = 502 * MiB;
constexpr size_t ACT_STRIDE = (size_t)NT * 384 * 2;
constexpr size_t WS_MERGED = WS_ACT8 + ACT_STRIDE;
constexpr size_t OUT_PO = 0, OUT_PL = 96 * MiB;
constexpr int CTL_WORDS = 2048, CTL_QUEUE = 1024, CTL_XBAR = 8192, XCD_BAR_WORDS = 3456;
constexpr int LIST_PER_BH = 126976;

struct Params {
    const float *x, *mem, *norm_gain, *w_in, *rel_bias, *mem_gain, *w_mem_kv, *w_branch, *w_out, *final_gain;
    float* out; unsigned char* ws;
};

typedef __bf16 bf16x2_t __attribute__((ext_vector_type(2)));
DEVINL unsigned cvtpk(float lo, float hi) { bf16x2_t v; v.x = (__bf16)lo; v.y = (__bf16)hi; return __builtin_bit_cast(unsigned, v); }
DEVINL float bf_lo(unsigned u) { return __uint_as_float(u << 16); }
DEVINL float bf_hi(unsigned u) { return __uint_as_float(u & 0xffff0000u); }
DEVINL float bf2f(bf16_t b) { return __uint_as_float(((unsigned)b) << 16); }
DEVINL float wave_sum(float v) {
#pragma unroll
    for (int o = 1; o < 64; o <<= 1) v += __shfl_xor(v, o);
    return v;
}
DEVINL float wave_max(float v) {
#pragma unroll
    for (int o = 1; o < 64; o <<= 1) v = fmaxf(v, __shfl_xor(v, o));
    return v;
}
template <int CTRL> DEVINL float dppf(float x) { return __uint_as_float((unsigned)__builtin_amdgcn_update_dpp(0, (int)__float_as_uint(x), CTRL, 0xF, 0xF, true)); }
DEVINL float xor32f(float x) { auto rr = __builtin_amdgcn_permlane32_swap(__float_as_uint(x), __float_as_uint(x), false, false); return __uint_as_float((threadIdx.x & 32) ? rr[0] : rr[1]); }
DEVINL float wave_sum_dpp(float v) {
    v += dppf<0xB1>(v); v += dppf<0x4E>(v); v += dppf<0x141>(v); v += dppf<0x128>(v); v += __shfl_xor(v, 16);
    auto rr = __builtin_amdgcn_permlane32_swap(__float_as_uint(v), __float_as_uint(v), false, false); return __uint_as_float(rr[0]) + __uint_as_float(rr[1]);
}
DEVINL float wave_max_dpp(float v) {
    v = fmaxf(v, dppf<0xB1>(v)); v = fmaxf(v, dppf<0x4E>(v)); v = fmaxf(v, dppf<0x141>(v)); v = fmaxf(v, dppf<0x128>(v)); v = fmaxf(v, __shfl_xor(v, 16));
    auto rr = __builtin_amdgcn_permlane32_swap(__float_as_uint(v), __float_as_uint(v), false, false); return fmaxf(__uint_as_float(rr[0]), __uint_as_float(rr[1]));
}
DEVINL float fexp2(float x) { return __builtin_amdgcn_exp2f(x); }
DEVINL float frcp(float x) { return __builtin_amdgcn_rcpf(x); }
DEVINL float fsigm(float z) { return frcp(1.f + fexp2(-z * LOG2E)); }
DEVINL float fsilu(float z) { return z * fsigm(z); }
#define LDS_WAIT() asm volatile("s_waitcnt lgkmcnt(0)" ::: "memory")
#define MFMA32(a, b, c) __builtin_amdgcn_mfma_f32_32x32x16_bf16(a, b, c, 0, 0, 0)
DEVINL int crow(int r, int hi) { return (r & 3) + 8 * (r >> 2) + 4 * hi; }
DEVINL int rel_bucket(int d) {
    if (d < 16) return d;
    return 16 + (d >= 19) + (d >= 21) + (d >= 24) + (d >= 27) + (d >= 31) + (d >= 35) + (d >= 40) + (d >= 46) + (d >= 52) + (d >= 59) +
           (d >= 67) + (d >= 77) + (d >= 87) + (d >= 99) + (d >= 113);
}
DEVINL int list_off(int n) { return 8192 * n - 128 * n * (n + 1); }

DEVINL int win_srccol(int n) {
    if (n < 3584) return n;
    if (n < 3840) return n - 3584 + 3656;
    if (n < 4096) return n - 3840 + 3912;
    if (n < 4160) return n - 4096 + 3584;
    if (n < 4168) return n - 4160 + 3648;
    if (n < GATE0) return -1;
    if (n >= GATE0 + 3072) return -1;
    return n - GATE0 + 4168;
}
template <int KIND>
DEVINL void p0_transpose_item(const float* __restrict__ W, int ldw, const float* __restrict__ gain, bf16_t* WT, int K, int item, int nblk, float* scr, int lane) {
    const int kb = item / nblk, nb = item % nblk, k0 = kb * 64, n0 = nb * 32;
    const int n = n0 + (lane & 31);
    const int sc = (KIND == 0) ? win_srccol(n) : n;
#pragma unroll 8
    for (int i = 0; i < 32; ++i) {
        const int kk = 2 * i + (lane >> 5);
        float v = 0.f;
        if (sc >= 0) v = W[(size_t)(k0 + kk) * ldw + sc];
        if (gain) v *= gain[k0 + kk];
        scr[kk * 33 + (lane & 31)] = v;
    }
    LDS_WAIT();
    const int c = lane & 7;
#pragma unroll
    for (int j = 0; j < 4; ++j) {
        const int nn = (lane >> 3) + 8 * j;
        const float* s = scr + (8 * c) * 33 + nn;
        u32x4 o;
        o.x = cvtpk(s[0 * 33], s[1 * 33]); o.y = cvtpk(s[2 * 33], s[3 * 33]); o.z = cvtpk(s[4 * 33], s[5 * 33]); o.w = cvtpk(s[6 * 33], s[7 * 33]);
        *(u32x4*)(WT + (size_t)(n0 + nn) * K + k0 + 8 * c) = o;
    }
    LDS_WAIT();
}
DEVINL void norm_row_bf16(const float* xrow, bf16_t* orow, int lane) {
    const f32x4* xr = (const f32x4*)xrow + lane;
    f32x4 v[4]; float s = 0.f;
#pragma unroll
    for (int j = 0; j < 4; ++j) { v[j] = xr[64 * j]; s += (v[j].x * v[j].x + v[j].y * v[j].y) + (v[j].z * v[j].z + v[j].w * v[j].w); }
    const float rstd = rsqrtf(wave_sum(s) * (1.f / DM) + EPS);
    u32x2* o8 = (u32x2*)orow + lane;
#pragma unroll
    for (int j = 0; j < 4; ++j) { u32x2 w; w.x = cvtpk(v[j].x * rstd, v[j].y * rstd); w.y = cvtpk(v[j].z * rstd, v[j].w * rstd); o8[64 * j] = w; }
}
DEVINL void phase0(const Params& p, char* lds) {
    const int tid = threadIdx.x, lane = tid & 63, wave = tid >> 6;
    const int gw = blockIdx.x * 8 + wave, NGW = gridDim.x * 8;
    unsigned* ctl = (unsigned*)(p.ws + WS_CTL);
    for (int i = blockIdx.x * NTHR + tid; i < CTL_WORDS + XCD_BAR_WORDS; i += gridDim.x * NTHR) ctl[i < CTL_WORDS ? i : CTL_XBAR + (i - CTL_WORDS)] = 0u;
    bf16_t* XN = (bf16_t*)p.out;
    bf16_t* MEMN = (bf16_t*)(p.ws + WS_MEMN);
    for (int r = gw; r < NT + NB * NMEM; r += NGW) {
        if (r < NT) norm_row_bf16(p.x + (size_t)r * DM, XN + (size_t)r * DM, lane);
        else norm_row_bf16(p.mem + (size_t)(r - NT) * DM, MEMN + (size_t)(r - NT) * DM, lane);
    }
    float* scr = (float*)(lds + wave * 8448);
    constexpr int I_WIN = 16 * (NWIN / 32), I_BR = 16 * 32, I_OUT = 16 * 32, I_MEM = 16 * 16;
    for (int it = gw; it < I_WIN + I_BR + I_OUT + I_MEM; it += NGW) {
        int r = it;
        if (r < I_WIN) { p0_transpose_item<0>(p.w_in, INW, p.norm_gain, (bf16_t*)(p.ws + WS_WIN), DM, r, NWIN / 32, scr, lane); continue; } r -= I_WIN;
        if (r < I_BR) { p0_transpose_item<1>(p.w_branch, DM, nullptr, (bf16_t*)(p.ws + WS_WBR), DM, r, 32, scr, lane); continue; } r -= I_BR;
        if (r < I_OUT) { p0_transpose_item<1>(p.w_out, DM, nullptr, (bf16_t*)(p.ws + WS_WOUT), DM, r, 32, scr, lane); continue; } r -= I_OUT;
        p0_transpose_item<1>(p.w_mem_kv, 512, p.mem_gain, (bf16_t*)(p.ws + WS_WMEM), DM, r, 16, scr, lane);
    }
}

constexpr int G_STAGE = 49152, G_AOFF = 0, G_BOFF = 32768;
DEVINL int swz128(int row, int chunk) { return row * 128 + ((chunk ^ ((row >> 1) & 7)) << 4); }
DEVINL void gemm_tile(const bf16_t* __restrict__ A, int lda, const bf16_t* __restrict__ Bt, int ldb, int K, f32x16 (&acc)[2][2], char* lds) {
    const int tid = threadIdx.x, lane = tid & 63, wave = tid >> 6, wm = wave >> 1, wn = wave & 1, r32 = lane & 31, hi = lane >> 5;
    const int lr = tid >> 3, lc = tid & 7;
    const bf16_t* ga = A + (size_t)lr * lda + lc * 8;
    const bf16_t* gb = Bt + (size_t)lr * ldb + lc * 8;
    u32x4 ra[4], rb[2];
#pragma unroll
    for (int j = 0; j < 4; ++j) ra[j] = *(const u32x4*)(ga + (size_t)(64 * j) * lda);
#pragma unroll
    for (int j = 0; j < 2; ++j) rb[j] = *(const u32x4*)(gb + (size_t)(64 * j) * ldb);
#pragma unroll
    for (int j = 0; j < 4; ++j) *(u32x4*)(lds + G_AOFF + swz128(lr + 64 * j, lc)) = ra[j];
#pragma unroll
    for (int j = 0; j < 2; ++j) *(u32x4*)(lds + G_BOFF + swz128(lr + 64 * j, lc)) = rb[j];
    __syncthreads();
    const int nk = K / 64;
    for (int kt = 0; kt < nk; ++kt) {
        const char* st = lds + (kt & 1) * G_STAGE;
        if (kt + 1 < nk) {
#pragma unroll
            for (int j = 0; j < 4; ++j) ra[j] = *(const u32x4*)(ga + (size_t)(64 * j) * lda + (kt + 1) * 64);
#pragma unroll
            for (int j = 0; j < 2; ++j) rb[j] = *(const u32x4*)(gb + (size_t)(64 * j) * ldb + (kt + 1) * 64);
        }
#pragma unroll
        for (int s = 0; s < 4; ++s) {
            const bf16x8 a0 = *(const bf16x8*)(st + G_AOFF + swz128(wm * 64 + r32, 2 * s + hi));
            const bf16x8 a1 = *(const bf16x8*)(st + G_AOFF + swz128(wm * 64 + 32 + r32, 2 * s + hi));
            const bf16x8 b0 = *(const bf16x8*)(st + G_BOFF + swz128(wn * 64 + r32, 2 * s + hi));
            const bf16x8 b1 = *(const bf16x8*)(st + G_BOFF + swz128(wn * 64 + 32 + r32, 2 * s + hi));
            acc[0][0] = MFMA32(b0, a0, acc[0][0]); acc[0][1] = MFMA32(b1, a0, acc[0][1]);
            acc[1][0] = MFMA32(b0, a1, acc[1][0]); acc[1][1] = MFMA32(b1, a1, acc[1][1]);
        }
        if (kt + 1 < nk) {
            char* sn = lds + ((kt + 1) & 1) * G_STAGE;
#pragma unroll
            for (int j = 0; j < 4; ++j) *(u32x4*)(sn + G_AOFF + swz128(lr + 64 * j, lc)) = ra[j];
#pragma unroll
            for (int j = 0; j < 2; ++j) *(u32x4*)(sn + G_BOFF + swz128(lr + 64 * j, lc)) = rb[j];
        }
        __syncthreads();
    }
}
DEVINL void zero_acc(f32x16 (&acc)[2][2]) {
#pragma unroll
    for (int i = 0; i < 2; ++i)
#pragma unroll
        for (int j = 0; j < 2; ++j)
#pragma unroll
            for (int r = 0; r < 16; ++r) acc[i][j][r] = 0.f;
}
constexpr int STG_PITCH = 272;
template <int ACT>
DEVINL void epi_to_lds(const f32x16 (&acc)[2][2], char* lds, float sc) {
    const int tid = threadIdx.x, lane = tid & 63, wave = tid >> 6, wm = wave >> 1, wn = wave & 1, r32 = lane & 31, hi = lane >> 5;
#pragma unroll
    for (int i = 0; i < 2; ++i)
#pragma unroll
        for (int j = 0; j < 2; ++j)
#pragma unroll
            for (int g = 0; g < 4; ++g) {
                float v[4];
#pragma unroll
                for (int e = 0; e < 4; ++e) {
                    float t = acc[i][j][4 * g + e];
                    if (ACT == 1) t *= sc;
                    if (ACT == 2) t = fsilu(t);
                    if (ACT == 3) t = fsigm(t);
                    v[e] = t;
                }
                u32x2 w; w.x = cvtpk(v[0], v[1]); w.y = cvtpk(v[2], v[3]);
                *(u32x2*)(lds + (wm * 64 + 32 * i + r32) * STG_PITCH + (wn * 64 + 32 * j + 8 * g + 4 * hi) * 2) = w;
            }
}
DEVINL void lds_tile_store(char* lds, bf16_t* C, int ldc) {
    const int tid = threadIdx.x;
#pragma unroll
    for (int j = 0; j < 8; ++j) {
        const int row = (tid >> 4) + 32 * j, ch = tid & 15;
        const u32x4 v = *(const u32x4*)(lds + row * STG_PITCH + ch * 16);
        *(u32x4*)(C + (size_t)row * ldc + ch * 8) = v;
    }
}


namespace pg8 {
#define PG8_LAS __attribute__((address_space(3)))
typedef float f32x4 __attribute__((ext_vector_type(4)));
typedef unsigned u32x4 __attribute__((ext_vector_type(4)));
constexpr int BM = 256, BK = 64, HALF = 128, HTB = HALF * BK * 2  , STAGE_BYTES = 8 * HTB, NXCD = 8, WGM = 8;

__host__ __device__ __forceinline__ int lds_byte(int r, int c) { const int st = (r >> 4) * 2 + (c >> 5), rr = r & 15, cc = c & 31, ob = rr * 64 + cc * 2; return st * 1024 + (ob ^ (((ob >> 9) & 1) << 5)); }
__host__ __device__ __forceinline__ void stage_rc(int b, int& R, int& C) { const int st = b / 1024, sb = b % 1024, swz = sb ^ (((sb >> 9) & 1) << 5); R = (st >> 1) * 16 + swz / 64; C = (st & 1) * 32 + (swz % 64) / 2; }
__host__ __device__ __forceinline__ int perm32(int rho) { const int n = rho >> 4, i = rho & 15; return 8 * (i >> 2) + 4 * n + (i & 3); }

struct Unit { int pm, pn; };
struct Gemm { const bf16_t* A; const bf16_t* Bt; int M, N, K; };

struct StaticOrder {
    int nM, nN, nwg, G, c;
    __host__ __device__ void init(int M, int N, int G_, int c_) { nM = M / BM; nN = N / BM; nwg = nM * nN; G = G_; c = c_; }
    __host__ __device__ bool next(int i, Unit& u) const {
        const long L = (long)i * G + c; if (L >= nwg) return false;
        int wgid = (int)L; { const int q = nwg / NXCD, r = nwg % NXCD, xcd = wgid % NXCD, off = wgid / NXCD; wgid = (xcd < r ? xcd * (q + 1) : r * (q + 1) + (xcd - r) * q) + off; }
        const int nig = WGM * nN, gid = wgid / nig, fm = gid * WGM, gsz = (nM - fm) < WGM ? (nM - fm) : WGM;
        u.pm = fm + ((wgid % nig) % gsz); u.pn = (wgid % nig) / gsz; return true;
    }
    __device__ __forceinline__ void a_ready(const Unit&) const {}
    __device__ __forceinline__ void done(const Unit&) const {}
};
template <class Epi, class Sched, bool ALIGN_EPI = false, bool SP2 = false>
__device__ __forceinline__ void gemm_phase(PG8_LAS unsigned char* lds, const Gemm g, const Sched& S, const Epi& E) {
    int tid_ = threadIdx.x; asm volatile("" : "+v"(tid_));
    const int tid = tid_, wid = __builtin_amdgcn_readfirstlane(tid >> 6), lane = tid & 63, wr = wid >> 2, wc = wid & 3, fr = lane & 15, fq = lane >> 4;
    const int K = g.K, nt = K / BK;
    unsigned voffA[2], voffB[2];
#pragma unroll
    for (int i = 0; i < 2; ++i) { int R, C; stage_rc(tid * 16 + i * 8192, R, C); const int Rb = Epi::PERM ? ((R & ~31) + perm32(R & 31)) : R;
        voffA[i] = (unsigned)(R * K + C) * 2u; voffB[i] = (unsigned)(Rb * K + C) * 2u; }
    const size_t kstep = (size_t)(BK * 2);
    const size_t hstep = (size_t)HALF * K * 2;
    const size_t tstep = 2 * hstep;
    const unsigned ldsw = (unsigned)wid * 1024u;
    const int aoff = lds_byte(wr * 64 + fr, fq * 8), boff = lds_byte(wc * 32 + fr, fq * 8);
#define PG8_SA(b, h) (((b) * 2 + (h)) * HTB)
#define PG8_SB(b, h) ((4 + (b) * 2 + (h)) * HTB)
#define PG8_STAGE(bufoff, gbase, voff) do { _Pragma("unroll") for (int _i = 0; _i < 2; ++_i) \
        __builtin_amdgcn_global_load_lds((const unsigned*)((const char*)(gbase) + (voff)[_i]), (PG8_LAS unsigned*)(lds + (bufoff) + ldsw + _i * 8192), 16, 0, 0); } while (0)
#define PG8_LDA(dst, b, h) do { _Pragma("unroll") for (int m = 0; m < 4; ++m) _Pragma("unroll") for (int k = 0; k < 2; ++k) dst[m][k] = *(const PG8_LAS bf16x8*)(lds + PG8_SA(b, h) + aoff + m * 2048 + k * 1024); } while (0)
#define PG8_LDB(dst, b, h) do { _Pragma("unroll") for (int n = 0; n < 2; ++n) _Pragma("unroll") for (int k = 0; k < 2; ++k) dst[n][k] = *(const PG8_LAS bf16x8*)(lds + PG8_SB(b, h) + boff + n * 2048 + k * 1024); } while (0)
#define PG8_MMA(ai, bj, At, Bt) do { __builtin_amdgcn_s_setprio(1); _Pragma("unroll") for (int m = 0; m < 4; ++m) _Pragma("unroll") for (int n = 0; n < 2; ++n) _Pragma("unroll") for (int k = 0; k < 2; ++k) \
        acc[ai][bj][m][n] = __builtin_amdgcn_mfma_f32_16x16x32_bf16(Bt[n][k], At[m][k], acc[ai][bj][m][n], 0, 0, 0); __builtin_amdgcn_s_setprio(0); } while (0)
#define PG8_WAIT_V(n) asm volatile("s_waitcnt vmcnt(" #n ")" ::: "memory")
#define PG8_WAIT_L(n) asm volatile("s_waitcnt lgkmcnt(" #n ")" ::: "memory")
#define PG8_BAR __builtin_amdgcn_s_barrier()
#define PG8_SCHED __builtin_amdgcn_sched_barrier(0)
    Unit cur, nxt; int ui = 0;
    if (!S.next(0, cur)) return;
    f32x4 acc[2][2][4][2];
#pragma unroll
    for (int a = 0; a < 2; ++a)
#pragma unroll
        for (int b = 0; b < 2; ++b)
#pragma unroll
            for (int m = 0; m < 4; ++m)
#pragma unroll
                for (int n = 0; n < 2; ++n) acc[a][b][m][n] = (f32x4){0.f, 0.f, 0.f, 0.f};
    bf16x8 At[4][2], B0[2][2], B1[2][2];
    const char* cA = (const char*)g.A + (size_t)cur.pm * tstep; const char* cB = (const char*)g.Bt + (size_t)cur.pn * tstep;
    S.a_ready(cur);
    if constexpr (SP2) {
        PG8_STAGE(PG8_SB(0, 0), cB, voffB); PG8_STAGE(PG8_SB(0, 1), cB + hstep, voffB); PG8_STAGE(PG8_SA(0, 0), cA, voffA); PG8_STAGE(PG8_SA(0, 1), cA + hstep, voffA);
        if (wr == 1) PG8_BAR;
        PG8_WAIT_V(2); PG8_BAR;
        PG8_STAGE(PG8_SB(1, 0), cB + kstep, voffB); PG8_STAGE(PG8_SA(1, 0), cA + kstep, voffA); PG8_STAGE(PG8_SB(1, 1), cB + hstep + kstep, voffB);
        PG8_WAIT_V(6); PG8_BAR;
    } else {
        PG8_STAGE(PG8_SB(0, 0), cB, voffB); PG8_STAGE(PG8_SA(0, 0), cA, voffA); PG8_STAGE(PG8_SB(0, 1), cB + hstep, voffB); PG8_STAGE(PG8_SA(0, 1), cA + hstep, voffA);
        if (wr == 1) PG8_BAR;
        PG8_WAIT_V(4); PG8_BAR;
        PG8_STAGE(PG8_SB(1, 0), cB + kstep, voffB); PG8_STAGE(PG8_SA(1, 0), cA + kstep, voffA); PG8_STAGE(PG8_SB(1, 1), cB + hstep + kstep, voffB);
        PG8_WAIT_V(6); PG8_BAR;
    }
    for (;;) {
        const bool has_next = S.next(ui + 1, nxt);
        const char* nA = has_next ? (const char*)g.A + (size_t)nxt.pm * tstep : cA; const char* nB = has_next ? (const char*)g.Bt + (size_t)nxt.pn * tstep : cB;
        for (int t = 0; t < nt; t += 2) {
            const bool last = (t == nt - 2);
            const char* a1 = cA + (size_t)(t + 1) * kstep;
            const char* a2 = last ? nA : cA + (size_t)(t + 2) * kstep; const char* b2 = last ? nB : cB + (size_t)(t + 2) * kstep;
            const char* a3 = a2 + kstep; const char* b3 = b2 + kstep;
            if (last && has_next) S.a_ready(nxt);
            if constexpr (SP2) {
            PG8_LDB(B0, 0, 0); PG8_LDB(B1, 0, 1); PG8_SCHED; PG8_LDA(At, 0, 0); PG8_STAGE(PG8_SA(1, 1), a1 + hstep, voffA);
            PG8_WAIT_V(8); PG8_WAIT_L(0); PG8_BAR; PG8_MMA(0, 0, At, B0); PG8_MMA(0, 1, At, B1); PG8_BAR; PG8_SCHED;
            PG8_LDA(At, 0, 1); PG8_STAGE(PG8_SB(0, 0), b2, voffB); PG8_STAGE(PG8_SB(0, 1), b2 + hstep, voffB); PG8_STAGE(PG8_SA(0, 0), a2, voffA);
            PG8_WAIT_V(8); PG8_WAIT_L(0); PG8_BAR; PG8_MMA(1, 0, At, B0); PG8_MMA(1, 1, At, B1); PG8_BAR; PG8_SCHED;
            PG8_LDB(B0, 1, 0); PG8_LDB(B1, 1, 1); PG8_SCHED; PG8_LDA(At, 1, 0); PG8_STAGE(PG8_SA(0, 1), a2 + hstep, voffA);
            PG8_WAIT_V(8); PG8_WAIT_L(0); PG8_BAR; PG8_MMA(0, 0, At, B0); PG8_MMA(0, 1, At, B1); PG8_BAR; PG8_SCHED;
            PG8_LDA(At, 1, 1); PG8_STAGE(PG8_SB(1, 0), b3, voffB); PG8_STAGE(PG8_SB(1, 1), b3 + hstep, voffB); PG8_STAGE(PG8_SA(1, 0), a3, voffA);
            PG8_WAIT_V(8); PG8_WAIT_L(0); PG8_BAR; PG8_MMA(1, 0, At, B0); PG8_MMA(1, 1, At, B1); PG8_BAR; PG8_SCHED;
            } else {
            PG8_LDB(B0, 0, 0); PG8_SCHED; PG8_LDA(At, 0, 0); PG8_STAGE(PG8_SA(1, 1), a1 + hstep, voffA);
            PG8_WAIT_L(8); PG8_BAR; PG8_WAIT_L(0); PG8_MMA(0, 0, At, B0); PG8_BAR; PG8_SCHED;
            PG8_LDB(B1, 0, 1); PG8_STAGE(PG8_SB(0, 0), b2, voffB);
            PG8_BAR; PG8_WAIT_L(0); PG8_MMA(0, 1, At, B1); PG8_BAR;
            PG8_LDA(At, 0, 1); PG8_STAGE(PG8_SA(0, 0), a2, voffA);
            PG8_BAR; PG8_WAIT_L(0); PG8_MMA(1, 0, At, B0); PG8_BAR; PG8_SCHED;
            PG8_STAGE(PG8_SB(0, 1), b2 + hstep, voffB);
            PG8_WAIT_V(6); PG8_BAR; PG8_MMA(1, 1, At, B1); PG8_BAR;
            PG8_LDB(B0, 1, 0); PG8_SCHED; PG8_LDA(At, 1, 0); PG8_STAGE(PG8_SA(0, 1), a2 + hstep, voffA);
            PG8_WAIT_L(8); PG8_BAR; PG8_WAIT_L(0); PG8_MMA(0, 0, At, B0); PG8_BAR; PG8_SCHED;
            PG8_LDB(B1, 1, 1); PG8_STAGE(PG8_SB(1, 0), b3, voffB);
            PG8_BAR; PG8_WAIT_L(0); PG8_MMA(0, 1, At, B1); PG8_BAR;
            PG8_LDA(At, 1, 1); PG8_STAGE(PG8_SA(1, 0), a3, voffA);
            PG8_BAR; PG8_WAIT_L(0); PG8_MMA(1, 0, At, B0); PG8_BAR; PG8_SCHED;
            PG8_STAGE(PG8_SB(1, 1), b3 + hstep, voffB);
            PG8_WAIT_V(6); PG8_BAR; PG8_MMA(1, 1, At, B1); PG8_BAR;
            }
        }
        if constexpr (ALIGN_EPI) { if (wr == 0) PG8_BAR; }
        if constexpr (!Epi::AFTER_DRAIN) { E(acc, cur, wr, wc, fr, fq); S.done(cur); }
        if (!has_next) break;
#pragma unroll
        for (int a = 0; a < 2; ++a)
#pragma unroll
            for (int b = 0; b < 2; ++b)
#pragma unroll
                for (int m = 0; m < 4; ++m)
#pragma unroll
                    for (int n = 0; n < 2; ++n) acc[a][b][m][n] = (f32x4){0.f, 0.f, 0.f, 0.f};
        cur = nxt; cA = nA; cB = nB; ++ui;
        if constexpr (ALIGN_EPI) { if (wr == 1) PG8_BAR; }
    }
    PG8_WAIT_V(0);
    if constexpr (!ALIGN_EPI) { if (wr == 0) PG8_BAR; }
    PG8_BAR;
    if constexpr (Epi::AFTER_DRAIN) { E.fused(acc, cur, wr, wc, fr, fq, lds, wid, lane); S.done(cur); }
#undef PG8_SA
#undef PG8_SB
#undef PG8_STAGE
#undef PG8_LDA
#undef PG8_LDB
#undef PG8_MMA
#undef PG8_WAIT_V
#undef PG8_WAIT_L
#undef PG8_BAR
#undef PG8_SCHED
}
}

DEVINL void proj_store_group(const pg8::f32x4 (&acc)[2][2][4][2], int bj, bf16_t* dst, int ld, int act, size_t row0, int cl0) {
    bf16_t* dp = dst + row0 * ld + cl0;
#pragma unroll
    for (int ai = 0; ai < 2; ++ai)
#pragma unroll
        for (int m = 0; m < 4; ++m) {
            float v[8];
#pragma unroll
            for (int e = 0; e < 4; ++e) { v[e] = bj == 0 ? acc[ai][0][m][0][e] : acc[ai][1][m][0][e]; v[4 + e] = bj == 0 ? acc[ai][0][m][1][e] : acc[ai][1][m][1][e]; }
            if (act == 1) {
#pragma unroll
                for (int e = 0; e < 8; ++e) v[e] *= QSCALE;
            } else if (act == 2) {
#pragma unroll
                for (int e = 0; e < 8; ++e) v[e] = fsilu(v[e]);
            } else if (act == 3) {
#pragma unroll
                for (int e = 0; e < 8; ++e) v[e] = fsigm(v[e]);
            }
            if (act == 4) {
                int w0 = __builtin_amdgcn_cvt_pk_fp8_f32(v[0], v[1], 0, false); w0 = __builtin_amdgcn_cvt_pk_fp8_f32(v[2], v[3], w0, true);
                int w1 = __builtin_amdgcn_cvt_pk_fp8_f32(v[4], v[5], 0, false); w1 = __builtin_amdgcn_cvt_pk_fp8_f32(v[6], v[7], w1, true);
                *(u32x2*)((unsigned char*)dst + (row0 + ai * 128 + m * 16) * ld + cl0) = (u32x2){(unsigned)w0, (unsigned)w1};
            } else {
                u32x4 w; w.x = cvtpk(v[0], v[1]); w.y = cvtpk(v[2], v[3]); w.z = cvtpk(v[4], v[5]); w.w = cvtpk(v[6], v[7]);
                *(u32x4*)(dp + (size_t)(ai * 128 + m * 16) * ld) = w;
            }
            asm volatile("" ::: "memory");
        }
}
struct EpiProj {
    static constexpr bool PERM = true, AFTER_DRAIN = false;
    unsigned char* ws;
    DEVINL void operator()(const pg8::f32x4 (&acc)[2][2][4][2], const pg8::Unit& u, int wr, int wc, int fr, int fq) const {
#pragma unroll
        for (int bj = 0; bj < 2; ++bj) {
            const int idx = 2 * u.pn + bj;
            if (idx >= 57) continue;
            const size_t row0 = (size_t)u.pm * 256 + wr * 64 + fr;
            const int cl0 = wc * 32 + 8 * fq;
            size_t boff; int ld, act = 0;
            if (idx < 24) { const int g8 = idx / 3; boff = WS_ACT8 + (size_t)g8 * ACT_STRIDE + (idx % 3) * 256; ld = 384; act = (g8 == 0 || g8 == 4) ? 1 : ((g8 == 3 || g8 == 7) ? 2 : 0);
                if (g8 == 5 || g8 == 6) { act = 4; boff = WS_ACT8 + (size_t)g8 * ACT_STRIDE + (idx % 3) * 128; } }
            else if (idx < 28) { boff = WS_IQ + (idx - 24) * 256; ld = 512; }
            else if (idx < 30) { boff = WS_QM + (idx - 28) * 256; ld = 256; act = 1; }
            else if (idx < 32) { boff = WS_ZM + (idx - 30) * 256; ld = 256; act = 2; }
            else if (idx == 32) { boff = WS_IK; ld = 64; }
            else { boff = WS_GATES + (idx - 33) * 256; ld = 3072; act = 3; }
            if (idx != 32 || wc < 2) proj_store_group(acc, bj, (bf16_t*)(ws + boff), ld, act, row0, cl0);
            if (idx == 32 && wc == 2 && fq == 0) {
                float* IW = (float*)(ws + WS_IW);
#pragma unroll
                for (int ai = 0; ai < 2; ++ai)
#pragma unroll
                    for (int m = 0; m < 4; ++m) {
                        const size_t r = row0 + ai * 128 + m * 16;
                        *(f32x4*)(IW + r * 8) = acc[ai][bj][m][0] * CSCALE; *(f32x4*)(IW + r * 8 + 4) = acc[ai][bj][m][1] * CSCALE;
                    }
            }
            if (idx >= 3 && idx < 6) {
                float cs[8];
#pragma unroll
                for (int e = 0; e < 8; ++e) cs[e] = 0.f;
#pragma unroll
                for (int ai = 0; ai < 2; ++ai)
#pragma unroll
                    for (int m = 0; m < 4; ++m)
#pragma unroll
                        for (int e = 0; e < 4; ++e) { cs[e] += acc[ai][bj][m][0][e]; cs[4 + e] += acc[ai][bj][m][1][e]; }
#pragma unroll
                for (int e = 0; e < 8; ++e) { cs[e] += __shfl_xor(cs[e], 1); cs[e] += __shfl_xor(cs[e], 2); cs[e] += __shfl_xor(cs[e], 4); cs[e] += __shfl_xor(cs[e], 8); }
                if (fr == 0) {
                    float* KM = (float*)(ws + WS_KMEAN) + ((size_t)u.pm * 2 + wr) * 384 + (idx - 3) * 128 + cl0;
                    *(f32x4*)KM = (f32x4){cs[0], cs[1], cs[2], cs[3]}; *(f32x4*)(KM + 4) = (f32x4){cs[4], cs[5], cs[6], cs[7]};
                }
            }
            asm volatile("" ::: "memory");
        }
    }
};
struct EpiOut {
    static constexpr bool PERM = false, AFTER_DRAIN = false;
    const float* x; float* out; float* ssq;
    DEVINL void operator()(const pg8::f32x4 (&acc)[2][2][4][2], const pg8::Unit& u, int wr, int wc, int fr, int fq) const {
#pragma unroll
        for (int ai = 0; ai < 2; ++ai)
#pragma unroll
            for (int m = 0; m < 4; ++m) {
                const size_t row = (size_t)u.pm * 256 + ai * 128 + wr * 64 + m * 16 + fr;
                float ss = 0.f;
#pragma unroll
                for (int bj = 0; bj < 2; ++bj)
#pragma unroll
                    for (int n = 0; n < 2; ++n) {
                        const int col = u.pn * 256 + bj * 128 + wc * 32 + n * 16 + 4 * fq;
                        const f32x4 xv = *(const f32x4*)(x + row * DM + col);
                        const f32x4 y = xv + acc[ai][bj][m][n];
                        ss += (y.x * y.x + y.y * y.y) + (y.z * y.z + y.w * y.w);
                        *(f32x4*)(out + row * DM + col) = y;
                    }
                ss += __shfl_xor(ss, 16); ss += __shfl_xor(ss, 32);
                if (fq == 0) ssq[row * 16 + u.pn * 4 + wc] = ss;
            }
    }
};
DEVINL void phase1(const Params& p, char* lds) {
    {
        pg8::Gemm g{(const bf16_t*)p.out, (const bf16_t*)(p.ws + WS_WIN), NT, NWIN, DM};
        pg8::StaticOrder S; S.init(NT, NWIN, (int)gridDim.x, (int)blockIdx.x);
        EpiProj E{p.ws};
        pg8::gemm_phase<EpiProj, pg8::StaticOrder, true, true>((LAS unsigned char*)lds, g, S, E);
    }
    __syncthreads();
    for (int it = (int)blockIdx.x - (gridDim.x >= 144 ? 128 : 0); it >= 0 && it < 16; it += gridDim.x) {
        const int mt = it >> 2, nt = it & 3;
        f32x16 acc[2][2]; zero_acc(acc);
        gemm_tile((const bf16_t*)(p.ws + WS_MEMN) + (size_t)mt * 256 * DM, DM, (const bf16_t*)(p.ws + WS_WMEM) + (size_t)nt * 128 * DM, DM, DM, acc, lds);
        epi_to_lds<0>(acc, lds, 1.f); __syncthreads();
        bf16_t* dst = (bf16_t*)(p.ws + (nt < 2 ? WS_MK : WS_MV)) + (size_t)mt * 256 * 256 + (nt & 1) * 128;
        lds_tile_store(lds, dst, 256); __syncthreads();
    }
}

DEVINL void phase_merge(const Params& p, char* lds) {
    const int tid = threadIdx.x, lane = tid & 63, wave = tid >> 6, wm = wave >> 1, wn = wave & 1, r32 = lane & 31, hi = lane >> 5;
    const bf16_t* WBR = (const bf16_t*)(p.ws + WS_WBR);
    const bf16_t* GATES = (const bf16_t*)(p.ws + WS_GATES);
    const int lr = tid >> 3, lc = tid & 7;
    for (int it = blockIdx.x; it < 128 * 8; it += gridDim.x) {
        const int nt = it >> 7, mt = it & 127;
        const size_t m0 = (size_t)mt * 256;
        const bf16_t* gb = WBR + (size_t)nt * 128 * DM + (size_t)lr * DM + lc * 8;
        const bf16_t* ya = (const bf16_t*)(p.ws + WS_ACT8) + (m0 + lr) * 384 + lc * 8;
        const bf16_t* yb = (const bf16_t*)(p.ws + WS_ACT8 + 4 * ACT_STRIDE) + (m0 + lr) * 384 + lc * 8;
        const bf16_t* ym = (const bf16_t*)(p.ws + WS_QM) + (m0 + lr) * 256 + lc * 8;
        f32x16 acc[2][2]; zero_acc(acc);
        u32x4 ra0[4], rb0[2], ra1[4], rb1[2];
#define MG_LOAD(RA, RB, kt) do { const bf16_t* ap_; size_t ld_; \
            if ((kt) < 6) { ap_ = ya + (kt) * 64; ld_ = 384; } else if ((kt) < 12) { ap_ = yb + ((kt) - 6) * 64; ld_ = 384; } else { ap_ = ym + ((kt) - 12) * 64; ld_ = 256; } \
            _Pragma("unroll") for (int j_ = 0; j_ < 4; ++j_) RA[j_] = *(const u32x4*)(ap_ + (size_t)(64 * j_) * ld_); \
            _Pragma("unroll") for (int j_ = 0; j_ < 2; ++j_) RB[j_] = *(const u32x4*)(gb + (size_t)(64 * j_) * DM + (kt) * 64); } while (0)
#define MG_COMMIT(RA, RB, stg) do { char* sn_ = lds + (stg) * G_STAGE; \
            _Pragma("unroll") for (int j_ = 0; j_ < 4; ++j_) *(u32x4*)(sn_ + G_AOFF + swz128(lr + 64 * j_, lc)) = RA[j_]; \
            _Pragma("unroll") for (int j_ = 0; j_ < 2; ++j_) *(u32x4*)(sn_ + G_BOFF + swz128(lr + 64 * j_, lc)) = RB[j_]; } while (0)
#define MG_COMPUTE(kt) do { const char* st = lds + ((kt) & 1) * G_STAGE; \
            _Pragma("unroll") for (int s = 0; s < 4; ++s) { \
                const bf16x8 a0 = *(const bf16x8*)(st + G_AOFF + swz128(wm * 64 + r32, 2 * s + hi)); \
                const bf16x8 a1 = *(const bf16x8*)(st + G_AOFF + swz128(wm * 64 + 32 + r32, 2 * s + hi)); \
                const bf16x8 b0 = *(const bf16x8*)(st + G_BOFF + swz128(wn * 64 + r32, 2 * s + hi)); \
                const bf16x8 b1 = *(const bf16x8*)(st + G_BOFF + swz128(wn * 64 + 32 + r32, 2 * s + hi)); \
                acc[0][0] = MFMA32(b0, a0, acc[0][0]); acc[0][1] = MFMA32(b1, a0, acc[0][1]); \
                acc[1][0] = MFMA32(b0, a1, acc[1][0]); acc[1][1] = MFMA32(b1, a1, acc[1][1]); } } while (0)
#define MG_GATE(kt) do { if ((kt) == 5 || (kt) == 11 || (kt) == 15) { const int br = (kt) == 5 ? 0 : ((kt) == 11 ? 1 : 2); \
            _Pragma("unroll") for (int i = 0; i < 2; ++i) _Pragma("unroll") for (int j = 0; j < 2; ++j) _Pragma("unroll") for (int g = 0; g < 4; ++g) { \
                const bf16_t* gp = GATES + (m0 + wm * 64 + 32 * i + r32) * 3072 + br * 1024 + nt * 128 + wn * 64 + 32 * j + 8 * g + 4 * hi; \
                const u32x2 gw = *(const u32x2*)gp; \
                float f0 = bf_lo(gw.x), f1 = bf_hi(gw.x), f2 = bf_lo(gw.y), f3 = bf_hi(gw.y); \
                if (br < 2) { const u32x2 gn = *(const u32x2*)(gp + 1024); f0 *= frcp(bf_lo(gn.x)); f1 *= frcp(bf_hi(gn.x)); f2 *= frcp(bf_lo(gn.y)); f3 *= frcp(bf_hi(gn.y)); } \
                acc[i][j][4 * g + 0] *= f0; acc[i][j][4 * g + 1] *= f1; acc[i][j][4 * g + 2] *= f2; acc[i][j][4 * g + 3] *= f3; } } } while (0)
        MG_LOAD(ra0, rb0, 0); MG_LOAD(ra1, rb1, 1);
        MG_COMMIT(ra0, rb0, 0); MG_COMMIT(ra1, rb1, 1);
        MG_LOAD(ra0, rb0, 2); MG_LOAD(ra1, rb1, 3);
        __syncthreads();
#pragma unroll 1
        for (int kt = 0; kt < 16; kt += 2) {
            MG_COMPUTE(kt); MG_GATE(kt);
            __syncthreads();
            if (kt + 2 < 16) MG_COMMIT(ra0, rb0, 0);
            if (kt + 4 < 16) MG_LOAD(ra0, rb0, kt + 4);
            MG_COMPUTE(kt + 1); MG_GATE(kt + 1);
            __syncthreads();
            if (kt + 3 < 16) MG_COMMIT(ra1, rb1, 1);
            if (kt + 5 < 16) MG_LOAD(ra1, rb1, kt + 5);
        }
        __syncthreads();
#undef MG_COMPUTE
#undef MG_GATE
#undef MG_LOAD
#undef MG_COMMIT
        epi_to_lds<0>(acc, lds, 1.f); __syncthreads();
        lds_tile_store(lds, (bf16_t*)(p.ws + WS_MERGED) + m0 * DM + nt * 128, DM); __syncthreads();
    }
}

DEVINL void phase_out(const Params& p, char* lds) {
    pg8::Gemm g{(const bf16_t*)(p.ws + WS_MERGED), (const bf16_t*)(p.ws + WS_WOUT), NT, DM, DM};
    pg8::StaticOrder S; S.init(NT, DM, (int)gridDim.x, (int)blockIdx.x);
    EpiOut E{p.x, p.out, (float*)(p.ws + WS_SSQ)};
    pg8::gemm_phase<EpiOut, pg8::StaticOrder, true, true>((LAS unsigned char*)lds, g, S, E);
    __syncthreads();
}
DEVINL void phase_final(const Params& p) {
    const int tid = threadIdx.x, lane = tid & 63, wave = tid >> 6;
#ifdef PROBE_A
    const unsigned* tsw = (const unsigned*)(p.ws + WS_CTL) + 4096;
    const float probeA = (float)(tsw[PROBE_A + 1] - tsw[PROBE_A]) * 1e-4f;
    const float probeB = (float)(tsw[PROBE_B + 1] - tsw[PROBE_B]) * 1e-5f;
#endif
    const float* SSQ = (const float*)(p.ws + WS_SSQ);
    for (int r = blockIdx.x * 8 + wave; r < NT; r += gridDim.x * 8) {
        float ss = 0.f;
#pragma unroll
        for (int k = 0; k < 4; ++k) { const f32x4 sv = *(const f32x4*)(SSQ + (size_t)r * 16 + 4 * k); ss += (sv.x + sv.y) + (sv.z + sv.w); }
        const float rstd = rsqrtf(ss * (1.f / DM) + EPS);
        f32x4* yr = (f32x4*)(p.out + (size_t)r * DM) + lane;
        const f32x4* gr = (const f32x4*)p.final_gain + lane;
#pragma unroll
        for (int j = 0; j < 4; ++j) { f32x4 y = yr[64 * j]; const f32x4 g = gr[64 * j]; y.x *= rstd * g.x; y.y *= rstd * g.y; y.z *= rstd * g.z; y.w *= rstd * g.w;
#ifdef PROBE_A
            y.x += probeB; y.y += probeB; y.z += probeB; y.w += probeB; if (r == 0 && j == 0 && lane == 0) y.x += probeA;
#endif
            yr[64 * j] = y; }
    }
}

constexpr int AT_K = 0, AT_V = 32768, AT_VPLANE = 16384 + 64, AT_END = AT_V + 2 * AT_VPLANE;
DEVINL void load_kv_block(const bf16_t* __restrict__ Kg, const bf16_t* __restrict__ Vg, int ld, char* lds) {
    const int tid = threadIdx.x, c = tid & 7, kr = tid >> 3;
    u32x4 kk[4], vv[4];
#pragma unroll
    for (int j = 0; j < 4; ++j) { kk[j] = *(const u32x4*)(Kg + (size_t)(kr + 64 * j) * ld + c * 8); vv[j] = *(const u32x4*)(Vg + (size_t)(kr + 64 * j) * ld + c * 8); }
#pragma unroll
    for (int j = 0; j < 4; ++j) {
        const int key = kr + 64 * j;
        *(u32x4*)(lds + AT_K + swz128(key, c)) = kk[j];
        *(u32x4*)(lds + AT_V + (c >> 2) * AT_VPLANE + key * 64 + (c & 3) * 16) = vv[j];
    }
}
DEVINL s16x4 tr_read(const char* p) {
    typedef short v4i16_t __attribute__((ext_vector_type(4)));
    return __builtin_bit_cast(s16x4, __builtin_amdgcn_ds_read_tr16_b64_v4i16((LAS v4i16_t*)(uintptr_t)(unsigned)(uintptr_t)p));
}
struct AttnState { float mhat, l; f32x16 o0, o1; };
constexpr float ATT_THR = 8.f;
template <int MODE>
DEVINL void attn_256(const bf16x8 (&qf)[4], const char* lds, int t_row, int pos0, const float* lut, float* wsf, AttnState& st) {
    const int lane = threadIdx.x & 63, r32 = lane & 31, hi = lane >> 5;
    const char* KL = lds + AT_K;
    const char* vbase = lds + AT_V + (4 * hi + ((lane & 15) >> 2)) * 64 + ((lane >> 4) & 1) * 32 + (lane & 3) * 8;
    float mhat = 0.f, l = 0.f;
    f32x16 o0, o1;
#pragma unroll
    for (int r = 0; r < 16; ++r) { o0[r] = 0.f; o1[r] = 0.f; }
#pragma unroll 1
    for (int stp = 0; stp < 4; ++stp) {
        f32x16 s0, s1;
#pragma unroll
        for (int r = 0; r < 16; ++r) { s0[r] = 0.f; s1[r] = 0.f; }
#pragma unroll
        for (int s = 0; s < 4; ++s) {
            const bf16x8 k0 = *(const bf16x8*)(KL + swz128(64 * stp + r32, 2 * s + hi));
            const bf16x8 k1 = *(const bf16x8*)(KL + swz128(64 * stp + 32 + r32, 2 * s + hi));
            s0 = MFMA32(k0, qf[s], s0); s1 = MFMA32(k1, qf[s], s1);
        }
        if (MODE == 1) {
#pragma unroll
            for (int r = 0; r < 16; ++r) {
                const int d0 = t_row - (pos0 + 64 * stp + crow(r, hi)), d1 = d0 - 32;
                s0[r] = d0 < 0 ? -INFINITY : s0[r] + lut[d0 > 127 ? 127 : d0];
                s1[r] = d1 < 0 ? -INFINITY : s1[r] + lut[d1 > 127 ? 127 : d1];
            }
        }
        float rm = fmaxf(s0[0], s1[0]);
#pragma unroll
        for (int r = 1; r < 16; ++r) rm = fmaxf(rm, fmaxf(s0[r], s1[r]));
        { auto rr = __builtin_amdgcn_permlane32_swap(__float_as_uint(rm), __float_as_uint(rm), false, false); rm = fmaxf(__uint_as_float(rr[0]), __uint_as_float(rr[1])); }
        if (stp == 0) { mhat = fmaxf(rm, -1e30f); }
        else {
            const float grow = rm - mhat;
            if (__any(grow > ATT_THR)) {
                const float dl = fmaxf(grow, 0.f); mhat += dl;
                const float f = fexp2(-dl); l *= f;
                if (hi == 0) wsf[r32] = f;
                LDS_WAIT();
#pragma unroll
                for (int g = 0; g < 4; ++g) {
                    const f32x4 fv = *(const f32x4*)(wsf + 8 * g + 4 * hi);
                    o0[4 * g + 0] *= fv.x; o0[4 * g + 1] *= fv.y; o0[4 * g + 2] *= fv.z; o0[4 * g + 3] *= fv.w;
                    o1[4 * g + 0] *= fv.x; o1[4 * g + 1] *= fv.y; o1[4 * g + 2] *= fv.z; o1[4 * g + 3] *= fv.w;
                }
                LDS_WAIT();
            }
        }
        float ps = 0.f;
#pragma unroll
        for (int r = 0; r < 16; ++r) { s0[r] = fexp2(s0[r] - mhat); s1[r] = fexp2(s1[r] - mhat); ps += s0[r] + s1[r]; }
        l += ps;
#pragma unroll
        for (int sub = 0; sub < 2; ++sub)
#pragma unroll
            for (int sp = 0; sp < 2; ++sp) {
                u32x4 pw;
                if (sub == 0) { pw.x = cvtpk(s0[8 * sp + 0], s0[8 * sp + 1]); pw.y = cvtpk(s0[8 * sp + 2], s0[8 * sp + 3]); pw.z = cvtpk(s0[8 * sp + 4], s0[8 * sp + 5]); pw.w = cvtpk(s0[8 * sp + 6], s0[8 * sp + 7]); }
                else { pw.x = cvtpk(s1[8 * sp + 0], s1[8 * sp + 1]); pw.y = cvtpk(s1[8 * sp + 2], s1[8 * sp + 3]); pw.z = cvtpk(s1[8 * sp + 4], s1[8 * sp + 5]); pw.w = cvtpk(s1[8 * sp + 6], s1[8 * sp + 7]); }
                const bf16x8 pf = __builtin_bit_cast(bf16x8, pw);
                const int keybase = 64 * stp + 32 * sub + 16 * sp;
                const char* va = vbase + keybase * 64;
                const s16x4 a0 = tr_read(va), a1 = tr_read(va + 512);
                const s16x4 b0 = tr_read(va + AT_VPLANE), b1 = tr_read(va + AT_VPLANE + 512);
                const bf16x8 vf0 = (bf16x8){a0[0], a0[1], a0[2], a0[3], a1[0], a1[1], a1[2], a1[3]};
                const bf16x8 vf1 = (bf16x8){b0[0], b0[1], b0[2], b0[3], b1[0], b1[1], b1[2], b1[3]};
                o0 = MFMA32(pf, vf0, o0); o1 = MFMA32(pf, vf1, o1);
            }
    }
    st.mhat = mhat; st.l = l; st.o0 = o0; st.o1 = o1;
}
DEVINL float half_sum(float v) { auto rr = __builtin_amdgcn_permlane32_swap(__float_as_uint(v), __float_as_uint(v), false, false); return __uint_as_float(rr[0]) + __uint_as_float(rr[1]); }
DEVINL void rows_to_regs(float v, float* wsf, float (&out)[16]) {
    const int lane = threadIdx.x & 63, r32 = lane & 31, hi = lane >> 5;
    LDS_WAIT();
    if (hi == 0) wsf[r32] = v;
    LDS_WAIT();
#pragma unroll
    for (int g = 0; g < 4; ++g) { const f32x4 fv = *(const f32x4*)(wsf + 8 * g + 4 * hi); out[4 * g] = fv.x; out[4 * g + 1] = fv.y; out[4 * g + 2] = fv.z; out[4 * g + 3] = fv.w; }
    LDS_WAIT();
}
DEVINL void build_lut(float* lut, const float* rel_bias, int col) {
    const int tid = threadIdx.x;
    if (tid < 128) lut[tid] = rel_bias[rel_bucket(tid) * 12 + col] * LOG2E;
}

DEVINL void moba_select_item(const Params& p, char* lds, int item) {
    const int tid = threadIdx.x;
    const int b = item / (HA * 16), h = (item / 16) % HA, t = (item % 16) * 512 + tid, own = t >> 8;
    float* km = (float*)lds;
    unsigned* lcnt = (unsigned*)(lds + 8192);
    unsigned* lbase = lcnt + 64;
    const float* KMEAN = (const float*)(p.ws + WS_KMEAN);
    for (int i = tid; i < 2048; i += NTHR) { const size_t o = (size_t)(b * 32 + (i >> 6)) * 768 + h * 64 + (i & 63); km[i] = (KMEAN[o] + KMEAN[o + 384]) * (1.f / 256.f); }
    if (tid < 64) lcnt[tid] = 0u;
    __syncthreads();
    const bf16_t* q = (const bf16_t*)(p.ws + WS_ACT8) + (size_t)(b * SEQ + t) * 384 + h * 64;
    float qv[64];
#pragma unroll
    for (int c = 0; c < 8; ++c) {
        const u32x4 w = *(const u32x4*)(q + c * 8);
        qv[8 * c + 0] = bf_lo(w.x); qv[8 * c + 1] = bf_hi(w.x); qv[8 * c + 2] = bf_lo(w.y); qv[8 * c + 3] = bf_hi(w.y);
        qv[8 * c + 4] = bf_lo(w.z); qv[8 * c + 5] = bf_hi(w.z); qv[8 * c + 6] = bf_lo(w.w); qv[8 * c + 7] = bf_hi(w.w);
    }
    float v0 = -INFINITY, v1 = -INFINITY, v2 = -INFINITY; int i0 = 0, i1 = 1, i2 = 2;
    const int nmax = (((item % 16) * 512 + 511) >> 8);
#pragma unroll 1
    for (int n = 0; n < nmax; ++n) {
        float g = 0.f;
#pragma unroll
        for (int c = 0; c < 16; ++c) { const f32x4 kv = *(const f32x4*)(km + n * 64 + 4 * c); g += qv[4 * c] * kv.x + qv[4 * c + 1] * kv.y + qv[4 * c + 2] * kv.z + qv[4 * c + 3] * kv.w; }
        if (n < own) {
            if (g > v0) { v2 = v1; i2 = i1; v1 = v0; i1 = i0; v0 = g; i0 = n; }
            else if (g > v1) { v2 = v1; i2 = i1; v1 = g; i1 = n; }
            else if (g > v2) { v2 = g; i2 = n; }
        }
    }
    const int nsel = own < 3 ? own : 3;
    const int sel[3] = {i0, i1, i2};
    unsigned off[3] = {0u, 0u, 0u};
#pragma unroll
    for (int s3 = 0; s3 < 3; ++s3) if (s3 < nsel) off[s3] = atomicAdd(&lcnt[sel[s3] + (sel[s3] == own - 1 ? 32 : 0)], 1u);
    __syncthreads();
    unsigned* gcnt = (unsigned*)(p.ws + WS_CTL) + (b * HA + h) * 32;
    if (tid < 64) lbase[tid] = lcnt[tid] ? atomicAdd(&gcnt[(tid & 31) + (tid >> 5) * 768], lcnt[tid]) : 0u;
    __syncthreads();
    bf16_t* L = (bf16_t*)(p.ws + WS_LIST) + (size_t)(b * HA + h) * LIST_PER_BH;
#pragma unroll
    for (int s3 = 0; s3 < 3; ++s3)
        if (s3 < nsel) {
            const int n = sel[s3]; const bool near = n == own - 1;
            const int pos = near ? list_off(n + 1) - 1 - (int)(lbase[32 + n] + off[s3]) : list_off(n) + (int)(lbase[n] + off[s3]);
            L[pos] = (bf16_t)(t | (s3 << 13));
        }
    __syncthreads();
}

DEVINL void mem_attn_item(const Params& p, char* lds, int item) {
    const int tid = threadIdx.x, lane = tid & 63, wave = tid >> 6, r32 = lane & 31, hi = lane >> 5;
    const int b = item / (HM * 32), h = (item / 32) % HM, qt = item % 32;
    float* wsf = (float*)(lds + AT_END) + wave * 32;
    char* ostg = lds + AT_END + 1024 + wave * 4096;
    load_kv_block((const bf16_t*)(p.ws + WS_MK) + (size_t)b * 256 * 256 + h * 64, (const bf16_t*)(p.ws + WS_MV) + (size_t)b * 256 * 256 + h * 64, 256, lds);
    const size_t row0 = (size_t)b * SEQ + qt * 256 + wave * 32;
    bf16_t* QM = (bf16_t*)(p.ws + WS_QM);
    bf16x8 qf[4];
#pragma unroll
    for (int s = 0; s < 4; ++s) qf[s] = *(const bf16x8*)(QM + (row0 + r32) * 256 + h * 64 + 16 * s + 8 * hi);
    __syncthreads();
    AttnState st;
    attn_256<0>(qf, lds, 0, 0, nullptr, wsf, st);
    const float ltot = half_sum(st.l);
    float rl[16]; rows_to_regs(frcp(ltot), wsf, rl);
#pragma unroll
    for (int r = 0; r < 16; ++r) {
        *(bf16_t*)(ostg + crow(r, hi) * 128 + r32 * 2) = (bf16_t)(cvtpk(st.o0[r] * rl[r], 0.f) & 0xffffu);
        *(bf16_t*)(ostg + crow(r, hi) * 128 + (32 + r32) * 2) = (bf16_t)(cvtpk(st.o1[r] * rl[r], 0.f) & 0xffffu);
    }
    LDS_WAIT();
    const bf16_t* ZM = (const bf16_t*)(p.ws + WS_ZM);
#pragma unroll
    for (int i = 0; i < 4; ++i) {
        const int row = i * 8 + (lane >> 3), ch = lane & 7;
        const u32x4 ov = *(const u32x4*)(ostg + row * 128 + ch * 16);
        const u32x4 zv = *(const u32x4*)(ZM + (row0 + row) * 256 + h * 64 + ch * 8);
        u32x4 w;
        w.x = cvtpk(bf_lo(ov.x) * bf_lo(zv.x), bf_hi(ov.x) * bf_hi(zv.x)); w.y = cvtpk(bf_lo(ov.y) * bf_lo(zv.y), bf_hi(ov.y) * bf_hi(zv.y));
        w.z = cvtpk(bf_lo(ov.z) * bf_lo(zv.z), bf_hi(ov.z) * bf_hi(zv.z)); w.w = cvtpk(bf_lo(ov.w) * bf_lo(zv.w), bf_hi(ov.w) * bf_hi(zv.w));
        *(u32x4*)(QM + (row0 + row) * 256 + h * 64 + ch * 8) = w;
    }
    __syncthreads();
}

constexpr int IXL_META = 0, IXL_CAND = 2048, IX_CAP = 128, IXL_CANDK = IXL_CAND + 32 * IX_CAP * 4, IXL_HIST = IXL_CAND + 32 * IX_CAP * 6, IXL_STAGE = IXL_HIST + 65536, IXL_END = IXL_STAGE + 2 * 32768;
struct IxMeta { int need[32]; int nr[32]; int done[32]; int ccnt[32]; int lcnt[32]; int B[4][32]; float lo[4][32]; float sc[4][32]; int flag; };
DEVINL int ix_bin(float s, float lo, float sc) { float v = (s - lo) * sc; v = fminf(fmaxf(v, 0.f), 511.f); return (int)v; }
DEVINL int ix_bin0(float s) { return (int)__builtin_amdgcn_fmed3f(__builtin_fmaf(s, 64.f, 256.f), 0.f, 511.f); }
DEVINL float ix_sc(int r) { return r == 0 ? 128.f : (r == 1 ? 65536.f : 33554432.f); }
DEVINL float relu1(float x) { return __builtin_amdgcn_fmed3f(x, 0.f, 3.0e38f); }
DEVINL f32x16 ix_mma(const bf16x8 (&a)[4], const bf16x8 (&b)[4]) {
    f32x16 acc;
#pragma unroll
    for (int r = 0; r < 16; ++r) acc[r] = 0.f;
#pragma unroll
    for (int s = 0; s < 4; ++s) acc = MFMA32(a[s], b[s], acc);
    return acc;
}
DEVINL void ix_reduce(const f32x16& acc, const f32x4 (&cv)[4], float& sA, float& sB) {
    float pj[4];
#pragma unroll
    for (int j = 0; j < 4; ++j) pj[j] = cv[j].x * relu1(acc[4 * j]) + cv[j].y * relu1(acc[4 * j + 1]) + cv[j].z * relu1(acc[4 * j + 2]) + cv[j].w * relu1(acc[4 * j + 3]);
    auto r02 = __builtin_amdgcn_permlane32_swap(__float_as_uint(pj[0]), __float_as_uint(pj[2]), false, false);
    auto r13 = __builtin_amdgcn_permlane32_swap(__float_as_uint(pj[1]), __float_as_uint(pj[3]), false, false);
    sA = __uint_as_float(r02[0]) + __uint_as_float(r02[1]);
    sB = __uint_as_float(r13[0]) + __uint_as_float(r13[1]);
}
template <int MODE, bool CAUSAL>
DEVINL void ix_tile(const f32x16& acc, const f32x4 (&cv)[4], int t0, int kt, int (&B0r)[2], int (&cnt)[2], int (&ccn)[2], IxMeta* meta, char* lds, int round) {
    const int lane = threadIdx.x & 63, wave = threadIdx.x >> 6, r32 = lane & 31, hi = lane >> 5;
    char* histb = lds + IXL_HIST;
    float* cand_s = (float*)(lds + IXL_CAND);
    bf16_t* cand_k = (bf16_t*)(lds + IXL_CANDK);
    const int k = 32 * kt + r32;
    float sc2[2];
    ix_reduce(acc, cv, sc2[0], sc2[1]);
#pragma unroll
    for (int q = 0; q < 2; ++q) {
        const float sv = sc2[q];
        const int row = 4 * wave + 2 * hi + q;
        const bool adm = CAUSAL ? (k <= t0 + row) : true;
        const int b0 = ix_bin0(sv);
        if (MODE == 0) {
            if (adm) atomicAdd((unsigned*)(histb + row * 2048 + b0 * 4), 1u);
        } else if (MODE == 2) {
            if (adm && !meta->done[row]) {
                bool eq = (b0 == meta->B[0][row]);
                for (int j = 1; j < round; ++j) eq = eq && (ix_bin(sv, meta->lo[j][row], meta->sc[j][row]) == meta->B[j][row]);
                if (eq) { const int bb = ix_bin(sv, meta->lo[round][row], meta->sc[round][row]); atomicAdd((unsigned*)(histb + row * 2048 + bb * 4), 1u); }
            }
        } else {
            const int B0 = B0r[q] & 0xffff;
            bool above = adm && b0 > B0, eqv = adm && b0 == B0;
            if (B0r[q] & 0x10000) {
                if (eqv) {
                    const int nr = meta->nr[row]; int cls = 1;
                    for (int j = 1; j < nr && cls == 1; ++j) { const int bj = ix_bin(sv, meta->lo[j][row], meta->sc[j][row]), Bj = meta->B[j][row]; if (bj > Bj) cls = 2; else if (bj < Bj) cls = 0; }
                    above = cls == 2; eqv = cls == 1;
                }
            }
            const unsigned long long bal = __ballot(above);
            const unsigned hm = (unsigned)(bal >> (32 * hi));
            const int pos = cnt[q] + __popc(hm & ((1u << r32) - 1u));
            if (above && pos < 256) *(bf16_t*)(histb + row * 2048 + pos * 2) = (bf16_t)k;
            cnt[q] += __popc(hm);
            const unsigned long long bale = __ballot(eqv);
            if (bale) {
                const unsigned he = (unsigned)(bale >> (32 * hi));
                const int c = ccn[q] + __popc(he & ((1u << r32) - 1u));
                if (eqv && c < IX_CAP) { cand_s[row * IX_CAP + c] = sv; cand_k[row * IX_CAP + c] = (bf16_t)k; }
                ccn[q] += __popc(he);
            }
        }
    }
}
template <int MODE, bool LAST>
DEVINL void ix_chunk(const bf16x8 (&af)[4], const f32x4 (&cv)[4], const char* buf, int t0, int kt0, int ktend, int (&B0r)[2], int (&cnt)[2], int (&ccn)[2], IxMeta* meta, char* lds, int round) {
    const int lane = threadIdx.x & 63, r32 = lane & 31, hi = lane >> 5;
    bf16x8 bfa[4], bfb[4];
#pragma unroll
    for (int s = 0; s < 4; ++s) bfa[s] = *(const bf16x8*)(buf + swz128(r32, 2 * s + hi));
#pragma unroll
    for (int s = 0; s < 4; ++s) bfb[s] = *(const bf16x8*)(buf + swz128(32 + r32, 2 * s + hi));
    f32x16 acc = ix_mma(af, bfa);
#pragma unroll
    for (int t8 = 0; t8 < 8; ++t8) {
        if (!LAST || t8 < ktend) {
            const f32x16 accn = ix_mma(af, bfb);
            if (t8 + 2 < 8) {
#pragma unroll
                for (int s = 0; s < 4; ++s) bfb[s] = *(const bf16x8*)(buf + swz128(32 * (t8 + 2) + r32, 2 * s + hi));
            }
            ix_tile<MODE, LAST>(acc, cv, t0, kt0 + t8, B0r, cnt, ccn, meta, lds, round);
            acc = accn;
        }
    }
}
template <int MODE>
DEVINL void ix_pass(const bf16x8 (&af)[4], const f32x4 (&cv)[4], const bf16_t* IK, int t0, int nkt, int (&B0r)[2], int (&cnt)[2], int (&ccn)[2], IxMeta* meta, char* lds, int round) {
    const int tid = threadIdx.x;
    const int lc = tid & 7, lr = tid >> 3;
    const int nch = (nkt + 7) >> 3;
    u32x4 st[4];
#pragma unroll
    for (int j = 0; j < 4; ++j) st[j] = *(const u32x4*)(IK + (size_t)(lr + 64 * j) * 64 + lc * 8);
#pragma unroll
    for (int j = 0; j < 4; ++j) *(u32x4*)(lds + IXL_STAGE + swz128(lr + 64 * j, lc)) = st[j];
    __syncthreads();
#pragma unroll 1
    for (int ch = 0; ch < nch; ++ch) {
        const char* buf = lds + IXL_STAGE + (ch & 1) * 32768;
        if (ch + 1 < nch) {
#pragma unroll
            for (int j = 0; j < 4; ++j) st[j] = *(const u32x4*)(IK + (size_t)(256 * (ch + 1) + lr + 64 * j) * 64 + lc * 8);
            ix_chunk<MODE, false>(af, cv, buf, t0, 8 * ch, 8, B0r, cnt, ccn, meta, lds, round);
            char* nb = lds + IXL_STAGE + ((ch + 1) & 1) * 32768;
#pragma unroll
            for (int j = 0; j < 4; ++j) *(u32x4*)(nb + swz128(lr + 64 * j, lc)) = st[j];
        } else {
            ix_chunk<MODE, true>(af, cv, buf, t0, 8 * ch, nkt - 8 * ch, B0r, cnt, ccn, meta, lds, round);
        }
        __syncthreads();
    }
}
DEVINL void indexer_item(const Params& p, char* lds, int item) {
    const int tid = threadIdx.x, lane = tid & 63, wave = tid >> 6, r32 = lane & 31, hi = lane >> 5;
    const int b = item >> 8, u = item & 255, qt = (b & 1) ? u : 255 - u, t0 = qt * 32;
    bf16_t* IDX = (bf16_t*)(p.ws + WS_IDX) + ((size_t)b * SEQ + t0) * 256;
    if (t0 < 256) {
#pragma unroll 1
        for (int rr = 0; rr < 4; ++rr) {
            const int row = 4 * wave + rr, n = t0 + row + 1;
#pragma unroll
            for (int k = 0; k < 4; ++k) { const int i = lane + 64 * k; IDX[row * 256 + i] = (bf16_t)(i < n ? i : 0xFFFF); }
        }
        return;
    }
    IxMeta* meta = (IxMeta*)(lds + IXL_META);
    unsigned* hist = (unsigned*)(lds + IXL_HIST);
    __syncthreads();
    if (tid < 32) { meta->need[tid] = 256; meta->nr[tid] = 0; meta->done[tid] = 0; meta->ccnt[tid] = 0; meta->lo[0][tid] = -4.f; meta->sc[0][tid] = 64.f; }
    const bf16_t* IQ = (const bf16_t*)(p.ws + WS_IQ) + ((size_t)b * SEQ + t0) * 512;
    const bf16_t* IK = (const bf16_t*)(p.ws + WS_IK) + (size_t)b * SEQ * 64;
    const float* IW = (const float*)(p.ws + WS_IW) + ((size_t)b * SEQ + t0) * 8;
    bf16x8 af[4]; f32x4 cv[4];
#pragma unroll
    for (int s = 0; s < 4; ++s) af[s] = *(const bf16x8*)(IQ + (size_t)(4 * wave + (r32 >> 3)) * 512 + (r32 & 7) * 64 + 16 * s + 8 * hi);
#pragma unroll
    for (int j = 0; j < 4; ++j) cv[j] = *(const f32x4*)(IW + (size_t)(4 * wave + j) * 8 + 4 * hi);
    int B0r[2] = {0, 0}, cnt[2] = {0, 0}, ccn[2] = {0, 0};
    const int nkt = (t0 + 32) / 32;
#pragma unroll 1
    for (int round = 0; round < 4; ++round) {
#pragma unroll
        for (int k = 0; k < 8; ++k) *(u32x4*)(lds + IXL_HIST + (tid + 512 * k) * 16) = (u32x4){0u, 0u, 0u, 0u};
        if (tid == 0) meta->flag = 0;
        __syncthreads();
        if (round == 0) ix_pass<0>(af, cv, IK, t0, nkt, B0r, cnt, ccn, meta, lds, 0);
        else ix_pass<2>(af, cv, IK, t0, nkt, B0r, cnt, ccn, meta, lds, round);
#pragma unroll 1
        for (int rr = 0; rr < 4; ++rr) {
            const int row = 4 * wave + rr;
            if (meta->done[row]) continue;
            const int need = meta->need[row];
            const u32x4 h0 = *(const u32x4*)(hist + row * 512 + 8 * lane), h1 = *(const u32x4*)(hist + row * 512 + 8 * lane + 4);
            const unsigned c = ((h0[0] + h0[1]) + (h0[2] + h0[3])) + ((h1[0] + h1[1]) + (h1[2] + h1[3]));
            unsigned suf = c;
#pragma unroll
            for (int o = 1; o < 64; o <<= 1) { const unsigned tv = __shfl_down(suf, o); if (lane + o < 64) suf += tv; }
            const unsigned long long bal = __ballot(suf >= (unsigned)need);
            const int Ls = bal ? 63 - __builtin_clzll(bal) : 0;
            const unsigned sufL = __shfl(suf, Ls), cL = __shfl(c, Ls);
            unsigned cum = sufL - cL; int Bs = 8 * Ls; unsigned cb = 0; bool found = false;
#pragma unroll 1
            for (int e = 7; e >= 0; --e) {
                const unsigned hv = hist[row * 512 + 8 * Ls + e];
                if (!found) { if (cum + hv >= (unsigned)need) { Bs = 8 * Ls + e; cb = hv; found = true; } else cum += hv; }
            }
            if (lane == 0) {
                meta->B[round][row] = Bs; meta->need[row] = need - (int)cum; meta->nr[row] = round + 1;
                if (cb > (unsigned)IX_CAP && round < 3) {
                    const float lo = meta->lo[round][row], sc = meta->sc[round][row];
                    if (Bs == 511) { meta->sc[round + 1][row] = sc * 0.0625f; meta->lo[round + 1][row] = lo + 511.f / sc; }
                    else if (Bs == 0) { meta->sc[round + 1][row] = sc * 0.0625f; meta->lo[round + 1][row] = lo + 1.f / sc - 8192.f / sc; }
                    else { meta->sc[round + 1][row] = sc * 512.f; meta->lo[round + 1][row] = lo + (float)Bs / sc; }
                    meta->flag = 1;
                }
                else meta->done[row] = 1;
            }
        }
        __syncthreads();
        const int more = meta->flag;
        __syncthreads();
        if (!more) break;
    }
#pragma unroll
    for (int q = 0; q < 2; ++q) { const int row = 4 * wave + 2 * hi + q; B0r[q] = meta->B[0][row] | (meta->nr[row] > 1 ? 0x10000 : 0); }
    ix_pass<1>(af, cv, IK, t0, nkt, B0r, cnt, ccn, meta, lds, 0);
    if (r32 == 0) {
#pragma unroll
        for (int q = 0; q < 2; ++q) { meta->lcnt[4 * wave + 2 * hi + q] = cnt[q] < 256 ? cnt[q] : 256; meta->ccnt[4 * wave + 2 * hi + q] = ccn[q]; }
    }
    LDS_WAIT();
    {
        const float* cand_s = (const float*)(lds + IXL_CAND);
        const bf16_t* cand_k = (const bf16_t*)(lds + IXL_CANDK);
#pragma unroll 1
        for (int rr = 0; rr < 4; ++rr) {
            const int row = 4 * wave + rr;
            const int c = meta->lcnt[row];
            for (int i = lane; i < c; i += 64) IDX[row * 256 + i] = *(const bf16_t*)(lds + IXL_HIST + row * 2048 + i * 2);
            const int m = meta->ccnt[row] < IX_CAP ? meta->ccnt[row] : IX_CAP, r = meta->need[row], base = 256 - r;
            for (int i = lane; i < m; i += 64) {
                const float si = cand_s[row * IX_CAP + i]; const int ki = cand_k[row * IX_CAP + i];
                int rank = 0;
                for (int j = 0; j < m; ++j) { const float sj = cand_s[row * IX_CAP + j]; const int kj = cand_k[row * IX_CAP + j]; rank += (sj > si || (sj == si && kj < ki)) ? 1 : 0; }
                if (rank < r) IDX[row * 256 + base + rank] = (bf16_t)ki;
            }
        }
    }
    __syncthreads();
}

DEVINL float dot2bf(unsigned a, unsigned b, float c) {
    typedef __bf16 bf2 __attribute__((ext_vector_type(2)));
    return __builtin_amdgcn_fdot2_f32_bf16(__builtin_bit_cast(bf2, a), __builtin_bit_cast(bf2, b), c, false);
}
typedef float f32x2 __attribute__((ext_vector_type(2)));
DEVINL void dsa_item(const Params& p, char* lds, int item) {
    const int tid = threadIdx.x, lane = tid & 63, wave = tid >> 6, ks = lane >> 2, j = lane & 3;
    const int pair = (item & 7) + 8 * (item >> 8), chunk = (item >> 3) & 31;
    const int b = pair / HB, h = pair % HB;
    float* lut = (float*)lds;
    float* pbuf = (float*)(lds + 512) + wave * 256;
    __syncthreads();
    build_lut(lut, p.rel_bias, 6 + h);
    __syncthreads();
    bf16_t* QB = (bf16_t*)(p.ws + WS_ACT8 + 4 * ACT_STRIDE);
    const unsigned char* KB8 = (const unsigned char*)(p.ws + WS_ACT8 + 5 * ACT_STRIDE) + (size_t)b * SEQ * 384 + h * 64 + 16 * j;
    const unsigned char* VB8 = (const unsigned char*)(p.ws + WS_ACT8 + 6 * ACT_STRIDE) + (size_t)b * SEQ * 384 + h * 64 + 16 * j;
    const bf16_t* ZB = (const bf16_t*)(p.ws + WS_ACT8 + 7 * ACT_STRIDE);
    const bf16_t* IDX = (const bf16_t*)(p.ws + WS_IDX);
    const int dim = 16 * j + ks;
    const int t_first = chunk * 256 + wave * 32;
    u32x4 q_n[2], iv_n[2]; int myk_n[4]; bf16_t z_n;
    {
        const size_t row = (size_t)b * SEQ + t_first;
        const bf16_t* irow = IDX + row * 256 + ks * 16;
        q_n[0] = *(const u32x4*)(QB + row * 384 + h * 64 + 16 * j); q_n[1] = *(const u32x4*)(QB + row * 384 + h * 64 + 16 * j + 8);
        iv_n[0] = *(const u32x4*)irow; iv_n[1] = *(const u32x4*)(irow + 8);
#pragma unroll
        for (int bt = 0; bt < 4; ++bt) myk_n[bt] = irow[4 * bt + j];
        z_n = ZB[row * 384 + h * 64 + dim];
    }
#pragma unroll 1
    for (int qi = 0; qi < 32; ++qi) {
        const int t = t_first + qi;
        const size_t row = (size_t)b * SEQ + t;
        f32x2 q2[8];
#pragma unroll
        for (int c = 0; c < 2; ++c)
#pragma unroll
            for (int e = 0; e < 4; ++e) { q2[4 * c + e].x = bf_lo(q_n[c][e]); q2[4 * c + e].y = bf_hi(q_n[c][e]); }
        unsigned iw[8]; int myk[4]; const bf16_t zc = z_n;
#pragma unroll
        for (int e = 0; e < 4; ++e) { iw[e] = iv_n[0][e]; iw[4 + e] = iv_n[1][e]; myk[e] = myk_n[e]; }
        {
            const size_t rown = row + (qi + 1 < 32 ? 1 : 0);
            const bf16_t* irow = IDX + rown * 256 + ks * 16;
            q_n[0] = *(const u32x4*)(QB + rown * 384 + h * 64 + 16 * j); q_n[1] = *(const u32x4*)(QB + rown * 384 + h * 64 + 16 * j + 8);
            iv_n[0] = *(const u32x4*)irow; iv_n[1] = *(const u32x4*)(irow + 8);
#pragma unroll
            for (int bt = 0; bt < 4; ++bt) myk_n[bt] = irow[4 * bt + j];
            z_n = ZB[rown * 384 + h * 64 + dim];
        }
        float lg[4];
#pragma unroll
        for (int bt = 0; bt < 4; ++bt) {
            float part[4];
#pragma unroll
            for (int i = 0; i < 4; ++i) {
                const int L = 4 * bt + i;
                const unsigned w = (L & 1) ? (iw[L >> 1] >> 16) : (iw[L >> 1] & 0xffffu);
                const int key = w == 0xFFFFu ? 0 : (int)w;
                const u32x4 kv = *(const u32x4*)(KB8 + (size_t)key * 384);
                f32x2 a2 = {0.f, 0.f};
#pragma unroll
                for (int d = 0; d < 4; ++d) {
                    a2 += __builtin_amdgcn_cvt_pk_f32_fp8((int)kv[d], false) * q2[2 * d];
                    a2 += __builtin_amdgcn_cvt_pk_f32_fp8((int)kv[d], true) * q2[2 * d + 1];
                }
                part[i] = a2.x + a2.y;
            }
            float v2[2];
#pragma unroll
            for (int a = 0; a < 2; ++a) { const float keep = (j & 2) ? part[2 + a] : part[a], send = (j & 2) ? part[a] : part[2 + a]; v2[a] = keep + dppf<0x4E>(send); }
            { const float keep = (j & 1) ? v2[1] : v2[0], send = (j & 1) ? v2[0] : v2[1]; lg[bt] = keep + dppf<0xB1>(send); }
        }
        float mx = -INFINITY;
#pragma unroll
        for (int bt = 0; bt < 4; ++bt) {
            const int d = t - myk[bt];
            lg[bt] = (myk[bt] == 0xFFFF || d < 0) ? -INFINITY : lg[bt] + lut[d > 127 ? 127 : d];
            mx = fmaxf(mx, lg[bt]);
        }
        mx = wave_max_dpp(mx);
        float ls = 0.f;
#pragma unroll
        for (int bt = 0; bt < 4; ++bt) { lg[bt] = fexp2(lg[bt] - mx); ls += lg[bt]; pbuf[ks * 16 + 4 * bt + j] = lg[bt]; }
        ls = wave_sum_dpp(ls);
        LDS_WAIT();
        f32x2 acc2[8];
#pragma unroll
        for (int e = 0; e < 8; ++e) acc2[e] = (f32x2){0.f, 0.f};
#pragma unroll
        for (int k4 = 0; k4 < 4; ++k4) {
            const f32x4 pv = *(const f32x4*)(pbuf + ks * 16 + 4 * k4);
#pragma unroll
            for (int i = 0; i < 4; ++i) {
                const int L = 4 * k4 + i;
                const unsigned w = (L & 1) ? (iw[L >> 1] >> 16) : (iw[L >> 1] & 0xffffu);
                const int key = w == 0xFFFFu ? 0 : (int)w;
                const u32x4 vv = *(const u32x4*)(VB8 + (size_t)key * 384);
                const float pk = pv[i];
#pragma unroll
                for (int d = 0; d < 4; ++d) {
                    acc2[2 * d] += __builtin_amdgcn_cvt_pk_f32_fp8((int)vv[d], false) * pk;
                    acc2[2 * d + 1] += __builtin_amdgcn_cvt_pk_f32_fp8((int)vv[d], true) * pk;
                }
            }
        }
        LDS_WAIT();
        float a16[16];
#pragma unroll
        for (int e = 0; e < 8; ++e) { a16[2 * e] = acc2[e].x; a16[2 * e + 1] = acc2[e].y; }
        float a8[8];
#pragma unroll
        for (int a = 0; a < 8; ++a) { const float keep = (ks & 8) ? a16[8 + a] : a16[a], send = (ks & 8) ? a16[a] : a16[8 + a]; a8[a] = keep + xor32f(send); }
        float a4[4];
#pragma unroll
        for (int a = 0; a < 4; ++a) { const float keep = (ks & 4) ? a8[4 + a] : a8[a], send = (ks & 4) ? a8[a] : a8[4 + a]; a4[a] = keep + __shfl_xor(send, 16); }
        float a2r[2];
#pragma unroll
        for (int a = 0; a < 2; ++a) { const float keep = (ks & 2) ? a4[2 + a] : a4[a], send = (ks & 2) ? a4[a] : a4[2 + a]; a2r[a] = keep + dppf<0x128>(send); }
        float a1;
        { const float keep = (ks & 1) ? a2r[1] : a2r[0], send = (ks & 1) ? a2r[0] : a2r[1]; a1 = keep + __shfl_xor(send, 4); }
        QB[row * 384 + h * 64 + dim] = (bf16_t)(cvtpk(a1 * frcp(ls) * bf2f(zc), 0.f) & 0xffffu);
    }
}

struct KvRegs { u32x4 kk[4], vv[4]; };
DEVINL void kv_issue(KvRegs& r, const bf16_t* __restrict__ Kg, const bf16_t* __restrict__ Vg, int ld) {
    const int tid = threadIdx.x, c = tid & 7, kr = tid >> 3;
#pragma unroll
    for (int j = 0; j < 4; ++j) { r.kk[j] = *(const u32x4*)(Kg + (size_t)(kr + 64 * j) * ld + c * 8); r.vv[j] = *(const u32x4*)(Vg + (size_t)(kr + 64 * j) * ld + c * 8); }
}
DEVINL void kv_commit(const KvRegs& r, char* lds) {
    const int tid = threadIdx.x, c = tid & 7, kr = tid >> 3;
#pragma unroll
    for (int j = 0; j < 4; ++j) {
        const int key = kr + 64 * j;
        *(u32x4*)(lds + AT_K + swz128(key, c)) = r.kk[j];
        *(u32x4*)(lds + AT_V + (c >> 2) * AT_VPLANE + key * 64 + (c & 3) * 16) = r.vv[j];
    }
}
constexpr int MB_LUT = AT_END, MB_WSF = AT_END + 3072, MB_ENT = MB_WSF + 1024, MB_OSTG = MB_ENT + 512, MB_PRE = MB_OSTG + 8 * 4096, MB_END = MB_PRE + 3072;
struct MobaItem { int b, h, n, c, cnt, near; };
DEVINL bool moba_decode(const unsigned* pre, const unsigned* ctl, int ri, int total, MobaItem& it) {
    if (ri >= total) return false;
    int lo = 0, hi2 = 744;
    while (hi2 - lo > 1) { const int mid = (lo + hi2) >> 1; if ((int)pre[mid] <= ri) lo = mid; else hi2 = mid; }
    const int bh = lo / 31; it.b = bh / HA; it.h = bh % HA; it.n = lo % 31;
    const int c = ri - (int)pre[lo], far = (int)ctl[bh * 32 + it.n], nf = (far + 255) >> 8;
    if (c < nf) { it.c = c; it.cnt = far; it.near = 0; } else { it.c = c - nf; it.cnt = (int)ctl[768 + bh * 32 + it.n]; it.near = 1; }
    return true;
}
DEVINL void moba_past_compute(const Params& p, char* lds, const MobaItem& it) {
    const int tid = threadIdx.x, lane = tid & 63, wave = tid >> 6, r32 = lane & 31, hi = lane >> 5;
    const float* lut = (const float*)(lds + MB_LUT) + it.h * 128;
    float* wsf = (float*)(lds + MB_WSF) + wave * 32;
    const bf16_t* ent = (const bf16_t*)(lds + MB_ENT);
    char* ostg = lds + MB_OSTG + wave * 4096;
    const int b = it.b, h = it.h, n = it.n;
    const int nvalid = it.cnt - it.c * 256 < 256 ? it.cnt - it.c * 256 : 256;
    if (wave * 32 < nvalid) {
        const int e = ent[wave * 32 + r32], t_row = e & 8191;
        const bf16_t* QA = (const bf16_t*)(p.ws + WS_ACT8);
        bf16x8 qf[4];
#pragma unroll
        for (int s = 0; s < 4; ++s) qf[s] = *(const bf16x8*)(QA + ((size_t)b * SEQ + t_row) * 384 + h * 64 + 16 * s + 8 * hi);
        AttnState st;
        float lse_add = 0.f;
        if (it.near) attn_256<1>(qf, lds, t_row, n * 256, lut, wsf, st);
        else { attn_256<0>(qf, lds, t_row, n * 256, lut, wsf, st); lse_add = lut[127]; }
        const float ltot = half_sum(st.l);
        float rl[16]; rows_to_regs(frcp(ltot), wsf, rl);
#pragma unroll
        for (int r = 0; r < 16; ++r) {
            *(bf16_t*)(ostg + crow(r, hi) * 128 + r32 * 2) = (bf16_t)(cvtpk(st.o0[r] * rl[r], 0.f) & 0xffffu);
            *(bf16_t*)(ostg + crow(r, hi) * 128 + (32 + r32) * 2) = (bf16_t)(cvtpk(st.o1[r] * rl[r], 0.f) & 0xffffu);
        }
        LDS_WAIT();
        bf16_t* PO = (bf16_t*)((char*)p.out + OUT_PO);
        float* PL = (float*)((char*)p.out + OUT_PL);
        if (hi == 0 && wave * 32 + r32 < nvalid) PL[(((size_t)b * SEQ + t_row) * HA + h) * 4 + (e >> 13)] = st.mhat + __builtin_amdgcn_logf(ltot) + lse_add;
#pragma unroll
        for (int i = 0; i < 4; ++i) {
            const int row = i * 8 + (lane >> 3), ch = lane & 7;
            if (wave * 32 + row < nvalid) {
                const int e2 = ent[wave * 32 + row];
                *(u32x4*)(PO + ((((size_t)b * SEQ + (e2 & 8191)) * HA + h) * 4 + (e2 >> 13)) * 64 + ch * 8) = *(const u32x4*)(ostg + row * 128 + ch * 16);
            }
        }
    }
}
DEVINL void moba_issue(const Params& p, const MobaItem& it, KvRegs& kv, int& entv) {
    const int tid = threadIdx.x;
    const size_t r0 = ((size_t)it.b * SEQ + it.n * 256) * 384 + it.h * 64;
    kv_issue(kv, (const bf16_t*)(p.ws + WS_ACT8 + 1 * ACT_STRIDE) + r0, (const bf16_t*)(p.ws + WS_ACT8 + 2 * ACT_STRIDE) + r0, 384);
    const bf16_t* Lb = (const bf16_t*)(p.ws + WS_LIST) + (size_t)(it.b * HA + it.h) * LIST_PER_BH;
    const int nvalid = it.cnt - it.c * 256 < 256 ? it.cnt - it.c * 256 : 256;
    const int i = tid < nvalid ? tid : 0;
    entv = tid < 256 ? (int)(it.near ? Lb[list_off(it.n + 1) - 1 - (it.c * 256 + i)] : Lb[list_off(it.n) + it.c * 256 + i]) : 0;
}
DEVINL void phase3(const Params& p, char* lds) {
    for (int it = blockIdx.x; it < 768; it += gridDim.x) dsa_item(p, lds, it);
    const unsigned* ctl = (const unsigned*)(p.ws + WS_CTL);
    unsigned* pre = (unsigned*)(lds + MB_PRE);
    __syncthreads();
    for (int i = threadIdx.x; i < 744; i += NTHR) pre[i + 1] = ((ctl[(i / 31) * 32 + (i % 31)] + 255u) >> 8) + ((ctl[768 + (i / 31) * 32 + (i % 31)] + 255u) >> 8);
    for (int i = threadIdx.x; i < HA * 128; i += NTHR) ((float*)(lds + MB_LUT))[i] = p.rel_bias[rel_bucket(i & 127) * 12 + (i >> 7)] * LOG2E;
    __syncthreads();
    if (threadIdx.x == 0) { unsigned a = 0; pre[0] = 0; for (int i = 1; i <= 744; ++i) { a += pre[i]; pre[i] = a; } }
    __syncthreads();
    const int total = (int)pre[744];
    bf16_t* ent = (bf16_t*)(lds + MB_ENT);
    MobaItem cur, nxt; KvRegs kv; int entv = 0;
    bool have = moba_decode(pre, ctl, blockIdx.x, total, cur);
    if (have) { moba_issue(p, cur, kv, entv); kv_commit(kv, lds); if (threadIdx.x < 256) ent[threadIdx.x] = (bf16_t)entv; }
    __syncthreads();
    for (int ri = blockIdx.x; have; ri += gridDim.x) {
        const bool hn = moba_decode(pre, ctl, ri + gridDim.x, total, nxt);
        if (hn) moba_issue(p, nxt, kv, entv);
        moba_past_compute(p, lds, cur);
        __syncthreads();
        if (hn) { kv_commit(kv, lds); if (threadIdx.x < 256) ent[threadIdx.x] = (bf16_t)entv; }
        __syncthreads();
        cur = nxt; have = hn;
    }
}
DEVINL void moba_own_item(const Params& p, char* lds, int item) {
    const int tid = threadIdx.x, lane = tid & 63, wave = tid >> 6, r32 = lane & 31, hi = lane >> 5;
    const int b = item / (HA * 32), h = (item / 32) % HA, n = item % 32;
    float* lut = (float*)(lds + AT_END);
    float* wsf = (float*)(lds + AT_END + 512) + wave * 32;
    float* lse_own = (float*)(lds + AT_END + 1536);
    float* oown = (float*)lds;
    __syncthreads();
    build_lut(lut, p.rel_bias, h);
    const size_t row0 = (size_t)b * SEQ + n * 256;
    load_kv_block((const bf16_t*)(p.ws + WS_ACT8 + 1 * ACT_STRIDE) + row0 * 384 + h * 64, (const bf16_t*)(p.ws + WS_ACT8 + 2 * ACT_STRIDE) + row0 * 384 + h * 64, 384, lds);
    bf16_t* QA = (bf16_t*)(p.ws + WS_ACT8);
    const int t_row = n * 256 + wave * 32 + r32;
    bf16x8 qf[4];
#pragma unroll
    for (int s = 0; s < 4; ++s) qf[s] = *(const bf16x8*)(QA + ((size_t)b * SEQ + t_row) * 384 + h * 64 + 16 * s + 8 * hi);
    __syncthreads();
    AttnState st;
    attn_256<1>(qf, lds, t_row, n * 256, lut, wsf, st);
    const float ltot = half_sum(st.l);
    float rl[16]; rows_to_regs(frcp(ltot), wsf, rl);
    __syncthreads();
    if (hi == 0) lse_own[wave * 32 + r32] = st.mhat + __builtin_amdgcn_logf(ltot);
#pragma unroll
    for (int r = 0; r < 16; ++r) {
        oown[(wave * 32 + crow(r, hi)) * 64 + r32] = st.o0[r] * rl[r];
        oown[(wave * 32 + crow(r, hi)) * 64 + 32 + r32] = st.o1[r] * rl[r];
    }
    __syncthreads();
    const bf16_t* PO = (const bf16_t*)((const char*)p.out + OUT_PO);
    const float* PL = (const float*)((const char*)p.out + OUT_PL);
    const bf16_t* ZA = (const bf16_t*)(p.ws + WS_ACT8 + 3 * ACT_STRIDE);
    const int nsel = n < 3 ? n : 3;
#pragma unroll 1
    for (int k = 0; k < 4; ++k) {
        const int task = tid + 512 * k, row = task >> 3, ch = task & 7;
        const size_t grow = row0 + row;
        const float lo = lse_own[row];
        float ls[3]; float M = lo;
#pragma unroll
        for (int s = 0; s < 3; ++s) { ls[s] = (s < nsel) ? PL[(grow * HA + h) * 4 + s] : -INFINITY; M = fmaxf(M, ls[s]); }
        const float w_own = fexp2(lo - M);
        float wsum = w_own, o[8];
#pragma unroll
        for (int e = 0; e < 8; ++e) o[e] = w_own * oown[row * 64 + ch * 8 + e];
#pragma unroll
        for (int s = 0; s < 3; ++s) {
            if (s < nsel) {
                const float w = fexp2(ls[s] - M); wsum += w;
                const u32x4 pv = *(const u32x4*)(PO + ((grow * HA + h) * 4 + s) * 64 + ch * 8);
                o[0] += w * bf_lo(pv.x); o[1] += w * bf_hi(pv.x); o[2] += w * bf_lo(pv.y); o[3] += w * bf_hi(pv.y);
                o[4] += w * bf_lo(pv.z); o[5] += w * bf_hi(pv.z); o[6] += w * bf_lo(pv.w); o[7] += w * bf_hi(pv.w);
            }
        }
        const float inv = frcp(wsum);
        const u32x4 zv = *(const u32x4*)(ZA + grow * 384 + h * 64 + ch * 8);
        u32x4 w;
        w.x = cvtpk(o[0] * inv * bf_lo(zv.x), o[1] * inv * bf_hi(zv.x)); w.y = cvtpk(o[2] * inv * bf_lo(zv.y), o[3] * inv * bf_hi(zv.y));
        w.z = cvtpk(o[4] * inv * bf_lo(zv.z), o[5] * inv * bf_hi(zv.z)); w.w = cvtpk(o[6] * inv * bf_lo(zv.w), o[7] * inv * bf_hi(zv.w));
        *(u32x4*)(QA + grow * 384 + h * 64 + ch * 8) = w;
    }
    __syncthreads();
}

DEVINL void phase2(const Params& p, char* lds) {
    for (int it = blockIdx.x; it < NB * 256; it += gridDim.x) indexer_item(p, lds, it);
    __syncthreads();
    for (int it = blockIdx.x; it < NB * HA * 16; it += gridDim.x) moba_select_item(p, lds, it);
    for (int it = blockIdx.x; it < NB * HM * 32; it += gridDim.x) mem_attn_item(p, lds, it);
}
DEVINL void phase4(const Params& p, char* lds) {
    for (int it = blockIdx.x; it < NB * HA * 32; it += gridDim.x) moba_own_item(p, lds, it);
}


#define XB_TMO      128
#define XB_XCNT(j)  (256  + 64 * (j))
#define XB_XSUB(j)  (1280 + 64 * (j))
#define XB_XGEN(j)  (2304 + 64 * (j))
#define XB_TOP      3328
#define XB_TOPGEN   3392
#define XB_SPIN_CAP (1u << 22)
DEVINL unsigned xb_ld(unsigned* p)              { return __hip_atomic_load(p, __ATOMIC_RELAXED, __HIP_MEMORY_SCOPE_AGENT); }
DEVINL unsigned xb_add(unsigned* p, unsigned v) { return __hip_atomic_fetch_add(p, v, __ATOMIC_RELAXED, __HIP_MEMORY_SCOPE_AGENT); }
DEVINL unsigned xb_xcc_id() { return (unsigned)__builtin_amdgcn_s_getreg((3 << 11) | 20) & 0xFu; }
#define XB_SPIN(cond, bar) do { unsigned _sp = 0; while (cond) { __builtin_amdgcn_s_sleep(1); \
    if ((++_sp & 255u) == 0u) { if (xb_ld(&(bar)[XB_TMO])) break; if (_sp > XB_SPIN_CAP) { atomicAdd(&(bar)[XB_TMO], 1u); break; } } } } while (0)
struct XcdBarrier { unsigned* bar; unsigned x; volatile LAS unsigned* st; };
DEVINL XcdBarrier xcd_barrier_post(unsigned* bar, volatile LAS unsigned* st) {
    XcdBarrier b; b.bar = bar; b.x = xb_xcc_id(); b.st = st;
    if (threadIdx.x == 0) (void)xb_add(&bar[XB_XCNT(b.x)], 1u);
    return b;
}
DEVINL void xcd_barrier_complete(unsigned* bar, unsigned x, unsigned& nloc, unsigned& nx) {
    const unsigned G = gridDim.x * gridDim.y * gridDim.z;
    unsigned sum, cnt, mine, sp = 0u;
    for (;;) {
        sum = 0u; cnt = 0u; mine = 0u;
#pragma unroll
        for (unsigned j = 0; j < 16; ++j) { const unsigned c = xb_ld(&bar[XB_XCNT(j)]); sum += c; cnt += (c > 0u) ? 1u : 0u; mine = (j == x) ? c : mine; }
        if (sum == G) break;
        __builtin_amdgcn_s_sleep(1);
        if ((++sp & 255u) == 0u) { if (xb_ld(&bar[XB_TMO])) break; if (sp > XB_SPIN_CAP) { atomicAdd(&bar[XB_TMO], 1u); break; } }
    }
    nloc = mine > 0u ? mine : 1u; nx = cnt > 0u ? cnt : 1u;
}
DEVINL void xcd_barrier(const XcdBarrier& b) {
    asm volatile("s_waitcnt vmcnt(0)" ::: "memory");
    __syncthreads();
    if (threadIdx.x == 0) {
        unsigned* bar = b.bar;
        __builtin_amdgcn_s_waitcnt(0);
        unsigned nloc = b.st[0], nx = b.st[1];
        if (nloc == 0u) { xcd_barrier_complete(bar, b.x, nloc, nx); b.st[0] = nloc; b.st[1] = nx; }
        const unsigned old = xb_add(&bar[XB_XSUB(b.x)], 1u);
        const unsigned gen = old / nloc;
        if (old + 1u == (gen + 1u) * nloc) {
            __builtin_amdgcn_fence(__ATOMIC_RELEASE, "agent");
            asm volatile("s_waitcnt vmcnt(0)" ::: "memory");
            const unsigned og = xb_add(&bar[XB_TOP], 1u);
            const unsigned tg = og / nx;
            if (og + 1u == (tg + 1u) * nx) xb_add(&bar[XB_TOPGEN], 1u);
            else XB_SPIN(xb_ld(&bar[XB_TOPGEN]) == tg, bar);
            __builtin_amdgcn_fence(__ATOMIC_ACQUIRE, "agent");
            xb_add(&bar[XB_XGEN(b.x)], 1u);
            asm volatile("s_waitcnt vmcnt(0)" ::: "memory");
        } else {
            XB_SPIN(xb_ld(&bar[XB_XGEN(b.x)]) == gen, bar);
            __builtin_amdgcn_fence(__ATOMIC_ACQUIRE, "agent");
            asm volatile("s_waitcnt vmcnt(0)" ::: "memory");
        }
    }
    __syncthreads();
}

constexpr int LDS_BYTES = IXL_END + 64, LDS_XB = IXL_END;
#define KERNEL_PROLOGUE __shared__ __attribute__((aligned(16))) char lds[LDS_BYTES];
#ifdef MULTI_LAUNCH
__global__ void __launch_bounds__(NTHR) k_phase0(Params p) { KERNEL_PROLOGUE phase0(p, lds); }
__global__ void __launch_bounds__(NTHR) k_phase1(Params p) { KERNEL_PROLOGUE phase1(p, lds); }
__global__ void __launch_bounds__(NTHR) k_phase2(Params p) { KERNEL_PROLOGUE phase2(p, lds); }
__global__ void __launch_bounds__(NTHR) k_phase3(Params p) { KERNEL_PROLOGUE phase3(p, lds); }
__global__ void __launch_bounds__(NTHR) k_phase4(Params p) { KERNEL_PROLOGUE phase4(p, lds); }
__global__ void __launch_bounds__(NTHR) k_phase5(Params p) { KERNEL_PROLOGUE phase_gates(p, lds); }
__global__ void __launch_bounds__(NTHR) k_phase6(Params p) { KERNEL_PROLOGUE phase_merge(p, lds); }
__global__ void __launch_bounds__(NTHR) k_phase7(Params p) { KERNEL_PROLOGUE phase_out(p, lds); }
__global__ void __launch_bounds__(NTHR) k_phase8(Params p) { phase_final(p); }
#else
__global__ void __launch_bounds__(NTHR) k_mega(Params p) {
    KERNEL_PROLOGUE
    cg::grid_group grid = cg::this_grid();
#ifdef PROBE_A
    int nst = 0;
#define STAMP() do { if (blockIdx.x == 0 && threadIdx.x == 0) ((unsigned*)(p.ws + WS_CTL))[4096 + nst] = (unsigned)__builtin_amdgcn_s_memrealtime(); ++nst; } while (0)
#else
#define STAMP() do { } while (0)
#endif
    volatile LAS unsigned* xst = (volatile LAS unsigned*)(LAS char*)(uintptr_t)(unsigned)(uintptr_t)(lds + LDS_XB);
    if (threadIdx.x == 0) { xst[0] = 0u; xst[1] = 0u; }
    __syncthreads();
    phase0(p, lds);      grid.sync();
    const XcdBarrier bar = xcd_barrier_post((unsigned*)(p.ws + WS_CTL) + CTL_XBAR, xst);
    phase1(p, lds);      xcd_barrier(bar);
    phase2(p, lds);      xcd_barrier(bar);
    phase3(p, lds);      xcd_barrier(bar);
    phase4(p, lds);      xcd_barrier(bar);
    phase_merge(p, lds); xcd_barrier(bar);
    phase_out(p, lds);   xcd_barrier(bar);
    phase_final(p);
}
#endif

extern "C" void kernel_launch(void* const* d_in, const int* in_sizes, int n_in, void* d_out, int out_size, void* d_ws, size_t ws_size, hipStream_t stream) {
    Params p{};
    p.x = (const float*)d_in[0]; p.mem = (const float*)d_in[1]; p.norm_gain = (const float*)d_in[2]; p.w_in = (const float*)d_in[3];
    p.rel_bias = (const float*)d_in[4]; p.mem_gain = (const float*)d_in[5]; p.w_mem_kv = (const float*)d_in[6]; p.w_branch = (const float*)d_in[7];
    p.w_out = (const float*)d_in[8]; p.final_gain = (const float*)d_in[9];
    p.out = (float*)d_out; p.ws = (unsigned char*)d_ws;
#ifdef MULTI_LAUNCH
    const int G = 256;
    hipLaunchKernelGGL(k_phase0, dim3(G), dim3(NTHR), 0, stream, p);
    hipLaunchKernelGGL(k_phase1, dim3(G), dim3(NTHR), 0, stream, p);
    hipLaunchKernelGGL(k_phase2, dim3(G), dim3(NTHR), 0, stream, p);
    hipLaunchKernelGGL(k_phase3, dim3(G), dim3(NTHR), 0, stream, p);
    hipLaunchKernelGGL(k_phase4, dim3(G), dim3(NTHR), 0, stream, p);
    hipLaunchKernelGGL(k_phase5, dim3(G), dim3(NTHR), 0, stream, p);
    hipLaunchKernelGGL(k_phase6, dim3(G), dim3(NTHR), 0, stream, p);
    hipLaunchKernelGGL(k_phase7, dim3(G), dim3(NTHR), 0, stream, p);
    hipLaunchKernelGGL(k_phase8, dim3(G), dim3(NTHR), 0, stream, p);
#else
    static int grid = 0;
    if (!grid) {
        int dev = 0, cus = 0, per_cu = 0;
        (void)hipGetDevice(&dev);
        (void)hipDeviceGetAttribute(&cus, hipDeviceAttributeMultiprocessorCount, dev);
        (void)hipOccupancyMaxActiveBlocksPerMultiprocessor(&per_cu, (const void*)k_mega, NTHR, 0);
        if (per_cu < 1) { fprintf(stderr, "kernel_launch: occupancy query says %d blocks/CU\n", per_cu); per_cu = 1; }
        grid = cus;
        if (ws_size < WS_END) fprintf(stderr, "kernel_launch: workspace too small: %zu < %zu\n", ws_size, (size_t)WS_END);
    }
    void* args[] = {&p};
    hipError_t e = hipLaunchCooperativeKernel((const void*)k_mega, dim3(grid), dim3(NTHR), args, 0, stream);
    if (e != hipSuccess) fprintf(stderr, "kernel_launch: cooperative launch failed: %s (grid %d)\n", hipGetErrorString(e), grid);
#endif
}
```
